# Optimizing an MI355X kernel written in HIP

```python
import math
import jax, jax.numpy as jnp
from jax import lax
import numpy as np

D_MODEL = 1024
BATCH = 16
SEQ = 2048
DEPTH = 1

HEAD_DIM = 64
ATTN_CONFIGS = ((128, 1), (512, 4), (2048, 16))
HEADS_PER_GROUP = 4
N_ATTN_HEADS = HEADS_PER_GROUP * len(ATTN_CONFIGS)
ATTN_WIDTH = N_ATTN_HEADS * HEAD_DIM
ATTN_OUT_WIDTH = HEADS_PER_GROUP * HEAD_DIM
BLOCK = 128
N_REL_BUCKETS = 32
REL_MAX_DISTANCE = 2048
NEG_INF = -1e30

POOL_SIZES = (2, 4, 8, 16)
POOL_GROUP_DIM = 128
POOL_WIDTH = POOL_GROUP_DIM * len(POOL_SIZES)

Q_OFF = 0
K_OFF = Q_OFF + ATTN_WIDTH
V_OFF = K_OFF + ATTN_WIDTH
POOL_OFF = V_OFF + ATTN_WIDTH
GATE_A_OFF = POOL_OFF + POOL_WIDTH
GATE_B_OFF = GATE_A_OFF + D_MODEL
IN_WIDTH = GATE_B_OFF + D_MODEL

N_EXPERT_GROUPS = 4
EXPERTS_PER_GROUP = 8
N_EXPERTS = N_EXPERT_GROUPS * EXPERTS_PER_GROUP
EXPERT_TOP_K = 2
D_EXPERT = 256

LN_EPS = 1e-5
DEEPNORM_ALPHA = (2.0 * DEPTH) ** 0.25
DEEPNORM_BETA = (8.0 * DEPTH) ** -0.25

kernel_name = 'hybrid_dilated_pool_hiermoe_block'


def layer_norm(x, gamma, beta):
    xf = x.astype(jnp.float32)
    mu = jnp.mean(xf, axis=-1, keepdims=True)
    var = jnp.mean(jnp.square(xf - mu), axis=-1, keepdims=True)
    return ((xf - mu) * lax.rsqrt(var + LN_EPS) * gamma + beta).astype(x.dtype)


def t5_causal_bucket(dist):
    max_exact = N_REL_BUCKETS // 2
    is_small = dist < max_exact
    d = jnp.maximum(dist, 1).astype(jnp.float32)
    large = max_exact + (jnp.log(d / max_exact) / math.log(REL_MAX_DISTANCE / max_exact)
                         * (N_REL_BUCKETS - max_exact)).astype(jnp.int32)
    large = jnp.minimum(large, N_REL_BUCKETS - 1)
    return jnp.where(is_small, dist, large)


def dilated_window_attention(q, k, v, bias_table, dilation, span):
    B, S, H, Dh = q.shape
    Z = B * dilation
    L = S // dilation
    nb = -(-L // BLOCK)
    Lp = nb * BLOCK

    def to_blocks(t):
        t = t.reshape(B, L, dilation, H, Dh).transpose(0, 2, 1, 3, 4).reshape(Z, L, H, Dh)
        t = jnp.pad(t, ((0, 0), (0, Lp - L), (0, 0), (0, 0)))
        return t.reshape(Z, nb, BLOCK, H, Dh)

    def with_prev(t):
        prev = jnp.pad(t[:, :-1], ((0, 0), (1, 0), (0, 0), (0, 0), (0, 0)))
        return jnp.concatenate([prev, t], axis=2)

    qb = to_blocks(q)
    kc = with_prev(to_blocks(k))
    vc = with_prev(to_blocks(v))
    logits = jnp.einsum('znqhd,znkhd->znhqk', qb, kc).astype(jnp.float32) * (Dh ** -0.5)

    qi = jnp.arange(BLOCK)[:, None]
    ki = jnp.arange(2 * BLOCK)[None, :]
    step = qi + BLOCK - ki
    in_window = (step >= 0) & (step <= span)
    bucket = t5_causal_bucket(jnp.clip(step, 0, span) * dilation)
    bias = jnp.transpose(bias_table[bucket], (2, 0, 1)).astype(jnp.float32)
    after_start = (jnp.arange(nb)[:, None, None] > 0) | (ki >= BLOCK)[None]
    valid = in_window[None] & after_start
    logits = jnp.where(valid[None, :, None], logits + bias[None, None], NEG_INF)

    m = jnp.max(logits, axis=-1, keepdims=True)
    p = jnp.exp(logits - m)
    s = jnp.sum(p, axis=-1, keepdims=True)
    o = jnp.einsum('znhqk,znkhd->znqhd', p.astype(v.dtype), vc)
    o = o / jnp.transpose(s, (0, 1, 3, 2, 4))
    lse = jnp.transpose((m + jnp.log(s))[..., 0], (0, 1, 3, 2))

    def from_blocks(t):
        t = t.reshape((Z, Lp) + t.shape[3:])[:, :L]
        t = t.reshape((B, dilation, L) + t.shape[2:])
        t = jnp.moveaxis(t, 1, 2)
        return t.reshape((B, S) + t.shape[3:])

    return from_blocks(o).astype(q.dtype), from_blocks(lse)


def dilated_attention_mixer(q, k, v, rel_bias_table):
    B, S = q.shape[:2]
    outs, lses = [], []
    for g, (window, dilation) in enumerate(ATTN_CONFIGS):
        hs = slice(g * HEADS_PER_GROUP, (g + 1) * HEADS_PER_GROUP)
        o, lse = dilated_window_attention(q[:, :, hs], k[:, :, hs], v[:, :, hs],
                                          rel_bias_table[:, hs], dilation, window // dilation)
        outs.append(o)
        lses.append(lse)
    weights = jax.nn.softmax(jnp.stack(lses, axis=0), axis=0)
    o = jnp.sum(weights[..., None] * jnp.stack(outs, axis=0).astype(jnp.float32), axis=0)
    return o.reshape(B, S, ATTN_OUT_WIDTH).astype(q.dtype)


def multiscale_pool_mixer(u, w_pool, pool_scale):
    B, S, _ = u.shape
    ug = u.reshape(B, S, len(POOL_SIZES), POOL_GROUP_DIM)
    csum = jnp.pad(jnp.cumsum(ug.astype(jnp.float32), axis=1), ((0, 0), (1, 0), (0, 0), (0, 0)))
    t = jnp.arange(S)
    pooled = []
    for gi, w in enumerate(POOL_SIZES):
        start = jnp.maximum(t + 1 - w, 0)
        count = jnp.minimum(t + 1, w).astype(jnp.float32)
        pooled.append((csum[:, t + 1, gi] - csum[:, start, gi]) / count[None, :, None])
    diff = (jnp.stack(pooled, axis=2) - ug.astype(jnp.float32)).astype(u.dtype)
    y = jnp.einsum('bsgc,gcd->bsgd', diff, w_pool).reshape(B, S, POOL_WIDTH)
    return y * pool_scale


def hierarchical_moe(h, w_router_group, b_router_group, w_router_expert, b_router_expert,
                     w_expert_gate, w_expert_up, w_expert_down):
    B, S, D = h.shape
    hf = h.reshape(B * S, D)
    group_probs = jax.nn.softmax((hf @ w_router_group + b_router_group).astype(jnp.float32), axis=-1)
    g_prob, g_idx = lax.top_k(group_probs, 1)
    expert_logits = (hf @ w_router_expert + b_router_expert).astype(jnp.float32)
    expert_logits = expert_logits.reshape(-1, N_EXPERT_GROUPS, EXPERTS_PER_GROUP)
    in_group = jnp.take_along_axis(expert_logits, g_idx[:, :, None], axis=1)[:, 0]
    top_logits, top_idx = lax.top_k(in_group, EXPERT_TOP_K)
    top_w = jax.nn.softmax(top_logits, axis=-1) * g_prob
    expert_id = g_idx * EXPERTS_PER_GROUP + top_idx
    combine = jnp.sum(jax.nn.one_hot(expert_id, N_EXPERTS, dtype=jnp.float32) * top_w[..., None],
                      axis=1).astype(h.dtype)
    y = jnp.zeros_like(hf)
    for e in range(N_EXPERTS):
        hidden = jax.nn.silu(hf @ w_expert_gate[e]) * (hf @ w_expert_up[e])
        y = y + combine[:, e:e + 1] * (hidden @ w_expert_down[e])
    return y.reshape(B, S, D)


def setup_inputs(seed: int = 0) -> dict:
    key = jax.random.key(seed)
    ks = jax.random.split(key, 22)
    f32 = jnp.float32
    nrm = lambda k, shape, scale: jax.random.normal(k, shape, f32) * scale
    L = DEPTH
    col_scale = jnp.ones((IN_WIDTH,), f32).at[V_OFF:V_OFF + ATTN_WIDTH].set(DEEPNORM_BETA)
    return {
        'x': jax.random.normal(ks[0], (BATCH, SEQ, D_MODEL), f32),
        'w_in': nrm(ks[1], (L, D_MODEL, IN_WIDTH), D_MODEL ** -0.5) * col_scale,
        'b_in': nrm(ks[2], (L, IN_WIDTH), 0.02),
        'rel_bias_table': nrm(ks[3], (N_REL_BUCKETS, N_ATTN_HEADS), 0.5),
        'w_pool': nrm(ks[4], (L, len(POOL_SIZES), POOL_GROUP_DIM, POOL_GROUP_DIM), POOL_GROUP_DIM ** -0.5),
        'pool_scale': 1.0 + nrm(ks[5], (L, POOL_WIDTH), 0.1),
        'w_proj_attn': nrm(ks[6], (L, ATTN_OUT_WIDTH, D_MODEL), ATTN_OUT_WIDTH ** -0.5),
        'w_proj_pool': nrm(ks[7], (L, POOL_WIDTH, D_MODEL), POOL_WIDTH ** -0.5),
        'w_out': nrm(ks[8], (L, D_MODEL, D_MODEL), D_MODEL ** -0.5 * DEEPNORM_BETA),
        'ln1_gamma': 1.0 + nrm(ks[9], (L, D_MODEL), 0.05),
        'ln1_beta': nrm(ks[10], (L, D_MODEL), 0.02),
        'w_router_group': nrm(ks[11], (L, D_MODEL, N_EXPERT_GROUPS), D_MODEL ** -0.5),
        'b_router_group': nrm(ks[12], (L, N_EXPERT_GROUPS), 0.01),
        'w_router_expert': nrm(ks[13], (L, D_MODEL, N_EXPERTS), D_MODEL ** -0.5),
        'b_router_expert': nrm(ks[14], (L, N_EXPERTS), 0.01),
        'w_expert_gate': nrm(ks[15], (L, N_EXPERTS, D_MODEL, D_EXPERT), D_MODEL ** -0.5 * DEEPNORM_BETA),
        'w_expert_up': nrm(ks[16], (L, N_EXPERTS, D_MODEL, D_EXPERT), D_MODEL ** -0.5 * DEEPNORM_BETA),
        'w_expert_down': nrm(ks[17], (L, N_EXPERTS, D_EXPERT, D_MODEL), D_EXPERT ** -0.5 * DEEPNORM_BETA),
        'ln2_gamma': 1.0 + nrm(ks[18], (L, D_MODEL), 0.05),
        'ln2_beta': nrm(ks[19], (L, D_MODEL), 0.02),
    }


def reference(x, w_in, b_in, rel_bias_table, w_pool, pool_scale, w_proj_attn, w_proj_pool, w_out,
              ln1_gamma, ln1_beta, w_router_group, b_router_group, w_router_expert, b_router_expert,
              w_expert_gate, w_expert_up, w_expert_down, ln2_gamma, ln2_beta):
    B, S, D = x.shape
    for layer in range(DEPTH):
        proj = x @ w_in[layer] + b_in[layer]
        q = proj[..., Q_OFF:K_OFF].reshape(B, S, N_ATTN_HEADS, HEAD_DIM)
        k = proj[..., K_OFF:V_OFF].reshape(B, S, N_ATTN_HEADS, HEAD_DIM)
        v = proj[..., V_OFF:POOL_OFF].reshape(B, S, N_ATTN_HEADS, HEAD_DIM)
        u = proj[..., POOL_OFF:GATE_A_OFF]
        gate_a = jax.nn.sigmoid(proj[..., GATE_A_OFF:GATE_B_OFF])
        gate_b = jax.nn.sigmoid(proj[..., GATE_B_OFF:IN_WIDTH])

        y_attn = dilated_attention_mixer(q, k, v, rel_bias_table) @ w_proj_attn[layer]
        y_pool = multiscale_pool_mixer(u, w_pool[layer], pool_scale[layer]) @ w_proj_pool[layer]
        mixed = gate_a * y_attn + gate_b * y_pool
        x = layer_norm(DEEPNORM_ALPHA * x + mixed @ w_out[layer], ln1_gamma[layer], ln1_beta[layer])

        moe = hierarchical_moe(x, w_router_group[layer], b_router_group[layer],
                               w_router_expert[layer], b_router_expert[layer],
                               w_expert_gate[layer], w_expert_up[layer], w_expert_down[layer])
        x = layer_norm(DEEPNORM_ALPHA * x + moe, ln2_gamma[layer], ln2_beta[layer])
    return x
```

```cpp
#include <hip/hip_runtime.h>
#include <cstdint>
#include <cstdio>

typedef unsigned short bf16_t;
typedef short bf16x8 __attribute__((ext_vector_type(8)));
typedef float f32x4 __attribute__((ext_vector_type(4)));

constexpr int BATCH = 16, SEQ = 2048, DM = 1024, NTOK = BATCH * SEQ;
constexpr int HD = 64, ATTW = 768, AOW = 256, POOLW = 512, INW = 4864;
constexpr int Q_OFF = 0, K_OFF = 768, V_OFF = 1536, POOL_OFF = 2304, GA_OFF = 2816, GB_OFF = 3840;
constexpr int NEXP = 32, DEXP = 256, NGRP = 4, EPG = 8;
constexpr float LN_EPS = 1e-5f;
constexpr float ALPHA = 1.189207115002721f;
constexpr int MAXROWS = 65536 + NEXP * 256;

constexpr size_t MiB = 1u << 20;
constexpr size_t WS_PROJ = 0;
constexpr size_t WS_PO = 0;
constexpr size_t WS_HID = 144 * MiB;
constexpr size_t WS_MIXED = 304 * MiB;
constexpr size_t WS_X1B = 368 * MiB;
constexpr size_t WS_WT = 432 * MiB;
constexpr size_t WS_CTL = 500 * MiB;
constexpr size_t WS_LIST = 501 * MiB;
constexpr size_t WS_LISTW = 505 * MiB;
constexpr size_t WS_TINFO = 509 * MiB;
constexpr size_t WS_END = 512 * MiB;
constexpr size_t DO_AO = 0, DO_DIFF = 16 * MiB, DO_PB = 48 * MiB;

__device__ __forceinline__ bf16_t f2bf(float f) { unsigned u = __float_as_uint(f); return (bf16_t)((u + 0x7fffu + ((u >> 16) & 1u)) >> 16); }
__device__ __forceinline__ float bf2f(bf16_t h) { return __uint_as_float(((unsigned)h) << 16); }
__device__ __forceinline__ bf16_t cvt_in(float v) { return f2bf(v); }
__device__ __forceinline__ bf16_t cvt_in(bf16_t v) { return v; }
__device__ __forceinline__ float sigmoidf_(float v) { return 1.f / (1.f + __expf(-v)); }
__device__ __forceinline__ float wave_sum(float v) {
#pragma unroll
    for (int o = 1; o < 64; o <<= 1) v += __shfl_xor(v, o);
    return v;
}
__device__ __forceinline__ float wave_max(float v) {
#pragma unroll
    for (int o = 1; o < 64; o <<= 1) v = fmaxf(v, __shfl_xor(v, o));
    return v;
}

template <int NB, class AT, class RowPtr, class Epi>
__device__ __forceinline__ void gemm_tile64(RowPtr rowptr, const float* B0, const float* B1, int ldb, int col0, int K, Epi epi) {
    __shared__ __attribute__((aligned(16))) bf16_t sA[64][40];
    __shared__ __attribute__((aligned(16))) bf16_t sB[NB][64][40];
    const int tid = threadIdx.x, lane = tid & 63, wid = tid >> 6, wr = wid >> 1, wc = wid & 1;
    f32x4 acc[NB][2][2];
#pragma unroll
    for (int b = 0; b < NB; ++b)
#pragma unroll
        for (int i = 0; i < 2; ++i)
#pragma unroll
            for (int j = 0; j < 2; ++j) acc[b][i][j] = (f32x4){0.f, 0.f, 0.f, 0.f};
    const int ar = tid >> 2, akc = (tid & 3) * 8;
    const AT* arow = rowptr(ar);
    const int bk = tid >> 3, bnc = (tid & 7) * 8;
    for (int k0 = 0; k0 < K; k0 += 32) {
#pragma unroll
        for (int j = 0; j < 8; ++j) sA[ar][akc + j] = cvt_in(arow[k0 + akc + j]);
#pragma unroll
        for (int b = 0; b < NB; ++b) {
            const float* p = (b == 0 ? B0 : B1) + (size_t)(k0 + bk) * ldb + col0 + bnc;
#pragma unroll
            for (int j = 0; j < 8; ++j) sB[b][bnc + j][bk] = f2bf(p[j]);
        }
        __syncthreads();
#pragma unroll
        for (int mi = 0; mi < 2; ++mi) {
            const bf16x8 a = *(const bf16x8*)&sA[wr * 32 + mi * 16 + (lane & 15)][8 * (lane >> 4)];
#pragma unroll
            for (int b = 0; b < NB; ++b)
#pragma unroll
                for (int ni = 0; ni < 2; ++ni) {
                    const bf16x8 bb = *(const bf16x8*)&sB[b][wc * 32 + ni * 16 + (lane & 15)][8 * (lane >> 4)];
                    acc[b][mi][ni] = __builtin_amdgcn_mfma_f32_16x16x32_bf16(a, bb, acc[b][mi][ni], 0, 0, 0);
                }
        }
        __syncthreads();
    }
#pragma unroll
    for (int mi = 0; mi < 2; ++mi)
#pragma unroll
        for (int ni = 0; ni < 2; ++ni)
#pragma unroll
            for (int j = 0; j < 4; ++j) {
                const int r = wr * 32 + mi * 16 + (lane >> 4) * 4 + j, c = col0 + wc * 32 + ni * 16 + (lane & 15);
                if (NB == 1) epi(r, c, acc[0][mi][ni][j], 0.f); else epi(r, c, acc[0][mi][ni][j], acc[NB - 1][mi][ni][j]);
            }
}

__global__ __launch_bounds__(256) void k_proj(const float* x, const float* w_in, const float* b_in, bf16_t* proj) {
    const int row0 = blockIdx.y * 64, col0 = blockIdx.x * 64;
    gemm_tile64<1, float>([&](int r) { return x + (size_t)(row0 + r) * DM; }, w_in, nullptr, INW, col0, DM,
        [&](int r, int c, float v, float) { v += b_in[c]; if (c >= GA_OFF) v = sigmoidf_(v); proj[(size_t)(row0 + r) * INW + c] = f2bf(v); });
}

__device__ __forceinline__ int t5_bucket(int dist) {
    if (dist < 16) return dist;
    const float d = (float)dist;
    int large = 16 + (int)(logf(d / 16.0f) / logf(128.0f) * 16.0f);
    return large < 31 ? large : 31;
}

__global__ __launch_bounds__(256) void k_attn(const bf16_t* proj, const float* rel_bias, bf16_t* ao) {
    __shared__ float sc[4][400];
    const int tok = blockIdx.x, t = tok % SEQ, lane = threadIdx.x & 63, slot = threadIdx.x >> 6;
    const bf16_t* prow = proj + (size_t)tok * INW;
    float mx = -3.0e38f;
    for (int idx = lane; idx < 387; idx += 64) {
        const int g = idx / 129, j = idx % 129, dil = (g == 0) ? 1 : (g == 1 ? 4 : 16), pos = t - j * dil, h = g * 4 + slot;
        float lg = -3.0e38f;
        if (pos >= 0) {
            const bf16_t* q = prow + Q_OFF + h * HD;
            const bf16_t* k = proj + (size_t)(tok - j * dil) * INW + K_OFF + h * HD;
            float d = 0.f;
            for (int e = 0; e < HD; ++e) d += bf2f(q[e]) * bf2f(k[e]);
            lg = d * 0.125f + rel_bias[t5_bucket(j * dil) * 12 + h];
        }
        sc[slot][idx] = lg; mx = fmaxf(mx, lg);
    }
    mx = wave_max(mx);
    float sum = 0.f;
    for (int idx = lane; idx < 387; idx += 64) { const float lg = sc[slot][idx]; const float p = (lg > -1.0e38f) ? __expf(lg - mx) : 0.f; sc[slot][idx] = p; sum += p; }
    sum = wave_sum(sum);
    __syncthreads();
    float o = 0.f;
    for (int idx = 0; idx < 387; ++idx) {
        const float p = sc[slot][idx];
        if (p != 0.f) { const int g = idx / 129, j = idx % 129, dil = (g == 0) ? 1 : (g == 1 ? 4 : 16), h = g * 4 + slot;
            o += p * bf2f(proj[(size_t)(tok - j * dil) * INW + V_OFF + h * HD + lane]); }
    }
    ao[(size_t)tok * AOW + slot * HD + lane] = f2bf(o / sum);
}

__global__ __launch_bounds__(256) void k_pool(const bf16_t* proj, bf16_t* diff) {
    const size_t i = (size_t)blockIdx.x * 256 + threadIdx.x; const int tok = (int)(i / POOLW), c = (int)(i % POOLW), t = tok % SEQ, gi = c >> 7, w = 2 << gi;
    const int cnt = (t + 1 < w) ? t + 1 : w;
    float s = 0.f;
    for (int j = 0; j < cnt; ++j) s += bf2f(proj[(size_t)(tok - j) * INW + POOL_OFF + c]);
    diff[i] = f2bf(s / (float)cnt - bf2f(proj[(size_t)tok * INW + POOL_OFF + c]));
}
__global__ __launch_bounds__(256) void k_poolmap(const bf16_t* diff, const float* w_pool, const float* pool_scale, bf16_t* pb) {
    const int row0 = blockIdx.y * 64, g = blockIdx.z, col0 = blockIdx.x * 64;
    gemm_tile64<1, bf16_t>([&](int r) { return diff + (size_t)(row0 + r) * POOLW + g * 128; }, w_pool + (size_t)g * 128 * 128, nullptr, 128, col0, 128,
        [&](int r, int c, float v, float) { pb[(size_t)(row0 + r) * POOLW + g * 128 + c] = f2bf(v * pool_scale[g * 128 + c]); });
}
__global__ __launch_bounds__(256) void k_yattn(const bf16_t* ao, const float* w_pa, const bf16_t* proj, bf16_t* mixed) {
    const int row0 = blockIdx.y * 64, col0 = blockIdx.x * 64;
    gemm_tile64<1, bf16_t>([&](int r) { return ao + (size_t)(row0 + r) * AOW; }, w_pa, nullptr, DM, col0, AOW,
        [&](int r, int c, float v, float) { mixed[(size_t)(row0 + r) * DM + c] = f2bf(v * bf2f(proj[(size_t)(row0 + r) * INW + GA_OFF + c])); });
}
__global__ __launch_bounds__(256) void k_ypool(const bf16_t* pb, const float* w_pp, const bf16_t* proj, bf16_t* mixed) {
    const int row0 = blockIdx.y * 64, col0 = blockIdx.x * 64;
    gemm_tile64<1, bf16_t>([&](int r) { return pb + (size_t)(row0 + r) * POOLW; }, w_pp, nullptr, DM, col0, POOLW,
        [&](int r, int c, float v, float) { bf16_t* m = mixed + (size_t)(row0 + r) * DM + c; *m = f2bf(bf2f(*m) + v * bf2f(proj[(size_t)(row0 + r) * INW + GB_OFF + c])); });
}
__global__ __launch_bounds__(256) void k_wout(const bf16_t* mixed, const float* w_out, const float* x, float* z) {
    const int row0 = blockIdx.y * 64, col0 = blockIdx.x * 64;
    gemm_tile64<1, bf16_t>([&](int r) { return mixed + (size_t)(row0 + r) * DM; }, w_out, nullptr, DM, col0, DM,
        [&](int r, int c, float v, float) { const size_t o = (size_t)(row0 + r) * DM + c; z[o] = ALPHA * x[o] + v; });
}

__global__ __launch_bounds__(256) void k_ln_router(float* zx, const float* g1, const float* b1, bf16_t* x1b,
                                                   const float* wrg, const float* brg, const float* wre, const float* bre,
                                                   int* cnt, int* list, float* listw, int4* tinfo) {
    __shared__ float slog[4][40];
    __shared__ __attribute__((aligned(16))) float sx[4][1024];
    const int lane = threadIdx.x & 63, wv = threadIdx.x >> 6, tok = blockIdx.x * 4 + wv;
    float* row = zx + (size_t)tok * DM;
    f32x4 v[4]; float s = 0.f;
#pragma unroll
    for (int j = 0; j < 4; ++j) { v[j] = *(const f32x4*)(row + lane * 4 + 256 * j); s += (v[j][0] + v[j][1]) + (v[j][2] + v[j][3]); }
    const float mean = wave_sum(s) * (1.f / DM); float s2 = 0.f;
#pragma unroll
    for (int j = 0; j < 4; ++j) { v[j] = v[j] - mean; s2 += (v[j][0] * v[j][0] + v[j][1] * v[j][1]) + (v[j][2] * v[j][2] + v[j][3] * v[j][3]); }
    const float rstd = 1.f / sqrtf(wave_sum(s2) * (1.f / DM) + LN_EPS);
#pragma unroll
    for (int j = 0; j < 4; ++j) {
        const int k0 = lane * 4 + 256 * j;
        const f32x4 gg = *(const f32x4*)(g1 + k0), bb = *(const f32x4*)(b1 + k0);
        v[j] = v[j] * rstd * gg + bb;
        *(f32x4*)(row + k0) = v[j];
        *(f32x4*)(&sx[wv][k0]) = v[j];
        ushort4 pk; pk.x = f2bf(v[j][0]); pk.y = f2bf(v[j][1]); pk.z = f2bf(v[j][2]); pk.w = f2bf(v[j][3]);
        *(ushort4*)(x1b + (size_t)tok * DM + k0) = pk;
    }
    __syncthreads();
    float acc[36];
#pragma unroll
    for (int o = 0; o < 36; ++o) acc[o] = 0.f;
#pragma unroll 1
    for (int m = 0; m < 16; ++m) {
        const int k = lane + 64 * m; const float xv = sx[wv][k];
        const f32x4 wg = *(const f32x4*)(wrg + (size_t)k * 4);
#pragma unroll
        for (int o = 0; o < 4; ++o) acc[o] += xv * wg[o];
#pragma unroll
        for (int q = 0; q < 8; ++q) { const f32x4 we = *(const f32x4*)(wre + (size_t)k * 32 + q * 4);
#pragma unroll
            for (int o = 0; o < 4; ++o) acc[4 + q * 4 + o] += xv * we[o]; }
    }
#pragma unroll
    for (int o = 0; o < 36; ++o) { const float tot = wave_sum(acc[o]); if (lane == 0) slog[wv][o] = tot + (o < 4 ? brg[o] : bre[o - 4]); }
    __syncthreads();
    if (lane == 0) {
        int gi = 0; float gm = slog[wv][0];
        for (int o = 1; o < 4; ++o) if (slog[wv][o] > gm) { gm = slog[wv][o]; gi = o; }
        float gs = 0.f; for (int o = 0; o < 4; ++o) gs += __expf(slog[wv][o] - gm);
        const float gprob = 1.f / gs;
        const float* el = &slog[wv][4 + gi * 8];
        int i0 = 0; float l0 = el[0];
        for (int o = 1; o < 8; ++o) if (el[o] > l0) { l0 = el[o]; i0 = o; }
        int i1 = -1; float l1 = -3.0e38f;
        for (int o = 0; o < 8; ++o) if (o != i0 && el[o] > l1) { l1 = el[o]; i1 = o; }
        const float e1 = __expf(l1 - l0), w0 = gprob / (1.f + e1), w1 = gprob * e1 / (1.f + e1);
        const int ex0 = gi * 8 + i0, ex1 = gi * 8 + i1;
        const int r0 = atomicAdd(&cnt[ex0], 1), r1 = atomicAdd(&cnt[ex1], 1);
        list[ex0 * NTOK + r0] = tok; listw[ex0 * NTOK + r0] = w0;
        list[ex1 * NTOK + r1] = tok; listw[ex1 * NTOK + r1] = w1;
        tinfo[tok] = make_int4(ex0, r0, ex1, r1);
    }
}

__device__ __forceinline__ int expert_off(const int* cnt, int e) { int off = 0; for (int i = 0; i < e; ++i) off += (cnt[i] + 255) & ~255; return off; }

__global__ __launch_bounds__(256) void k_moe1(const bf16_t* x1b, const float* wg, const float* wu, const int* cnt, const int* list, const float* listw, bf16_t* hid) {
    const int e = blockIdx.z, rt = blockIdx.y, n = cnt[e];
    if (rt * 64 >= n) return;
    const int off = expert_off(cnt, e), col0 = blockIdx.x * 64;
    gemm_tile64<2, bf16_t>([&](int r) { const int idx = rt * 64 + r; const int tok = idx < n ? list[e * NTOK + idx] : 0; return x1b + (size_t)tok * DM; },
        wg + (size_t)e * DM * DEXP, wu + (size_t)e * DM * DEXP, DEXP, col0, DM,
        [&](int r, int c, float g, float u) { const int idx = rt * 64 + r; if (idx < n) { const float w = listw[e * NTOK + idx];
            hid[(size_t)(off + idx) * DEXP + c] = f2bf(w * (g / (1.f + __expf(-g))) * u); } });
}
__global__ __launch_bounds__(256) void k_moe2(const bf16_t* hid, const float* wd, const int* cnt, bf16_t* po) {
    const int e = blockIdx.z, rt = blockIdx.y, n = cnt[e];
    if (rt * 64 >= n) return;
    const int off = expert_off(cnt, e), col0 = blockIdx.x * 64;
    gemm_tile64<1, bf16_t>([&](int r) { int idx = rt * 64 + r; if (idx >= n) idx = 0; return hid + (size_t)(off + idx) * DEXP; },
        wd + (size_t)e * DEXP * DM, nullptr, DM, col0, DEXP,
        [&](int r, int c, float v, float) { const int idx = rt * 64 + r; if (idx < n) po[(size_t)(off + idx) * DM + c] = f2bf(v); });
}
__global__ __launch_bounds__(256) void k_final(float* out, const bf16_t* po, const int* cnt, const int4* tinfo, const float* g2, const float* b2) {
    const int lane = threadIdx.x & 63, wv = threadIdx.x >> 6, tok = blockIdx.x * 4 + wv;
    const int4 ti = tinfo[tok];
    const size_t p0 = (size_t)(expert_off(cnt, ti.x) + ti.y) * DM, p1 = (size_t)(expert_off(cnt, ti.z) + ti.w) * DM;
    float* row = out + (size_t)tok * DM;
    f32x4 v[4]; float s = 0.f;
#pragma unroll
    for (int j = 0; j < 4; ++j) { const int k0 = lane * 4 + 256 * j; v[j] = *(const f32x4*)(row + k0) * ALPHA;
        const ushort4 a = *(const ushort4*)(po + p0 + k0), b = *(const ushort4*)(po + p1 + k0);
        v[j][0] += bf2f(a.x) + bf2f(b.x); v[j][1] += bf2f(a.y) + bf2f(b.y); v[j][2] += bf2f(a.z) + bf2f(b.z); v[j][3] += bf2f(a.w) + bf2f(b.w);
        s += (v[j][0] + v[j][1]) + (v[j][2] + v[j][3]); }
    const float mean = wave_sum(s) * (1.f / DM); float s2 = 0.f;
#pragma unroll
    for (int j = 0; j < 4; ++j) { v[j] = v[j] - mean; s2 += (v[j][0] * v[j][0] + v[j][1] * v[j][1]) + (v[j][2] * v[j][2] + v[j][3] * v[j][3]); }
    const float rstd = 1.f / sqrtf(wave_sum(s2) * (1.f / DM) + LN_EPS);
#pragma unroll
    for (int j = 0; j < 4; ++j) { const int k0 = lane * 4 + 256 * j; *(f32x4*)(row + k0) = v[j] * rstd * *(const f32x4*)(g2 + k0) + *(const f32x4*)(b2 + k0); }
}

extern "C" void kernel_launch(void* const* d_in, const int* in_sizes, int n_in, void* d_out, int out_size, void* d_ws, size_t ws_size, hipStream_t stream) {
    if (n_in != 20 || in_sizes[0] != NTOK * DM || out_size != NTOK * DM || ws_size < WS_END) {
        fprintf(stderr, "kernel_launch: unexpected shapes (n_in %d, in0 %d, out %d, ws %zu)\n", n_in, n_in > 0 ? in_sizes[0] : -1, out_size, ws_size); return; }
    const float* x = (const float*)d_in[0]; const float* w_in = (const float*)d_in[1]; const float* b_in = (const float*)d_in[2]; const float* rel = (const float*)d_in[3];
    const float* w_pool = (const float*)d_in[4]; const float* pool_scale = (const float*)d_in[5]; const float* w_pa = (const float*)d_in[6]; const float* w_pp = (const float*)d_in[7];
    const float* w_out = (const float*)d_in[8]; const float* g1 = (const float*)d_in[9]; const float* b1 = (const float*)d_in[10];
    const float* wrg = (const float*)d_in[11]; const float* brg = (const float*)d_in[12]; const float* wre = (const float*)d_in[13]; const float* bre = (const float*)d_in[14];
    const float* weg = (const float*)d_in[15]; const float* weu = (const float*)d_in[16]; const float* wed = (const float*)d_in[17];
    const float* g2 = (const float*)d_in[18]; const float* b2 = (const float*)d_in[19];
    unsigned char* ws = (unsigned char*)d_ws; float* out = (float*)d_out; unsigned char* ob = (unsigned char*)d_out;
    bf16_t* proj = (bf16_t*)(ws + WS_PROJ); bf16_t* po = (bf16_t*)(ws + WS_PO); bf16_t* hid = (bf16_t*)(ws + WS_HID);
    bf16_t* mixed = (bf16_t*)(ws + WS_MIXED); bf16_t* x1b = (bf16_t*)(ws + WS_X1B);
    int* cnt = (int*)(ws + WS_CTL); int* list = (int*)(ws + WS_LIST); float* listw = (float*)(ws + WS_LISTW); int4* tinfo = (int4*)(ws + WS_TINFO);
    bf16_t* ao = (bf16_t*)(ob + DO_AO); bf16_t* diff = (bf16_t*)(ob + DO_DIFF); bf16_t* pb = (bf16_t*)(ob + DO_PB);
    hipMemsetAsync(cnt, 0, 4096, stream);
    k_proj<<<dim3(INW / 64, NTOK / 64), 256, 0, stream>>>(x, w_in, b_in, proj);
    k_attn<<<NTOK, 256, 0, stream>>>(proj, rel, ao);
    k_pool<<<NTOK * POOLW / 256, 256, 0, stream>>>(proj, diff);
    k_poolmap<<<dim3(2, NTOK / 64, 4), 256, 0, stream>>>(diff, w_pool, pool_scale, pb);
    k_yattn<<<dim3(DM / 64, NTOK / 64), 256, 0, stream>>>(ao, w_pa, proj, mixed);
    k_ypool<<<dim3(DM / 64, NTOK / 64), 256, 0, stream>>>(pb, w_pp, proj, mixed);
    k_wout<<<dim3(DM / 64, NTOK / 64), 256, 0, stream>>>(mixed, w_out, x, out);
    k_ln_router<<<NTOK / 4, 256, 0, stream>>>(out, g1, b1, x1b, wrg, brg, wre, bre, cnt, list, listw, tinfo);
    k_moe1<<<dim3(DEXP / 64, NTOK / 64, NEXP), 256, 0, stream>>>(x1b, weg, weu, cnt, list, listw, hid);
    k_moe2<<<dim3(DM / 64, NTOK / 64, NEXP), 256, 0, stream>>>(hid, wed, cnt, po);
    k_final<<<NTOK / 4, 256, 0, stream>>>(out, po, cnt, tinfo, g2, b2);
}
```

```cpp
#define SINGLE_LAUNCH 1
#include <hip/hip_runtime.h>
#include <cstdint>
#include <cstdio>

typedef unsigned short bf16_t;
typedef short bf16x8 __attribute__((ext_vector_type(8)));
typedef float f32x4 __attribute__((ext_vector_type(4)));

constexpr int BATCH = 16, SEQ = 2048, DM = 1024, NTOK = BATCH * SEQ;
constexpr int HD = 64, ATTW = 768, AOW = 256, POOLW = 512, INW = 4864;
constexpr int Q_OFF = 0, K_OFF = 768, V_OFF = 1536, POOL_OFF = 2304, GA_OFF = 2816, GB_OFF = 3840;
constexpr int NEXP = 32, DEXP = 256, NGRP = 4, EPG = 8;
constexpr float LN_EPS = 1e-5f;
constexpr float ALPHA = 1.189207115002721f;
constexpr int MAXROWS = 65536 + NEXP * 256;

constexpr size_t MiB = 1u << 20;
constexpr size_t WS_PROJ = 0;
constexpr size_t WS_PO = 0;
constexpr size_t WS_HID = 130 * MiB;
constexpr size_t WS_Z = 166 * MiB;
constexpr size_t WS_MIXED = 304 * MiB;
constexpr size_t WS_X1B = 368 * MiB;
constexpr size_t WS_WT = 432 * MiB;
constexpr size_t WS_CTL = 500 * MiB;
constexpr size_t WS_LIST = 501 * MiB;
constexpr size_t WS_LISTW = 505 * MiB;
constexpr size_t WS_TINFO = 509 * MiB;
constexpr size_t WS_END = 512 * MiB;
constexpr size_t DO_AO = 0, DO_DIFF = 16 * MiB, DO_AOG = 48 * MiB, DO_LSE = 96 * MiB;

__device__ __forceinline__ bf16_t f2bf(float f) { unsigned u = __float_as_uint(f); return (bf16_t)((u + 0x7fffu + ((u >> 16) & 1u)) >> 16); }
__device__ __forceinline__ float bf2f(bf16_t h) { return __uint_as_float(((unsigned)h) << 16); }
__device__ __forceinline__ bf16_t cvt_in(float v) { return f2bf(v); }
__device__ __forceinline__ bf16_t cvt_in(bf16_t v) { return v; }
__device__ __forceinline__ float sigmoidf_(float v) { return 1.f / (1.f + __expf(-v)); }
#define DPP_ADD(v, CTRL) ((v) + __builtin_bit_cast(float, __builtin_amdgcn_update_dpp(0, __builtin_bit_cast(int, (v)), (CTRL), 0xf, 0xf, true)))
__device__ __forceinline__ float wave_sum(float v) {
    v = DPP_ADD(v, 0xB1);
    v = DPP_ADD(v, 0x4E);
    v = DPP_ADD(v, 0x141);
    v = DPP_ADD(v, 0x140);
    const int iv = __builtin_bit_cast(int, v);
    return (__builtin_bit_cast(float, __builtin_amdgcn_readlane(iv, 0)) + __builtin_bit_cast(float, __builtin_amdgcn_readlane(iv, 16)))
         + (__builtin_bit_cast(float, __builtin_amdgcn_readlane(iv, 32)) + __builtin_bit_cast(float, __builtin_amdgcn_readlane(iv, 48)));
}
__device__ __forceinline__ float wave_max(float v) {
#pragma unroll
    for (int o = 1; o < 64; o <<= 1) v = fmaxf(v, __shfl_xor(v, o));
    return v;
}

__device__ __forceinline__ int t5_bucket(int dist) {
    if (dist < 16) return dist;
    const float d = (float)dist;
    int large = 16 + (int)(logf(d / 16.0f) / logf(128.0f) * 16.0f);
    return large < 31 ? large : 31;
}


namespace pg8 {
#define PG8_LAS __attribute__((address_space(3)))
typedef unsigned u32x4 __attribute__((ext_vector_type(4)));
typedef unsigned u32x2 __attribute__((ext_vector_type(2)));
constexpr int BM = 256, BK = 64, HALF = 128, HTB = HALF * BK * 2  , STAGE_BYTES = 8 * HTB, NXCD = 8, WGM = 8;

__host__ __device__ __forceinline__ int lds_byte(int r, int c) { const int st = (r >> 4) * 2 + (c >> 5), rr = r & 15, cc = c & 31, ob = rr * 64 + cc * 2; return st * 1024 + (ob ^ (((ob >> 9) & 1) << 5)); }
__host__ __device__ __forceinline__ void stage_rc(int b, int& R, int& C) { const int st = b / 1024, sb = b % 1024, swz = sb ^ (((sb >> 9) & 1) << 5); R = (st >> 1) * 16 + swz / 64; C = (st & 1) * 32 + (swz % 64) / 2; }
__host__ __device__ __forceinline__ int perm32(int rho) { const int n = rho >> 4, i = rho & 15; return 8 * (i >> 2) + 4 * n + (i & 3); }

struct Unit { int pm, pn, e, rt; };
struct Gemm { const bf16_t* A; const bf16_t* Bt; int K; };

struct StaticOrder {
    int nM, nN, nwg, G, c;
    __device__ void init(int M, int N, int G_, int c_) { nM = M / BM; nN = N / BM; nwg = nM * nN; G = G_; c = c_; }
    __device__ bool next(int i, Unit& u) const {
        const long L = (long)i * G + c; if (L >= nwg) return false;
        int wgid = (int)L; { const int q = nwg / NXCD, r = nwg % NXCD, xcd = wgid % NXCD, off = wgid / NXCD; wgid = (xcd < r ? xcd * (q + 1) : r * (q + 1) + (xcd - r) * q) + off; }
        const int nig = WGM * nN, gid = wgid / nig, fm = gid * WGM, gsz = (nM - fm) < WGM ? (nM - fm) : WGM;
        u.pm = fm + ((wgid % nig) % gsz); u.pn = (wgid % nig) / gsz; u.e = 0; u.rt = 0; return true;
    }
    __device__ __forceinline__ int arow(const Unit& u, int r) const { return u.pm * BM + r; }
    __device__ __forceinline__ void done(const Unit&) const {}
};

struct MoeOrder {
    const PG8_LAS int* tile_e; const PG8_LAS int* first; const int* cnt; const int* list; int nN, G, c, ntiles; bool gather; unsigned* ready;
    __device__ bool next(int i, Unit& u) const {
        const int L = i * G + c; if (L >= ntiles * nN) return false;
        const int rt = L / nN, pn = L - rt * nN, e = tile_e[rt];
        u.pm = rt; u.pn = e * nN + pn; u.e = e; u.rt = rt - first[e]; return true;
    }
    __device__ __forceinline__ int arow(const Unit& u, int r) const {
        if (!gather) return u.pm * BM + r;
        const int idx = u.rt * BM + r; return idx < cnt[u.e * 64] ? (list[u.e * NTOK + idx] >> 1) : 0;
    }
    __device__ __forceinline__ void done(const Unit& u) const {
        asm volatile("s_waitcnt vmcnt(0)" ::: "memory");
        if ((threadIdx.x & 63) == 0) __hip_atomic_fetch_add(ready + 64 * u.pm, 1u, __ATOMIC_RELAXED, __HIP_MEMORY_SCOPE_AGENT);
    }
};
struct DynMoeOrder {
    const PG8_LAS int* tile_e; const PG8_LAS int* first; int nN, ntiles; unsigned* queue; const unsigned* ready; unsigned need; unsigned* tmo; volatile PG8_LAS int* slot;
    __device__ bool next(int i, Unit& u) const {
        if (threadIdx.x < 64) {
            int L = 0; if (threadIdx.x == 0) L = (int)__hip_atomic_fetch_add(queue, 1u, __ATOMIC_RELAXED, __HIP_MEMORY_SCOPE_AGENT);
            L = __builtin_amdgcn_readfirstlane(L);
            if (L < ntiles * nN) {
                const int rt = L / nN; unsigned spins = 0;
                while ((unsigned)__builtin_amdgcn_readfirstlane(__hip_atomic_load(ready + 64 * rt, __ATOMIC_RELAXED, __HIP_MEMORY_SCOPE_AGENT)) < need) {
                    __builtin_amdgcn_s_sleep(2);
                    if (++spins > (1u << 20)) { if (threadIdx.x == 0) __hip_atomic_store(tmo, 1u, __ATOMIC_RELAXED, __HIP_MEMORY_SCOPE_AGENT); break; } }
                __builtin_amdgcn_fence(__ATOMIC_ACQUIRE, "agent");
                asm volatile("s_waitcnt vmcnt(0)" ::: "memory");
            } else L = -1;
            if (threadIdx.x == 0) slot[i & 1] = L;
            asm volatile("s_waitcnt lgkmcnt(0)" ::: "memory");
        }
        __builtin_amdgcn_s_barrier(); asm volatile("" ::: "memory");
        const int L = slot[i & 1]; if (L < 0) return false;
        const int rt = L / nN, pn = L - rt * nN, e = tile_e[rt];
        u.pm = rt; u.pn = e * nN + pn; u.e = e; u.rt = rt - first[e]; return true;
    }
    __device__ __forceinline__ int arow(const Unit& u, int r) const { return u.pm * BM + r; }
    __device__ __forceinline__ void done(const Unit&) const {}
};

__device__ __forceinline__ unsigned cvt_pk_bf16(float lo, float hi) { unsigned r; asm volatile("v_cvt_pk_bf16_f32 %0, %1, %2" : "=v"(r) : "v"(lo), "v"(hi)); return r; }
__device__ __forceinline__ float bflo(unsigned w) { return __uint_as_float(w << 16); }
__device__ __forceinline__ float bfhi(unsigned w) { return __uint_as_float(w & 0xffff0000u); }
__device__ __forceinline__ float fsig(float v) { return __builtin_amdgcn_rcpf(1.f + __builtin_amdgcn_exp2f(-1.4426950408889634f * v)); }
__device__ __forceinline__ float fsig_gate(float v) { return fmaxf(fsig(v), 1.0e-7f); }

struct EpiProj {
    static constexpr bool PERM = true;
    bf16_t* O; const float* bias; float qscale;
    __device__ __forceinline__ void operator()(const f32x4 (&acc)[2][2][4][2], const Unit& u, int wr, int wc, int fr, int fq) const {
        const int row0 = u.pm * BM + wr * 64 + fr, lc0 = wc * 32 + 8 * fq;
        const bool gate = u.pn >= 11;
        const int lg = (u.pn < 9) ? 2 * (u.pn % 3) : 0;
        const int cb0 = gate ? GA_OFF + (u.pn - 11) * HALF + lc0 : u.pn * BM + lc0, cb1 = gate ? GB_OFF + (u.pn - 11) * HALF + lc0 : u.pn * BM + HALF + lc0;
        f32x4 bv[2][2];
#pragma unroll
        for (int n = 0; n < 2; ++n) { bv[0][n] = *(const f32x4*)(bias + cb0 + 4 * n); bv[1][n] = *(const f32x4*)(bias + cb1 + 4 * n); }
#pragma unroll
        for (int ai = 0; ai < 2; ++ai)
#pragma unroll
            for (int m = 0; m < 4; ++m) { const int rg = row0 + ai * HALF + m * 16, t = rg & (SEQ - 1), prow = (rg & ~(SEQ - 1)) + ((t & ((1 << lg) - 1)) << (11 - lg)) + (t >> lg);
                bf16_t* rowp = O + (size_t)prow * INW;
                f32x4 a0 = acc[ai][0][m][0] + bv[0][0], a1 = acc[ai][0][m][1] + bv[0][1], b0 = acc[ai][1][m][0] + bv[1][0], b1 = acc[ai][1][m][1] + bv[1][1];
                if (u.pn < 3) { a0 = a0 * qscale; a1 = a1 * qscale; b0 = b0 * qscale; b1 = b1 * qscale; }
                if (gate) {
#pragma unroll
                    for (int i = 0; i < 4; ++i) { const float s0 = fsig_gate(b0[i]), s1 = fsig_gate(b1[i]); a0[i] = fsig(a0[i]) * __builtin_amdgcn_rcpf(s0); a1[i] = fsig(a1[i]) * __builtin_amdgcn_rcpf(s1); b0[i] = s0; b1[i] = s1; } }
                u32x4 w; w.x = cvt_pk_bf16(a0[0], a0[1]); w.y = cvt_pk_bf16(a0[2], a0[3]); w.z = cvt_pk_bf16(a1[0], a1[1]); w.w = cvt_pk_bf16(a1[2], a1[3]);
                *(u32x4*)(rowp + cb0) = w;
                w.x = cvt_pk_bf16(b0[0], b0[1]); w.y = cvt_pk_bf16(b0[2], b0[3]); w.z = cvt_pk_bf16(b1[0], b1[1]); w.w = cvt_pk_bf16(b1[2], b1[3]);
                *(u32x4*)(rowp + cb1) = w; }
    }
};
template <bool ACCUM> struct EpiGate {
    static constexpr bool PERM = true;
    bf16_t* O; const bf16_t* gate;
    __device__ __forceinline__ void operator()(const f32x4 (&acc)[2][2][4][2], const Unit& u, int wr, int wc, int fr, int fq) const {
        const int row0 = u.pm * BM + wr * 64 + fr, col0 = u.pn * BM + wc * 32 + 8 * fq;
#pragma unroll
        for (int ai = 0; ai < 2; ++ai)
#pragma unroll
            for (int m = 0; m < 4; ++m) { const size_t r = (size_t)(row0 + ai * HALF + m * 16);
#pragma unroll
                for (int bj = 0; bj < 2; ++bj) {
                    const u32x4 gw = *(const u32x4*)(gate + r * INW + col0 + bj * HALF);
                    bf16_t* op = O + r * DM + col0 + bj * HALF;
                    f32x4 v0 = acc[ai][bj][m][0], v1 = acc[ai][bj][m][1];
                    v0[0] *= bflo(gw.x); v0[1] *= bfhi(gw.x); v0[2] *= bflo(gw.y); v0[3] *= bfhi(gw.y);
                    v1[0] *= bflo(gw.z); v1[1] *= bfhi(gw.z); v1[2] *= bflo(gw.w); v1[3] *= bfhi(gw.w);
                    if (ACCUM) { const u32x4 ow = *(const u32x4*)op;
                        v0[0] += bflo(ow.x); v0[1] += bfhi(ow.x); v0[2] += bflo(ow.y); v0[3] += bfhi(ow.y);
                        v1[0] += bflo(ow.z); v1[1] += bfhi(ow.z); v1[2] += bflo(ow.w); v1[3] += bfhi(ow.w); }
                    u32x4 w; w.x = cvt_pk_bf16(v0[0], v0[1]); w.y = cvt_pk_bf16(v0[2], v0[3]); w.z = cvt_pk_bf16(v1[0], v1[1]); w.w = cvt_pk_bf16(v1[2], v1[3]);
                    *(u32x4*)op = w; } }
    }
};
struct EpiMix {
    static constexpr bool PERM = true;
    bf16_t* O; const bf16_t* ga; const bf16_t* gb;
    __device__ __forceinline__ void mid(f32x4 (&acc)[2][2][4][2], const Unit& u, int wr, int wc, int fr, int fq) const {
        int row0 = u.pm * BM + wr * 64 + fr, col0 = u.pn * BM + wc * 32 + 8 * fq;
        asm volatile("" : "+v"(row0), "+v"(col0));
#pragma unroll
        for (int ai = 0; ai < 2; ++ai)
#pragma unroll
            for (int m = 0; m < 4; ++m) { const size_t r = (size_t)(row0 + ai * HALF + m * 16);
#pragma unroll
                for (int bj = 0; bj < 2; ++bj) {
                    const u32x4 a = *(const u32x4*)(ga + r * INW + col0 + bj * HALF);
                    f32x4& v0 = acc[ai][bj][m][0]; f32x4& v1 = acc[ai][bj][m][1];
                    v0[0] *= bflo(a.x); v0[1] *= bfhi(a.x); v0[2] *= bflo(a.y); v0[3] *= bfhi(a.y);
                    v1[0] *= bflo(a.z); v1[1] *= bfhi(a.z); v1[2] *= bflo(a.w); v1[3] *= bfhi(a.w); }
                }
    }
    __device__ __forceinline__ void operator()(const f32x4 (&acc)[2][2][4][2], const Unit& u, int wr, int wc, int fr, int fq) const {
        const int row0 = u.pm * BM + wr * 64 + fr, col0 = u.pn * BM + wc * 32 + 8 * fq;
#pragma unroll
        for (int ai = 0; ai < 2; ++ai)
#pragma unroll
            for (int m = 0; m < 4; ++m) { const size_t r = (size_t)(row0 + ai * HALF + m * 16);
#pragma unroll
                for (int bj = 0; bj < 2; ++bj) {
                    const u32x4 b = *(const u32x4*)(gb + r * INW + col0 + bj * HALF);
                    const f32x4 v0 = acc[ai][bj][m][0], v1 = acc[ai][bj][m][1];
                    u32x4 w; w.x = cvt_pk_bf16(v0[0] * bflo(b.x), v0[1] * bfhi(b.x)); w.y = cvt_pk_bf16(v0[2] * bflo(b.y), v0[3] * bfhi(b.y));
                    w.z = cvt_pk_bf16(v1[0] * bflo(b.z), v1[1] * bfhi(b.z)); w.w = cvt_pk_bf16(v1[2] * bflo(b.w), v1[3] * bfhi(b.w));
                    *(u32x4*)(O + r * DM + col0 + bj * HALF) = w; }
                }
    }
};
struct EpiY {
    static constexpr bool PERM = true;
    bf16_t* Y;
    __device__ __forceinline__ void operator()(const f32x4 (&acc)[2][2][4][2], const Unit& u, int wr, int wc, int fr, int fq) const {
        const int col0 = u.pn * BM + wc * 32 + 8 * fq;
#pragma unroll
        for (int ai = 0; ai < 2; ++ai)
#pragma unroll
            for (int m = 0; m < 4; ++m) { bf16_t* rowp = Y + (size_t)(u.pm * BM + ai * HALF + wr * 64 + m * 16 + fr) * DM + col0;
#pragma unroll
                for (int bj = 0; bj < 2; ++bj) { const f32x4 v0 = acc[ai][bj][m][0], v1 = acc[ai][bj][m][1];
                    u32x4 w; w.x = cvt_pk_bf16(v0[0], v0[1]); w.y = cvt_pk_bf16(v0[2], v0[3]); w.z = cvt_pk_bf16(v1[0], v1[1]); w.w = cvt_pk_bf16(v1[2], v1[3]);
                    *(u32x4*)(rowp + bj * HALF) = w; } }
    }
};
struct EpiMoe1 {
    static constexpr bool PERM = true;
    bf16_t* hid; const int* cnt; const float* listw;
    __device__ __forceinline__ void operator()(const f32x4 (&acc)[2][2][4][2], const Unit& u, int wr, int wc, int fr, int fq) const {
        const int n_e = cnt[u.e * 64], pnl = u.pn & 1, hc0 = pnl * 128 + wc * 32 + 8 * fq;
        const __amdgpu_buffer_rsrc_t rs = __builtin_amdgcn_make_buffer_rsrc(hid, 0, MAXROWS * DEXP * 2, 0x00020000);
#pragma unroll
        for (int ai = 0; ai < 2; ++ai)
#pragma unroll
            for (int m = 0; m < 4; ++m) { const int r = ai * HALF + wr * 64 + m * 16 + fr, idx = u.rt * BM + r;
                const float w = idx < n_e ? listw[u.e * NTOK + idx] : 0.f;
                float h[8];
#pragma unroll
                for (int n = 0; n < 2; ++n)
#pragma unroll
                    for (int i = 0; i < 4; ++i) { const float g = acc[ai][0][m][n][i], uu = acc[ai][1][m][n][i]; h[n * 4 + i] = w * g * fsig(g) * uu; }
                u32x4 o; o.x = cvt_pk_bf16(h[0], h[1]); o.y = cvt_pk_bf16(h[2], h[3]); o.z = cvt_pk_bf16(h[4], h[5]); o.w = cvt_pk_bf16(h[6], h[7]);
                __builtin_amdgcn_raw_buffer_store_b128(o, rs, (unsigned)(((u.pm * BM + r) * DEXP + hc0) * 2), 0,   16); }
    }
};
struct EpiMoe2 {
    static constexpr bool PERM = true;
    bf16_t* po; const int* cnt; const int* list;
    __device__ __forceinline__ void operator()(const f32x4 (&acc)[2][2][4][2], const Unit& u, int wr, int wc, int fr, int fq) const {
        const int col0 = (u.pn & 3) * BM + wc * 32 + 8 * fq, n_e = cnt[u.e * 64];
#pragma unroll
        for (int ai = 0; ai < 2; ++ai)
#pragma unroll
            for (int m = 0; m < 4; ++m) { const int r = ai * HALF + wr * 64 + m * 16 + fr, idx = u.rt * BM + r;
                const int drow = idx < n_e ? list[u.e * NTOK + idx] : 2 * NTOK + r;
                bf16_t* rowp = po + (size_t)drow * DM + col0;
#pragma unroll
                for (int bj = 0; bj < 2; ++bj) { const f32x4 v0 = acc[ai][bj][m][0], v1 = acc[ai][bj][m][1];
                    u32x4 w; w.x = cvt_pk_bf16(v0[0], v0[1]); w.y = cvt_pk_bf16(v0[2], v0[3]); w.z = cvt_pk_bf16(v1[0], v1[1]); w.w = cvt_pk_bf16(v1[2], v1[3]);
                    *(u32x4*)(rowp + bj * HALF) = w; } }
    }
};

template <class Epi, class Sched, bool ALIGN_EPI>
__device__ __forceinline__ void gemm_phase(PG8_LAS unsigned char* lds, const Gemm g, const Sched& S, const Epi& E) {
    const int tid = threadIdx.x, wid = __builtin_amdgcn_readfirstlane(tid >> 6), lane = tid & 63, wr = wid >> 2, wc = wid & 3, fr = lane & 15, fq = lane >> 4;
    const int K = g.K, nt = K / BK;
    int RA[2]; unsigned CA[2], voffB[2];
#pragma unroll
    for (int i = 0; i < 2; ++i) { int R, C; stage_rc(tid * 16 + i * 8192, R, C); const int Rb = Epi::PERM ? ((R & ~31) + perm32(R & 31)) : R;
        RA[i] = R; CA[i] = (unsigned)C * 2u; voffB[i] = (unsigned)(Rb * K + C) * 2u; }
    const size_t kstep = (size_t)(BK * 2);
    const size_t hstep = (size_t)HALF * K * 2;
    const size_t tstep = 2 * hstep;
    const unsigned ldsw = (unsigned)wid * 1024u;
    const int aoff = lds_byte(wr * 64 + fr, fq * 8), boff = lds_byte(wc * 32 + fr, fq * 8);
#define PG8_SA(b, h) (((b) * 2 + (h)) * HTB)
#define PG8_SB(b, h) ((4 + (b) * 2 + (h)) * HTB)
#define PG8_STAGE(bufoff, gbase, voff) do { _Pragma("unroll") for (int _i = 0; _i < 2; ++_i) \
        __builtin_amdgcn_global_load_lds((const unsigned*)((const char*)(gbase) + (voff)[_i]), (PG8_LAS unsigned*)(lds + (bufoff) + ldsw + _i * 8192), 16, 0, 0); } while (0)
#define PG8_LDA(dst, b, h) do { _Pragma("unroll") for (int m = 0; m < 4; ++m) _Pragma("unroll") for (int k = 0; k < 2; ++k) dst[m][k] = *(const PG8_LAS bf16x8*)(lds + PG8_SA(b, h) + aoff + m * 2048 + k * 1024); } while (0)
#define PG8_LDB(dst, b, h) do { _Pragma("unroll") for (int n = 0; n < 2; ++n) _Pragma("unroll") for (int k = 0; k < 2; ++k) dst[n][k] = *(const PG8_LAS bf16x8*)(lds + PG8_SB(b, h) + boff + n * 2048 + k * 1024); } while (0)
#define PG8_MMA(ai, bj, At, Bt) do { __builtin_amdgcn_s_setprio(1); _Pragma("unroll") for (int m = 0; m < 4; ++m) _Pragma("unroll") for (int n = 0; n < 2; ++n) _Pragma("unroll") for (int k = 0; k < 2; ++k) \
        acc[ai][bj][m][n] = __builtin_amdgcn_mfma_f32_16x16x32_bf16(Bt[n][k], At[m][k], acc[ai][bj][m][n], 0, 0, 0); __builtin_amdgcn_s_setprio(0); } while (0)
#define PG8_WAIT_V(n) asm volatile("s_waitcnt vmcnt(" #n ")" ::: "memory")
#define PG8_WAIT_L(n) asm volatile("s_waitcnt lgkmcnt(" #n ")" ::: "memory")
#define PG8_BAR __builtin_amdgcn_s_barrier()
#define PG8_SCHED __builtin_amdgcn_sched_barrier(0)
#define PG8_AOFF(dst, U) do { _Pragma("unroll") for (int _h = 0; _h < 2; ++_h) _Pragma("unroll") for (int _i = 0; _i < 2; ++_i) \
        dst[_h][_i] = (unsigned)S.arow(U, _h * HALF + RA[_i]) * (unsigned)(K * 2) + CA[_i]; } while (0)
    Unit cur, nxt; int ui = 0;
    if (!S.next(0, cur)) return;
    f32x4 acc[2][2][4][2];
#pragma unroll
    for (int a = 0; a < 2; ++a)
#pragma unroll
        for (int b = 0; b < 2; ++b)
#pragma unroll
            for (int m = 0; m < 4; ++m)
#pragma unroll
                for (int n = 0; n < 2; ++n) acc[a][b][m][n] = (f32x4){0.f, 0.f, 0.f, 0.f};
    bf16x8 At[4][2], B0[2][2], B1[2][2];
    unsigned offC[2][2], offN[2][2];
    PG8_AOFF(offC, cur);
    const char* A0 = (const char*)g.A;
    const char* cB = (const char*)g.Bt + (size_t)cur.pn * tstep;
    PG8_STAGE(PG8_SB(0, 0), cB, voffB); PG8_STAGE(PG8_SB(0, 1), cB + hstep, voffB); PG8_STAGE(PG8_SA(0, 0), A0, offC[0]); PG8_STAGE(PG8_SA(0, 1), A0, offC[1]);
    if (wr == 1) PG8_BAR;
    PG8_WAIT_V(2); PG8_BAR;
    PG8_STAGE(PG8_SB(1, 0), cB + kstep, voffB); PG8_STAGE(PG8_SA(1, 0), A0 + kstep, offC[0]); PG8_STAGE(PG8_SB(1, 1), cB + hstep + kstep, voffB);
    PG8_WAIT_V(6); PG8_BAR;
    for (;;) {
        const bool has_next = S.next(ui + 1, nxt);
        if (has_next) PG8_AOFF(offN, nxt);
        const char* nB = has_next ? (const char*)g.Bt + (size_t)nxt.pn * tstep : cB;
#pragma unroll 1
        for (int t = 0; t < nt; t += 2) {
            const bool last = (t == nt - 2);
            const char* a1 = A0 + (size_t)(t + 1) * kstep;
            const char* a2 = last ? A0 : A0 + (size_t)(t + 2) * kstep; const char* b2 = last ? nB : cB + (size_t)(t + 2) * kstep;
            const char* a3 = a2 + kstep; const char* b3 = b2 + kstep;
            PG8_LDB(B0, 0, 0); PG8_LDB(B1, 0, 1); PG8_SCHED; PG8_LDA(At, 0, 0); PG8_STAGE(PG8_SA(1, 1), a1, offC[1]);
            if (last && has_next) {
#pragma unroll
                for (int _h = 0; _h < 2; ++_h)
#pragma unroll
                    for (int _i = 0; _i < 2; ++_i) offC[_h][_i] = offN[_h][_i];
            }
            PG8_WAIT_V(8); PG8_WAIT_L(0); PG8_BAR; PG8_MMA(0, 0, At, B0); PG8_MMA(0, 1, At, B1); PG8_BAR; PG8_SCHED;
            PG8_LDA(At, 0, 1); PG8_STAGE(PG8_SB(0, 0), b2, voffB); PG8_STAGE(PG8_SB(0, 1), b2 + hstep, voffB); PG8_STAGE(PG8_SA(0, 0), a2, offC[0]);
            PG8_WAIT_V(8); PG8_WAIT_L(0); PG8_BAR; PG8_MMA(1, 0, At, B0); PG8_MMA(1, 1, At, B1); PG8_BAR; PG8_SCHED;
            PG8_LDB(B0, 1, 0); PG8_LDB(B1, 1, 1); PG8_SCHED; PG8_LDA(At, 1, 0); PG8_STAGE(PG8_SA(0, 1), a2, offC[1]);
            PG8_WAIT_V(8); PG8_WAIT_L(0); PG8_BAR; PG8_MMA(0, 0, At, B0); PG8_MMA(0, 1, At, B1); PG8_BAR; PG8_SCHED;
            PG8_LDA(At, 1, 1); PG8_STAGE(PG8_SB(1, 0), b3, voffB); PG8_STAGE(PG8_SB(1, 1), b3 + hstep, voffB); PG8_STAGE(PG8_SA(1, 0), a3, offC[0]);
            PG8_WAIT_V(8); PG8_WAIT_L(0); PG8_BAR; PG8_MMA(1, 0, At, B0); PG8_MMA(1, 1, At, B1); PG8_BAR; PG8_SCHED;
        }
        if constexpr (ALIGN_EPI) { if (wr == 0) PG8_BAR; }
        E(acc, cur, wr, wc, fr, fq); S.done(cur);
        if (!has_next) break;
#pragma unroll
        for (int a = 0; a < 2; ++a)
#pragma unroll
            for (int b = 0; b < 2; ++b)
#pragma unroll
                for (int m = 0; m < 4; ++m)
#pragma unroll
                    for (int n = 0; n < 2; ++n) acc[a][b][m][n] = (f32x4){0.f, 0.f, 0.f, 0.f};
        cur = nxt; cB = nB; ++ui;
        if constexpr (ALIGN_EPI) { if (wr == 1) PG8_BAR; }
    }
    PG8_WAIT_V(0);
    if constexpr (!ALIGN_EPI) { if (wr == 0) PG8_BAR; }
    PG8_BAR;
#undef PG8_SA
#undef PG8_SB
#undef PG8_STAGE
#undef PG8_LDA
#undef PG8_LDB
#undef PG8_MMA
#undef PG8_WAIT_V
#undef PG8_WAIT_L
#undef PG8_BAR
#undef PG8_SCHED
#undef PG8_AOFF
}

struct Gemm2 { const bf16_t* A0; const bf16_t* B0; int K0; const bf16_t* A1; const bf16_t* B1; int K1; };
template <class Epi, class Sched, bool ALIGN_EPI>
__device__ __forceinline__ void gemm_phase2(PG8_LAS unsigned char* lds, const Gemm2 g, const Sched& S, const Epi& E) {
    const int tid = threadIdx.x, wid = __builtin_amdgcn_readfirstlane(tid >> 6), lane = tid & 63, wr = wid >> 2, wc = wid & 3, fr = lane & 15, fq = lane >> 4;
    const int nt0 = g.K0 / BK, nt = nt0 + g.K1 / BK;
    unsigned RA2[2], RB2[2], C2[2];
#pragma unroll
    for (int i = 0; i < 2; ++i) { int R, C; stage_rc(tid * 16 + i * 8192, R, C); const int Rb = Epi::PERM ? ((R & ~31) + perm32(R & 31)) : R;
        RA2[i] = (unsigned)R * 2u; RB2[i] = (unsigned)Rb * 2u; C2[i] = (unsigned)C * 2u; }
    const size_t kstep = (size_t)(BK * 2);
    const unsigned ldsw = (unsigned)wid * 1024u;
    const int aoff = lds_byte(wr * 64 + fr, fq * 8), boff = lds_byte(wc * 32 + fr, fq * 8);
#define PG8_SA(b, h) (((b) * 2 + (h)) * HTB)
#define PG8_SB(b, h) ((4 + (b) * 2 + (h)) * HTB)
#define PG8_STAGE(bufoff, gbase, R2, Kb) do { _Pragma("unroll") for (int _i = 0; _i < 2; ++_i) \
        __builtin_amdgcn_global_load_lds((const unsigned*)((const char*)(gbase) + ((R2)[_i] * (unsigned)(Kb) + C2[_i])), (PG8_LAS unsigned*)(lds + (bufoff) + ldsw + _i * 8192), 16, 0, 0); } while (0)
#define PG8_LDA(dst, b, h) do { _Pragma("unroll") for (int m = 0; m < 4; ++m) _Pragma("unroll") for (int k = 0; k < 2; ++k) dst[m][k] = *(const PG8_LAS bf16x8*)(lds + PG8_SA(b, h) + aoff + m * 2048 + k * 1024); } while (0)
#define PG8_LDB(dst, b, h) do { _Pragma("unroll") for (int n = 0; n < 2; ++n) _Pragma("unroll") for (int k = 0; k < 2; ++k) dst[n][k] = *(const PG8_LAS bf16x8*)(lds + PG8_SB(b, h) + boff + n * 2048 + k * 1024); } while (0)
#define PG8_MMA(ai, bj, At, Bt) do { __builtin_amdgcn_s_setprio(1); _Pragma("unroll") for (int m = 0; m < 4; ++m) _Pragma("unroll") for (int n = 0; n < 2; ++n) _Pragma("unroll") for (int k = 0; k < 2; ++k) \
        acc[ai][bj][m][n] = __builtin_amdgcn_mfma_f32_16x16x32_bf16(Bt[n][k], At[m][k], acc[ai][bj][m][n], 0, 0, 0); __builtin_amdgcn_s_setprio(0); } while (0)
#define PG8_WAIT_V(n) asm volatile("s_waitcnt vmcnt(" #n ")" ::: "memory")
#define PG8_WAIT_L(n) asm volatile("s_waitcnt lgkmcnt(" #n ")" ::: "memory")
#define PG8_BAR __builtin_amdgcn_s_barrier()
#define PG8_SCHED __builtin_amdgcn_sched_barrier(0)
#define PG8_APTR(pm_, h, tt) ((tt) < nt0 ? (const char*)g.A0 + ((size_t)((pm_) * BM + (h) * HALF) * g.K0 + (size_t)(tt) * BK) * 2 : (const char*)g.A1 + ((size_t)((pm_) * BM + (h) * HALF) * g.K1 + (size_t)((tt) - nt0) * BK) * 2)
#define PG8_BPTR(pn_, h, tt) ((tt) < nt0 ? (const char*)g.B0 + ((size_t)((pn_) * BM + (h) * HALF) * g.K0 + (size_t)(tt) * BK) * 2 : (const char*)g.B1 + ((size_t)((pn_) * BM + (h) * HALF) * g.K1 + (size_t)((tt) - nt0) * BK) * 2)
    Unit cur, nxt; int ui = 0;
    if (!S.next(0, cur)) return;
    f32x4 acc[2][2][4][2];
#pragma unroll
    for (int a = 0; a < 2; ++a)
#pragma unroll
        for (int b = 0; b < 2; ++b)
#pragma unroll
            for (int m = 0; m < 4; ++m)
#pragma unroll
                for (int n = 0; n < 2; ++n) acc[a][b][m][n] = (f32x4){0.f, 0.f, 0.f, 0.f};
    bf16x8 At[4][2], B0[2][2], B1[2][2];
    PG8_STAGE(PG8_SB(0, 0), PG8_BPTR(cur.pn, 0, 0), RB2, g.K0); PG8_STAGE(PG8_SB(0, 1), PG8_BPTR(cur.pn, 1, 0), RB2, g.K0); PG8_STAGE(PG8_SA(0, 0), PG8_APTR(cur.pm, 0, 0), RA2, g.K0); PG8_STAGE(PG8_SA(0, 1), PG8_APTR(cur.pm, 1, 0), RA2, g.K0);
    if (wr == 1) PG8_BAR;
    PG8_WAIT_V(2); PG8_BAR;
    PG8_STAGE(PG8_SB(1, 0), PG8_BPTR(cur.pn, 0, 1), RB2, g.K0); PG8_STAGE(PG8_SA(1, 0), PG8_APTR(cur.pm, 0, 1), RA2, g.K0); PG8_STAGE(PG8_SB(1, 1), PG8_BPTR(cur.pn, 1, 1), RB2, g.K0);
    PG8_WAIT_V(6); PG8_BAR;
    for (;;) {
        const bool has_next = S.next(ui + 1, nxt);
#pragma unroll 1
        for (int t = 0; t < nt; t += 2) {
            const bool last = (t == nt - 2);
            if (t == nt0) E.mid(acc, cur, wr, wc, fr, fq);
            const bool s1 = t >= nt0;
            const int t2 = last ? 0 : t + 2; const bool s2 = t2 >= nt0;
            const int pm2 = (last && has_next) ? nxt.pm : cur.pm, pn2 = (last && has_next) ? nxt.pn : cur.pn;
            const int Ks1 = s1 ? g.K1 : g.K0, Ks2 = s2 ? g.K1 : g.K0;
            const char* a1h1 = PG8_APTR(cur.pm, 1, t + 1);
            const char* a2h0 = PG8_APTR(pm2, 0, t2); const char* a2h1 = PG8_APTR(pm2, 1, t2);
            const char* b2h0 = PG8_BPTR(pn2, 0, t2); const char* b2h1 = PG8_BPTR(pn2, 1, t2);
            PG8_LDB(B0, 0, 0); PG8_LDB(B1, 0, 1); PG8_SCHED; PG8_LDA(At, 0, 0); PG8_STAGE(PG8_SA(1, 1), a1h1, RA2, Ks1);
            PG8_WAIT_V(8); PG8_WAIT_L(0); PG8_BAR; PG8_MMA(0, 0, At, B0); PG8_MMA(0, 1, At, B1); PG8_BAR; PG8_SCHED;
            PG8_LDA(At, 0, 1); PG8_STAGE(PG8_SB(0, 0), b2h0, RB2, Ks2); PG8_STAGE(PG8_SB(0, 1), b2h1, RB2, Ks2); PG8_STAGE(PG8_SA(0, 0), a2h0, RA2, Ks2);
            PG8_WAIT_V(8); PG8_WAIT_L(0); PG8_BAR; PG8_MMA(1, 0, At, B0); PG8_MMA(1, 1, At, B1); PG8_BAR; PG8_SCHED;
            PG8_LDB(B0, 1, 0); PG8_LDB(B1, 1, 1); PG8_SCHED; PG8_LDA(At, 1, 0); PG8_STAGE(PG8_SA(0, 1), a2h1, RA2, Ks2);
            PG8_WAIT_V(8); PG8_WAIT_L(0); PG8_BAR; PG8_MMA(0, 0, At, B0); PG8_MMA(0, 1, At, B1); PG8_BAR; PG8_SCHED;
            PG8_LDA(At, 1, 1); PG8_STAGE(PG8_SB(1, 0), b2h0 + kstep, RB2, Ks2); PG8_STAGE(PG8_SB(1, 1), b2h1 + kstep, RB2, Ks2); PG8_STAGE(PG8_SA(1, 0), a2h0 + kstep, RA2, Ks2);
            PG8_WAIT_V(8); PG8_WAIT_L(0); PG8_BAR; PG8_MMA(1, 0, At, B0); PG8_MMA(1, 1, At, B1); PG8_BAR; PG8_SCHED;
        }
        if constexpr (ALIGN_EPI) { if (wr == 0) PG8_BAR; }
        E(acc, cur, wr, wc, fr, fq);
        if (!has_next) break;
#pragma unroll
        for (int a = 0; a < 2; ++a)
#pragma unroll
            for (int b = 0; b < 2; ++b)
#pragma unroll
                for (int m = 0; m < 4; ++m)
#pragma unroll
                    for (int n = 0; n < 2; ++n) acc[a][b][m][n] = (f32x4){0.f, 0.f, 0.f, 0.f};
        cur = nxt; ++ui;
        if constexpr (ALIGN_EPI) { if (wr == 1) PG8_BAR; }
    }
    PG8_WAIT_V(0);
    if constexpr (!ALIGN_EPI) { if (wr == 0) PG8_BAR; }
    PG8_BAR;
#undef PG8_SA
#undef PG8_SB
#undef PG8_STAGE
#undef PG8_LDA
#undef PG8_LDB
#undef PG8_MMA
#undef PG8_WAIT_V
#undef PG8_WAIT_L
#undef PG8_BAR
#undef PG8_SCHED
#undef PG8_APTR
#undef PG8_BPTR
}
}

constexpr int NWAVES = 8;
constexpr int RING_OFF = 0, RING_BYTES = 131072;
constexpr int ATTN_LDS = 147456;
constexpr int BIAS_OFF = ATTN_LDS;
constexpr int LDSCTL_OFF = BIAS_OFF + 3 * 4 * 192 * 4;
constexpr int MISC_OFF = LDSCTL_OFF, TILE_E_OFF = LDSCTL_OFF + 256, FIRST_OFF = TILE_E_OFF + 320 * 4;
constexpr int LDS_BYTES = 163840;
static_assert(FIRST_OFF + 64 * 4 <= LDS_BYTES, "LDS map");
constexpr size_t WS_XB = WS_X1B;
constexpr size_t WT_WIN = WS_WT;
constexpr size_t WT_WPA = WT_WIN + (size_t)INW * DM * 2;
constexpr size_t WT_WEFF = WT_WPA + (size_t)DM * AOW * 2;
constexpr size_t WT_WOUT = WT_WEFF + (size_t)DM * POOLW * 2;
constexpr size_t WT_WGU = WT_WOUT + (size_t)DM * DM * 2;
constexpr size_t WT_WD = WT_WGU + (size_t)NEXP * 512 * DM * 2;
static_assert(WT_WD + (size_t)NEXP * DM * DEXP * 2 <= WS_CTL, "weights fit");
constexpr int CW_CNT = 0;
constexpr int CW_BAR = 4096;
constexpr int CW_READY = 8192;
constexpr int CW_Q9 = 30720, CW_TMO = 30784;
constexpr size_t CTL_ZERO_BYTES = 262144;

#define GAS __attribute__((address_space(1)))
#define LAS __attribute__((address_space(3)))
typedef GAS unsigned gu32;
#define RLX_AGENT __ATOMIC_RELAXED, __HIP_MEMORY_SCOPE_AGENT
#define LDS_WAIT() asm volatile("s_waitcnt lgkmcnt(0)" ::: "memory")
#define VM_WAIT() asm volatile("s_waitcnt vmcnt(0)" ::: "memory")
typedef unsigned v4u __attribute__((ext_vector_type(4)));
__device__ __forceinline__ unsigned pk2(float lo, float hi) { return (unsigned)f2bf(lo) | ((unsigned)f2bf(hi) << 16); }

#define XB_TMO      128
#define XB_XCNT(j)  (256  + 64 * (j))
#define XB_XSUB(j)  (1280 + 64 * (j))
#define XB_XGEN(j)  (2304 + 64 * (j))
#define XB_TOP      3328
#define XB_TOPGEN   3392
#define XCD_BAR_WORDS 3456
#define XB_SPIN_CAP (1u << 18)

__device__ __forceinline__ unsigned xb_ld(unsigned* p)              { return __hip_atomic_load(p, __ATOMIC_RELAXED, __HIP_MEMORY_SCOPE_AGENT); }
__device__ __forceinline__ unsigned xb_add(unsigned* p, unsigned v) { return __hip_atomic_fetch_add(p, v, __ATOMIC_RELAXED, __HIP_MEMORY_SCOPE_AGENT); }
__device__ __forceinline__ unsigned xb_xcc_id() { return (unsigned)__builtin_amdgcn_s_getreg((3 << 11) | 20) & 0xFu; }
#define XB_SPIN(cond, bar) do { unsigned _sp = 0; while (cond) { __builtin_amdgcn_s_sleep(1); \
    if ((++_sp & 255u) == 0u) { if (xb_ld(&(bar)[XB_TMO])) break; if (_sp > XB_SPIN_CAP) { atomicAdd(&(bar)[XB_TMO], 1u); break; } } } } while (0)

struct XcdBarrier {
    unsigned* bar; unsigned x;
    volatile LAS unsigned* st;
};

__device__ __forceinline__ XcdBarrier xcd_barrier_post(unsigned* bar, volatile LAS unsigned* st) {
    XcdBarrier b; b.bar = bar; b.x = xb_xcc_id(); b.st = st;
    if (threadIdx.x == 0) (void)xb_add(&bar[XB_XCNT(b.x)], 1u);
    return b;
}
__device__ __forceinline__ void xcd_barrier_complete(unsigned* bar, unsigned x, unsigned& nloc, unsigned& nx) {
    const unsigned G = gridDim.x * gridDim.y * gridDim.z;
    unsigned sum, cnt, mine, sp = 0u;
    for (;;) {
        sum = 0u; cnt = 0u; mine = 0u;
#pragma unroll
        for (unsigned j = 0; j < 16; ++j) { const unsigned c = xb_ld(&bar[XB_XCNT(j)]); sum += c; cnt += (c > 0u) ? 1u : 0u; mine = (j == x) ? c : mine; }
        if (sum == G) break;
        __builtin_amdgcn_s_sleep(1);
        if ((++sp & 255u) == 0u) { if (xb_ld(&bar[XB_TMO])) break; if (sp > XB_SPIN_CAP) { atomicAdd(&bar[XB_TMO], 1u); break; } }
    }
    nloc = mine > 0u ? mine : 1u; nx = cnt > 0u ? cnt : 1u;
}

__device__ __forceinline__ void xcd_barrier(const XcdBarrier& b) {
    asm volatile("s_waitcnt vmcnt(0)" ::: "memory");
    __syncthreads();
    if (threadIdx.x == 0) {
        unsigned* bar = b.bar;
        __builtin_amdgcn_s_waitcnt(0);
        unsigned nloc = b.st[0], nx = b.st[1];
        if (nloc == 0u) { xcd_barrier_complete(bar, b.x, nloc, nx); b.st[0] = nloc; b.st[1] = nx; }
        const unsigned old = xb_add(&bar[XB_XSUB(b.x)], 1u);
        const unsigned gen = old / nloc;
        if (old + 1u == (gen + 1u) * nloc) {
            __builtin_amdgcn_fence(__ATOMIC_RELEASE, "agent");
            asm volatile("s_waitcnt vmcnt(0)" ::: "memory");
            const unsigned og = xb_add(&bar[XB_TOP], 1u);
            const unsigned tg = og / nx;
            if (og + 1u == (tg + 1u) * nx) xb_add(&bar[XB_TOPGEN], 1u);
            else XB_SPIN(xb_ld(&bar[XB_TOPGEN]) == tg, bar);
            __builtin_amdgcn_fence(__ATOMIC_ACQUIRE, "agent");
            xb_add(&bar[XB_XGEN(b.x)], 1u);
            asm volatile("s_waitcnt vmcnt(0)" ::: "memory");
        } else {
            XB_SPIN(xb_ld(&bar[XB_XGEN(b.x)]) == gen, bar);
            __builtin_amdgcn_fence(__ATOMIC_ACQUIRE, "agent");
            asm volatile("s_waitcnt vmcnt(0)" ::: "memory");
        }
    }
    __syncthreads();
}


struct Frame {
    LAS unsigned char* lds;
    int tid, lane, wave, vcu, G;
};
struct MArgs { const float* in[20]; float* out; unsigned char* ws; int ph_lo, ph_hi; };

struct TrItem { const float* W; bf16_t* WT; int K, N, k0, n0, drow0; };
__device__ __forceinline__ void tr_load(const TrItem& t, float (&v)[32], int lane) {
#pragma unroll
    for (int i = 0; i < 32; ++i) v[i] = t.W[(size_t)(t.k0 + 2 * i + (lane >> 5)) * t.N + t.n0 + (lane & 31)];
}
__device__ __forceinline__ void tr_store(const TrItem& t, const float (&v)[32], LAS float* scr, int lane) {
#pragma unroll
    for (int i = 0; i < 32; ++i) scr[(2 * i + (lane >> 5)) * 33 + (lane & 31)] = v[i];
    LDS_WAIT(); asm volatile("" ::: "memory");
    const int c = lane & 7;
#pragma unroll
    for (int j = 0; j < 4; ++j) { const int n = (lane >> 3) + 8 * j; const LAS float* s = scr + (8 * c) * 33 + n;
        v4u o; o.x = pk2(s[0 * 33], s[1 * 33]); o.y = pk2(s[2 * 33], s[3 * 33]); o.z = pk2(s[4 * 33], s[5 * 33]); o.w = pk2(s[6 * 33], s[7 * 33]);
        *(GAS v4u*)(t.WT + (size_t)(t.drow0 + n) * t.K + t.k0 + 8 * c) = o; }
    LDS_WAIT(); asm volatile("" ::: "memory");
}
constexpr int TR_IN = (DM / 64) * (INW / 32), TR_PA = (AOW / 64) * (DM / 32), TR_OUT = (DM / 64) * (DM / 32), TR_G = (DM / 64) * (DEXP / 32), TR_D = (DEXP / 64) * (DM / 32);
constexpr int TR_DENSE = TR_IN + TR_PA + TR_OUT, TR_EXP = NEXP * (2 * TR_G + TR_D);
__device__ __forceinline__ TrItem tr_item(const MArgs& a, int it) {
    unsigned char* ws = a.ws; TrItem t; int r = it;
    if (r < TR_IN) { const int nb = INW / 32; t.W = a.in[1]; t.WT = (bf16_t*)(ws + WT_WIN); t.K = DM; t.N = INW; t.k0 = (r / nb) * 64; t.n0 = (r % nb) * 32;
        t.drow0 = t.n0 < GA_OFF ? t.n0 : (t.n0 < GB_OFF ? GA_OFF + ((t.n0 - GA_OFF) >> 7) * 256 + ((t.n0 - GA_OFF) & 127) : GA_OFF + ((t.n0 - GB_OFF) >> 7) * 256 + 128 + ((t.n0 - GB_OFF) & 127)); return t; } r -= TR_IN;
    if (r < TR_PA) { const int nb = DM / 32; t.W = a.in[6]; t.WT = (bf16_t*)(ws + WT_WPA); t.K = AOW; t.N = DM; t.k0 = (r / nb) * 64; t.n0 = (r % nb) * 32; t.drow0 = t.n0; return t; } r -= TR_PA;
    if (r < TR_OUT) { const int nb = DM / 32; t.W = a.in[8]; t.WT = (bf16_t*)(ws + WT_WOUT); t.K = DM; t.N = DM; t.k0 = (r / nb) * 64; t.n0 = (r % nb) * 32; t.drow0 = t.n0; return t; } r -= TR_OUT;
    const int e = r / (2 * TR_G + TR_D); r -= e * (2 * TR_G + TR_D);
    if (r < 2 * TR_G) { const int up = r >= TR_G; if (up) r -= TR_G; const int nb = DEXP / 32; t.W = (up ? a.in[16] : a.in[15]) + (size_t)e * DM * DEXP; t.WT = (bf16_t*)(ws + WT_WGU); t.K = DM; t.N = DEXP;
        t.k0 = (r / nb) * 64; t.n0 = (r % nb) * 32; t.drow0 = e * 512 + (t.n0 >> 7) * 256 + up * 128 + (t.n0 & 127); return t; }
    r -= 2 * TR_G;
    { const int nb = DM / 32; t.W = a.in[17] + (size_t)e * DEXP * DM; t.WT = (bf16_t*)(ws + WT_WD) + (size_t)e * DM * DEXP; t.K = DEXP; t.N = DM; t.k0 = (r / nb) * 64; t.n0 = (r % nb) * 32; t.drow0 = t.n0; return t; }
}
__device__ __forceinline__ void tr_run(Frame& F, const MArgs& a, int first, int stride, int end) {
    LAS float* scr = (LAS float*)(F.lds + RING_OFF + F.wave * 16384);
    if (first >= end) return;
    float vn[32]; TrItem tn = tr_item(a, first); tr_load(tn, vn, F.lane);
    for (int it = first; it < end; it += stride) {
        float v[32]; TrItem t = tn;
#pragma unroll
        for (int i = 0; i < 32; ++i) v[i] = vn[i];
        if (it + stride < end) { tn = tr_item(a, it + stride); tr_load(tn, vn, F.lane); }
        tr_store(t, v, scr, F.lane);
    }
}
__device__ __forceinline__ void p0_prologue(Frame& F, const MArgs& a) {
    unsigned char* ws = a.ws;
    const int gw = F.vcu * NWAVES + F.wave, NGW = F.G * NWAVES, lane = F.lane;
    const float* w_pool = a.in[4]; const float* pscale = a.in[5]; const float* w_pp = a.in[7];
    bf16_t* WeffT = (bf16_t*)(ws + WT_WEFF);
    tr_run(F, a, gw, NGW, TR_DENSE);
    for (int it = gw; it < (DM / 32) * (POOLW / 32); it += NGW) {
        const int nb = it >> 4, kb = it & 15, g = kb >> 2, n0 = nb * 32, c0 = (kb & 3) * 32, rr = lane & 31, kk = lane >> 5;
        typedef float f32x16 __attribute__((ext_vector_type(16)));
        f32x16 acc = {0.f, 0.f, 0.f, 0.f, 0.f, 0.f, 0.f, 0.f, 0.f, 0.f, 0.f, 0.f, 0.f, 0.f, 0.f, 0.f};
        const float* ap = w_pp + (size_t)(g * 128 + kk) * DM + n0 + rr;
        const float* sp = pscale + g * 128 + kk;
        const float* bp = w_pool + (size_t)(g * 128 + c0 + rr) * 128 + kk;
#pragma unroll 16
        for (int ks = 0; ks < 64; ++ks) { const float av = ap[(size_t)(2 * ks) * DM] * sp[2 * ks], bv = bp[2 * ks];
            acc = __builtin_amdgcn_mfma_f32_32x32x2f32(av, bv, acc, 0, 0, 0); }
#pragma unroll
        for (int i = 0; i < 16; ++i) { const int n = n0 + (i & 3) + 8 * (i >> 2) + 4 * kk;
            WeffT[(size_t)n * POOLW + g * 128 + c0 + rr] = f2bf(acc[i]); }
    }
    const float* x = a.in[0]; bf16_t* XB = (bf16_t*)(ws + WS_XB);
    for (int it = gw * 8; it < NTOK * DM / 512; it += NGW * 8) {
        f32x4 a0[8], a1[8];
#pragma unroll
        for (int u = 0; u < 8; ++u) { const size_t o = (size_t)(it + u) * 512 + lane * 8; a0[u] = *(const f32x4*)(x + o); a1[u] = *(const f32x4*)(x + o + 4); }
#pragma unroll
        for (int u = 0; u < 8; ++u) { const size_t o = (size_t)(it + u) * 512 + lane * 8;
            v4u w; w.x = pk2(a0[u][0], a0[u][1]); w.y = pk2(a0[u][2], a0[u][3]); w.z = pk2(a1[u][0], a1[u][1]); w.w = pk2(a1[u][2], a1[u][3]);
            *(GAS v4u*)(XB + o) = w; } }
}

__device__ __forceinline__ int moe_tables(Frame& F, const int* cnt) {
    LAS int* tile_e = (LAS int*)(F.lds + TILE_E_OFF); LAS int* first = (LAS int*)(F.lds + FIRST_OFF);
    __syncthreads();
    if (F.tid < 64) {
        const int e = F.tid, nt = (e < NEXP) ? ((__hip_atomic_load(cnt + (e & 31) * 64, RLX_AGENT) + 255) >> 8) : 0;
        int incl = nt;
#pragma unroll
        for (int o = 1; o < 32; o <<= 1) { const int t = __shfl_up(incl, o); if ((e & 31) >= o) incl += t; }
        const int f0 = incl - nt;
        if (e < NEXP) { first[e] = f0; for (int i = 0; i < nt; ++i) tile_e[f0 + i] = e; if (e == NEXP - 1) first[NEXP] = incl; }
    }
    __syncthreads();
    return first[NEXP];
}


typedef float f32x16 __attribute__((ext_vector_type(16)));
typedef short s16x4 __attribute__((ext_vector_type(4)));
constexpr float LOG2E = 1.4426950408889634f;
constexpr float QSCALE = 0.125f * LOG2E;
constexpr int VROW = 192;
__device__ __forceinline__ s16x4 vtr(const LAS unsigned char* p) { return __builtin_bit_cast(s16x4, __builtin_amdgcn_ds_read_tr16_b64_v4i16((LAS s16x4*)p)); }
constexpr int AT_K = 0, AT_V0 = 49152, AT_V1 = 98304;
__device__ __forceinline__ void attn_unit_decode(int un, int& b, int& h, int& g, int& dil, int& L, int& c0, int& l0) {
    const int j = un & 7, bh = un >> 3; h = bh % 12; b = bh / 12; g = h >> 2; dil = 1 << (2 * g); L = SEQ >> (2 * g);
    if (g == 0) { c0 = 0; l0 = 256 * j; } else if (g == 1) { c0 = j >> 1; l0 = 256 * (j & 1); } else { c0 = 2 * j; l0 = 0; }
}
__device__ __forceinline__ size_t attn_krow(int b, int g, int L, int c0, int l0, int wr_) {
    if (g == 2) { const int cls = c0 + ((wr_ >> 7) & 1), l = wr_ & 127; return (size_t)b * SEQ + (size_t)cls * L + l; }
    int l = l0 - 128 + wr_; l = l < 0 ? 0 : l; return (size_t)b * SEQ + (size_t)c0 * L + l;
}
__device__ __forceinline__ void attn_wave_q(int g, int c0, int l0, int w, int& cq, int& lq0) { cq = (g == 2) ? c0 + (w >> 2) : c0; lq0 = (g == 2) ? 32 * (w & 3) : l0 + 32 * w; }
__device__ __forceinline__ void phase_attn(Frame& F, const MArgs& a, const bf16_t* proj, bf16_t* aog, float* lse) {
    LAS float* bias2 = (LAS float*)(F.lds + BIAS_OFF);
    const float* rel_bias = a.in[3];
    int tid0 = F.tid; asm volatile("" : "+v"(tid0));
    for (int i = tid0; i < 3 * 4 * 192; i += NWAVES * 64) { const int gs = i / 192, j = i - gs * 192 - 32, g = gs >> 2, dil = 1 << (2 * g);
        bias2[i] = (j >= 0 && j <= 128) ? rel_bias[t5_bucket(j * dil) * 12 + gs] * LOG2E : -1.0e30f; }
    asm volatile("s_waitcnt vmcnt(0) lgkmcnt(0)" ::: "memory"); __builtin_amdgcn_s_barrier(); asm volatile("" ::: "memory");
    LAS unsigned char* ring = F.lds;
    const unsigned lds0 = (unsigned)(size_t)F.lds;
    const int lane = F.lane, w = F.wave, r = lane & 31, hh = lane >> 5;
    const int NU = BATCH * 12 * 8;
    const int drow = lane >> 3, schunk = (lane & 7) ^ (lane >> 3);
    int koff[4];
#pragma unroll
    for (int ks = 0; ks < 4; ++ks) koff[ks] = r * 128 + ((((2 * ks + hh) ^ (r & 7))) << 4);
    const int trow = 4 * hh + ((lane & 15) >> 2);
    int toff[2];
#pragma unroll
    for (int dt = 0; dt < 2; ++dt) toff[dt] = trow * 128 + (((4 * dt + 2 * ((lane >> 4) & 1) + ((lane & 3) >> 1)) ^ (trow & 7)) << 4) + (lane & 1) * 8;
#define AT_DMA(dst_off, col_off) do { _Pragma("unroll") for (int _p = 0; _p < 6; ++_p) { const int _pc = w + 8 * _p; \
        const bf16_t* _src = proj + attn_krow(b_, g_, L_, c0_, l0_, _pc * 8 + drow) * INW + (col_off) + h_ * HD + schunk * 8; \
        unsigned _keep; const unsigned _dst = (unsigned)__builtin_amdgcn_readfirstlane((int)(lds0 + (unsigned)(dst_off) + (unsigned)_pc * 1024u)); \
        asm volatile("s_mov_b32 %0, m0\n\ts_mov_b32 m0, %2\n\ts_nop 0\n\tglobal_load_lds_dwordx4 %1, off\n\ts_mov_b32 m0, %0" : "=&s"(_keep) : "v"(_src), "s"(_dst) : "memory"); } } while (0)
#define AT_QLOAD(dst) do { int cq_, lq_; attn_wave_q(g_, c0_, l0_, w, cq_, lq_); const bf16_t* _qp = proj + ((size_t)b_ * SEQ + (size_t)cq_ * L_ + lq_ + r) * INW + Q_OFF + h_ * HD + 8 * hh; \
        _Pragma("unroll") for (int ks = 0; ks < 4; ++ks) dst[ks] = *(const bf16x8*)(_qp + 16 * ks); } while (0)
    bf16x8 qn[4];
    int un = F.vcu;
    { int b_, h_, g_, dil_, L_, c0_, l0_; attn_unit_decode(un, b_, h_, g_, dil_, L_, c0_, l0_); (void)dil_;
      AT_QLOAD(qn); AT_DMA(AT_K, K_OFF); AT_DMA(AT_V0, V_OFF); }
    bool first = true;
    for (int par = 0; un < NU; un += F.G, par ^= 1) {
        int b, h, g, dil, L, c0, l0; attn_unit_decode(un, b, h, g, dil, L, c0, l0);
        const bool has_next = (un + F.G) < NU;
        int cq, lq0; attn_wave_q(g, c0, l0, w, cq, lq0);
        const int wbase = (g == 2) ? 128 * (w >> 2) + 32 * (w & 3) - 128 : 32 * w;
        bf16x8 qf[4];
#pragma unroll
        for (int ks = 0; ks < 4; ++ks) qf[ks] = qn[ks];
        if (first) asm volatile("s_waitcnt vmcnt(0)" ::: "memory"); else asm volatile("s_waitcnt vmcnt(9)" ::: "memory");
        first = false;
        __builtin_amdgcn_s_barrier(); asm volatile("" ::: "memory");
        if (has_next) { int b_, h_, g_, dil_, L_, c0_, l0_; attn_unit_decode(un + F.G, b_, h_, g_, dil_, L_, c0_, l0_); (void)dil_;
            AT_QLOAD(qn); if (par == 0) AT_DMA(AT_V1, V_OFF); else AT_DMA(AT_V0, V_OFF); }
        f32x16 st[5];
#pragma unroll
        for (int kt = 0; kt < 5; ++kt) {
            int wrow = wbase + 32 * kt; if (g == 2) { const int lo_ = 128 * (w >> 2); wrow = wrow < lo_ ? lo_ : wrow; }
            f32x16 acc = {0.f, 0.f, 0.f, 0.f, 0.f, 0.f, 0.f, 0.f, 0.f, 0.f, 0.f, 0.f, 0.f, 0.f, 0.f, 0.f};
#pragma unroll
            for (int ks = 0; ks < 4; ++ks) { const bf16x8 kf = *(const LAS bf16x8*)(ring + AT_K + wrow * 128 + koff[ks]);
                acc = __builtin_amdgcn_mfma_f32_32x32x16_bf16(kf, qf[ks], acc, 0, 0, 0); }
            st[kt] = acc;
        }
        asm volatile("s_waitcnt lgkmcnt(0)" ::: "memory"); __builtin_amdgcn_s_barrier(); asm volatile("" ::: "memory");
        if (has_next) { int b_, h_, g_, dil_, L_, c0_, l0_; attn_unit_decode(un + F.G, b_, h_, g_, dil_, L_, c0_, l0_); (void)dil_; AT_DMA(AT_K, K_OFF); }
        const LAS float* bt = bias2 + h * 192 + 32 + 128 + (r - 4 * hh);
        float mx = -1.0e30f;
        if (lq0 >= 128) {
#pragma unroll
            for (int kt = 0; kt < 5; ++kt)
#pragma unroll
                for (int hb = 0; hb < 2; ++hb) { float bvv[8];
#pragma unroll
                    for (int i = 0; i < 8; ++i) bvv[i] = bt[-32 * kt - ((i & 3) + 8 * (2 * hb + (i >> 2)))];
                    asm volatile("" : "+v"(bvv[0]), "+v"(bvv[1]), "+v"(bvv[2]), "+v"(bvv[3]), "+v"(bvv[4]), "+v"(bvv[5]), "+v"(bvv[6]), "+v"(bvv[7]));
#pragma unroll
                    for (int i = 0; i < 8; ++i) { const float sv = st[kt][8 * hb + i] + bvv[i]; st[kt][8 * hb + i] = sv; mx = fmaxf(mx, sv); } }
        } else {
            const int jmax = lq0 + r, jl = 128 + r - 4 * hh;
#pragma unroll
            for (int kt = 0; kt < 5; ++kt)
#pragma unroll
                for (int hb = 0; hb < 2; ++hb) { float bvv[8];
#pragma unroll
                    for (int i = 0; i < 8; ++i) bvv[i] = bt[-32 * kt - ((i & 3) + 8 * (2 * hb + (i >> 2)))];
                    asm volatile("" : "+v"(bvv[0]), "+v"(bvv[1]), "+v"(bvv[2]), "+v"(bvv[3]), "+v"(bvv[4]), "+v"(bvv[5]), "+v"(bvv[6]), "+v"(bvv[7]));
#pragma unroll
                    for (int i = 0; i < 8; ++i) { const int jc = -32 * kt - ((i & 3) + 8 * (2 * hb + (i >> 2)));
                        const float sv = (jl + jc <= jmax) ? st[kt][8 * hb + i] + bvv[i] : -1.0e30f; st[kt][8 * hb + i] = sv; mx = fmaxf(mx, sv); } }
        }
        mx = fmaxf(mx, __shfl_xor(mx, 32));
        float lsum = 0.f;
#pragma unroll
        for (int kt = 0; kt < 5; ++kt)
#pragma unroll
            for (int i = 0; i < 16; ++i) { const float pv = __builtin_amdgcn_exp2f(st[kt][i] - mx); st[kt][i] = pv; lsum += pv; }
        lsum += __shfl_xor(lsum, 32);
        f32x16 o0 = {0.f, 0.f, 0.f, 0.f, 0.f, 0.f, 0.f, 0.f, 0.f, 0.f, 0.f, 0.f, 0.f, 0.f, 0.f, 0.f}, o1 = o0;
        const int vbuf = par ? AT_V1 : AT_V0;
#pragma unroll
        for (int kt = 0; kt < 5; ++kt) {
            int wrow = wbase + 32 * kt; if (g == 2) { const int lo_ = 128 * (w >> 2); wrow = wrow < lo_ ? lo_ : wrow; }
            const LAS unsigned char* vb = ring + vbuf + wrow * 128;
#pragma unroll
            for (int s2 = 0; s2 < 2; ++s2) {
                pg8::u32x4 pw; pw.x = pg8::cvt_pk_bf16(st[kt][8 * s2 + 0], st[kt][8 * s2 + 1]); pw.y = pg8::cvt_pk_bf16(st[kt][8 * s2 + 2], st[kt][8 * s2 + 3]);
                pw.z = pg8::cvt_pk_bf16(st[kt][8 * s2 + 4], st[kt][8 * s2 + 5]); pw.w = pg8::cvt_pk_bf16(st[kt][8 * s2 + 6], st[kt][8 * s2 + 7]);
                const bf16x8 pf = __builtin_bit_cast(bf16x8, pw);
#pragma unroll
                for (int dt = 0; dt < 2; ++dt) {
                    const s16x4 lo = vtr(vb + (16 * s2) * 128 + toff[dt]), hi = vtr(vb + (16 * s2 + 8) * 128 + toff[dt]);
                    const bf16x8 vf = {lo[0], lo[1], lo[2], lo[3], hi[0], hi[1], hi[2], hi[3]};
                    if (dt == 0) o0 = __builtin_amdgcn_mfma_f32_32x32x16_bf16(vf, pf, o0, 0, 0, 0); else o1 = __builtin_amdgcn_mfma_f32_32x32x16_bf16(vf, pf, o1, 0, 0, 0);
                }
            }
        }
        const float inv = 1.f / lsum;
        const int tok = b * SEQ + cq + dil * (lq0 + r);
        bf16_t* op = aog + ((size_t)g * NTOK + tok) * AOW + (h & 3) * HD + 4 * hh;
#pragma unroll
        for (int dt = 0; dt < 2; ++dt)
#pragma unroll
            for (int q4 = 0; q4 < 4; ++q4) { const f32x16& o = dt == 0 ? o0 : o1;
                pg8::u32x2 wv; wv.x = pg8::cvt_pk_bf16(o[4 * q4] * inv, o[4 * q4 + 1] * inv); wv.y = pg8::cvt_pk_bf16(o[4 * q4 + 2] * inv, o[4 * q4 + 3] * inv);
                *(pg8::u32x2*)(op + 32 * dt + 8 * q4) = wv; }
        if (hh == 0) lse[((size_t)g * NTOK + tok) * 4 + (h & 3)] = mx + __builtin_amdgcn_logf(lsum);
        asm volatile("s_waitcnt lgkmcnt(0)" ::: "memory");
    }
    asm volatile("s_waitcnt vmcnt(0) lgkmcnt(0)" ::: "memory"); __builtin_amdgcn_s_barrier(); asm volatile("" ::: "memory");
#undef AT_DMA
#undef AT_QLOAD
}
template <int W, int NI> __device__ __forceinline__ void pool_items(const bf16_t* proj, bf16_t* diff, int tok0, int ch) {
    pg8::u32x4 v[NI][W];
#pragma unroll
    for (int u = 0; u < NI; ++u) { const int tok = tok0 + 8 * u, t = tok & (SEQ - 1); const bf16_t* p = proj + (size_t)tok * INW + POOL_OFF + ch * 8;
#pragma unroll
        for (int j = 0; j < W; ++j) v[u][j] = *(const pg8::u32x4*)(p - (size_t)((t >= j) ? j : 0) * INW); }
#pragma unroll
    for (int u = 0; u < NI; ++u) { const int tok = tok0 + 8 * u, t = tok & (SEQ - 1);
        float s[8];
#pragma unroll
        for (int e = 0; e < 8; ++e) s[e] = 0.f;
#pragma unroll
        for (int j = 0; j < W; ++j) { const float m = (t >= j) ? 1.f : 0.f;
            s[0] += m * pg8::bflo(v[u][j].x); s[1] += m * pg8::bfhi(v[u][j].x); s[2] += m * pg8::bflo(v[u][j].y); s[3] += m * pg8::bfhi(v[u][j].y);
            s[4] += m * pg8::bflo(v[u][j].z); s[5] += m * pg8::bfhi(v[u][j].z); s[6] += m * pg8::bflo(v[u][j].w); s[7] += m * pg8::bfhi(v[u][j].w); }
        const float ic = 1.f / (float)((t + 1 < W) ? t + 1 : W);
        pg8::u32x4 o;
        o.x = pg8::cvt_pk_bf16(s[0] * ic - pg8::bflo(v[u][0].x), s[1] * ic - pg8::bfhi(v[u][0].x)); o.y = pg8::cvt_pk_bf16(s[2] * ic - pg8::bflo(v[u][0].y), s[3] * ic - pg8::bfhi(v[u][0].y));
        o.z = pg8::cvt_pk_bf16(s[4] * ic - pg8::bflo(v[u][0].z), s[5] * ic - pg8::bfhi(v[u][0].z)); o.w = pg8::cvt_pk_bf16(s[6] * ic - pg8::bflo(v[u][0].w), s[7] * ic - pg8::bfhi(v[u][0].w));
        *(pg8::u32x4*)(diff + (size_t)tok * POOLW + ch * 8) = o; }
}
__device__ __forceinline__ void phase_pool(Frame& F, const bf16_t* proj, bf16_t* diff) {
    const int gw = F.vcu * NWAVES + F.wave, NGW = F.G * NWAVES, lane = F.lane;
    for (int it = gw; it < NTOK / 4; it += NGW) {
        const int tg = it >> 3, cg = ((it & 7) + 2 * (it / NGW)) & 7, tok0 = tg * 32 + (lane >> 3), ch = cg * 8 + (lane & 7), gi = cg >> 1;
        if (gi == 0) pool_items<2, 4>(proj, diff, tok0, ch); else if (gi == 1) pool_items<4, 4>(proj, diff, tok0, ch);
        else if (gi == 2) { pool_items<8, 2>(proj, diff, tok0, ch); pool_items<8, 2>(proj, diff, tok0 + 16, ch); }
        else { pool_items<16, 1>(proj, diff, tok0, ch); pool_items<16, 1>(proj, diff, tok0 + 8, ch); pool_items<16, 1>(proj, diff, tok0 + 16, ch); pool_items<16, 1>(proj, diff, tok0 + 24, ch); }
    }
}
__device__ __forceinline__ void phase_combine(Frame& F, const bf16_t* aog, const float* lse, bf16_t* ao) {
    const int gt = (F.vcu * NWAVES + F.wave) * 64 + F.lane, NGT = F.G * NWAVES * 64;
    for (int it = gt; it < NTOK * 32; it += NGT) {
        const int tok = it >> 5, ch = it & 31, slot = ch >> 3;
        const float l0 = lse[((size_t)0 * NTOK + tok) * 4 + slot], l1 = lse[((size_t)1 * NTOK + tok) * 4 + slot], l2 = lse[((size_t)2 * NTOK + tok) * 4 + slot];
        const float M = fmaxf(l0, fmaxf(l1, l2));
        float w0 = __builtin_amdgcn_exp2f(l0 - M), w1 = __builtin_amdgcn_exp2f(l1 - M), w2 = __builtin_amdgcn_exp2f(l2 - M);
        const float iw = 1.f / (w0 + w1 + w2); w0 *= iw; w1 *= iw; w2 *= iw;
        const pg8::u32x4 a0 = *(const pg8::u32x4*)(aog + ((size_t)0 * NTOK + tok) * AOW + ch * 8), a1 = *(const pg8::u32x4*)(aog + ((size_t)1 * NTOK + tok) * AOW + ch * 8),
                         a2 = *(const pg8::u32x4*)(aog + ((size_t)2 * NTOK + tok) * AOW + ch * 8);
        pg8::u32x4 o;
#define CMB(f) pg8::cvt_pk_bf16(w0 * pg8::bflo(a0.f) + w1 * pg8::bflo(a1.f) + w2 * pg8::bflo(a2.f), w0 * pg8::bfhi(a0.f) + w1 * pg8::bfhi(a1.f) + w2 * pg8::bfhi(a2.f))
        o.x = CMB(x); o.y = CMB(y); o.z = CMB(z); o.w = CMB(w);
#undef CMB
        *(pg8::u32x4*)(ao + (size_t)tok * AOW + ch * 8) = o;
    }
}

constexpr int XS = 1028;
__device__ __forceinline__ void phase_ln_router(Frame& F, const MArgs& a, const bf16_t* y, bf16_t* x1b, int* cnt, int* list, float* listw) {
    const float* x = a.in[0];
    LAS float* xs = (LAS float*)(F.lds + RING_OFF);
    LAS float* part = xs + 16 * XS;
    LAS float* lgs = part + 8 * 16 * 48;
    LAS unsigned* lcnt = (LAS unsigned*)(lgs + 8 * 16 * 40);
    LAS int* rtab = (LAS int*)(lcnt + 32);
    if (F.tid < 32) lcnt[F.tid] = 0u;
    const float* g1 = a.in[9]; const float* b1 = a.in[10]; const float* wrg = a.in[11]; const float* brg = a.in[12]; const float* wre = a.in[13]; const float* bre = a.in[14];
    LAS float* gb1 = (LAS float*)(F.lds + RING_OFF + 122880);
    { int tid0 = F.tid; asm volatile("" : "+v"(tid0)); for (int i = tid0; i < 2 * DM; i += NWAVES * 64) gb1[i] = (i < DM) ? g1[i] : b1[i - DM]; }
    __syncthreads();
    const int lane = F.lane, w = F.wave, t16 = lane & 15, q = lane >> 4, tid = F.tid;
    bf16x8 wBh[4][3], wBl[4][3];
#pragma unroll
    for (int ks = 0; ks < 4; ++ks)
#pragma unroll
        for (int ct = 0; ct < 3; ++ct) { const int o = 16 * ct + t16; float wv[8];
#pragma unroll
            for (int j = 0; j < 8; ++j) { const int k = 128 * w + 32 * ks + 8 * q + j; wv[j] = (o < 4) ? wrg[k * 4 + o] : ((o < 36) ? wre[k * 32 + o - 4] : 0.f); }
            pg8::u32x4 hw, lw;
#pragma unroll
            for (int j2 = 0; j2 < 4; ++j2) { const unsigned hp = pg8::cvt_pk_bf16(wv[2 * j2], wv[2 * j2 + 1]);
                const unsigned lp = pg8::cvt_pk_bf16(wv[2 * j2] - pg8::bflo(hp), wv[2 * j2 + 1] - pg8::bfhi(hp)); hw[j2] = hp; lw[j2] = lp; }
            wBh[ks][ct] = __builtin_bit_cast(bf16x8, hw); wBl[ks][ct] = __builtin_bit_cast(bf16x8, lw); }
    const int ntile = NTOK / 16;
    f32x4 vn[2][4]; pg8::u32x2 yn[2][4];
#define LNR_LOAD(T_) do { _Pragma("unroll") for (int rr = 0; rr < 2; ++rr) _Pragma("unroll") for (int j = 0; j < 4; ++j) { const size_t o_ = (size_t)(16 * (T_) + 2 * w + rr) * DM + lane * 4 + 256 * j; \
        vn[rr][j] = *(const f32x4*)(x + o_); yn[rr][j] = *(const pg8::u32x2*)(y + o_); } } while (0)
    LNR_LOAD(F.vcu);
    const float rb0 = ((tid % 36) < 4) ? brg[tid % 36] : bre[(tid % 36) - 4], rb1 = (((tid + NWAVES * 64) % 36) < 4) ? brg[(tid + NWAVES * 64) % 36] : bre[((tid + NWAVES * 64) % 36) - 4];
    int ti = 0;
    for (int T = F.vcu; T < ntile; T += F.G, ++ti) {
        f32x4 v[2][4];
#pragma unroll
        for (int rr = 0; rr < 2; ++rr)
#pragma unroll
            for (int j = 0; j < 4; ++j) { f32x4 z = vn[rr][j] * ALPHA; z[0] += pg8::bflo(yn[rr][j].x); z[1] += pg8::bfhi(yn[rr][j].x); z[2] += pg8::bflo(yn[rr][j].y); z[3] += pg8::bfhi(yn[rr][j].y); v[rr][j] = z; }
        if (T + F.G < ntile) LNR_LOAD(T + F.G);
#pragma unroll
        for (int rr = 0; rr < 2; ++rr) {
            const int tok = 16 * T + 2 * w + rr;
            float s = 0.f;
#pragma unroll
            for (int j = 0; j < 4; ++j) s += (v[rr][j][0] + v[rr][j][1]) + (v[rr][j][2] + v[rr][j][3]);
            const float mean = wave_sum(s) * (1.f / DM); float s2 = 0.f;
#pragma unroll
            for (int j = 0; j < 4; ++j) { const f32x4 d = v[rr][j] - mean; s2 += (d[0] * d[0] + d[1] * d[1]) + (d[2] * d[2] + d[3] * d[3]); }
            const float rstd = 1.f / sqrtf(wave_sum(s2) * (1.f / DM) + LN_EPS);
#pragma unroll
            for (int j = 0; j < 4; ++j) { const int k0 = lane * 4 + 256 * j;
                const f32x4 x1 = (v[rr][j] - mean) * rstd * *(const LAS f32x4*)(gb1 + k0) + *(const LAS f32x4*)(gb1 + DM + k0);
                *(LAS f32x4*)(xs + (2 * w + rr) * XS + k0) = x1;
                pg8::u32x2 pk; pk.x = pg8::cvt_pk_bf16(x1[0], x1[1]); pk.y = pg8::cvt_pk_bf16(x1[2], x1[3]);
                *(pg8::u32x2*)(x1b + (size_t)tok * DM + k0) = pk; }
        }
        __syncthreads();
        f32x4 acc[3];
#pragma unroll
        for (int ct = 0; ct < 3; ++ct) acc[ct] = (f32x4){0.f, 0.f, 0.f, 0.f};
        const LAS float* xr = xs + t16 * XS + 128 * w + 8 * q;
#pragma unroll
        for (int ks = 0; ks < 4; ++ks) { const f32x4 xa = *(const LAS f32x4*)(xr + 32 * ks), xb = *(const LAS f32x4*)(xr + 32 * ks + 4);
            pg8::u32x4 hw, lw;
            hw.x = pg8::cvt_pk_bf16(xa[0], xa[1]); hw.y = pg8::cvt_pk_bf16(xa[2], xa[3]); hw.z = pg8::cvt_pk_bf16(xb[0], xb[1]); hw.w = pg8::cvt_pk_bf16(xb[2], xb[3]);
            lw.x = pg8::cvt_pk_bf16(xa[0] - pg8::bflo(hw.x), xa[1] - pg8::bfhi(hw.x)); lw.y = pg8::cvt_pk_bf16(xa[2] - pg8::bflo(hw.y), xa[3] - pg8::bfhi(hw.y));
            lw.z = pg8::cvt_pk_bf16(xb[0] - pg8::bflo(hw.z), xb[1] - pg8::bfhi(hw.z)); lw.w = pg8::cvt_pk_bf16(xb[2] - pg8::bflo(hw.w), xb[3] - pg8::bfhi(hw.w));
            const bf16x8 ah = __builtin_bit_cast(bf16x8, hw), al = __builtin_bit_cast(bf16x8, lw);
#pragma unroll
            for (int ct = 0; ct < 3; ++ct) {
                acc[ct] = __builtin_amdgcn_mfma_f32_16x16x32_bf16(ah, wBh[ks][ct], acc[ct], 0, 0, 0);
                acc[ct] = __builtin_amdgcn_mfma_f32_16x16x32_bf16(al, wBh[ks][ct], acc[ct], 0, 0, 0);
                acc[ct] = __builtin_amdgcn_mfma_f32_16x16x32_bf16(ah, wBl[ks][ct], acc[ct], 0, 0, 0); } }
#pragma unroll
        for (int ct = 0; ct < 3; ++ct)
#pragma unroll
            for (int rg = 0; rg < 4; ++rg) part[(w * 16 + 4 * q + rg) * 48 + 16 * ct + t16] = acc[ct][rg];
        __syncthreads();
        for (int i = tid; i < 16 * 36; i += NWAVES * 64) { const int tk = i / 36, o = i - tk * 36; float sum = (i < NWAVES * 64) ? rb0 : rb1;
#pragma unroll
            for (int ww = 0; ww < 8; ++ww) sum += part[(ww * 16 + tk) * 48 + o];
            lgs[(ti * 16 + tk) * 40 + o] = sum; }
    }
#undef LNR_LOAD
    __syncthreads();
    for (int sl_ = tid; sl_ < ti * 16; sl_ += NWAVES * 64) {
        const LAS float* sl = lgs + sl_ * 40;
        int gi = 0; float gm = sl[0];
        for (int o = 1; o < 4; ++o) if (sl[o] > gm) { gm = sl[o]; gi = o; }
        float gs = 0.f; for (int o = 0; o < 4; ++o) gs += __expf(sl[o] - gm);
        const float gprob = 1.f / gs;
        const LAS float* el = sl + 4 + gi * 8;
        int i0 = 0; float l0 = el[0];
        for (int o = 1; o < 8; ++o) if (el[o] > l0) { l0 = el[o]; i0 = o; }
        int i1 = -1; float l1 = -3.0e38f;
        for (int o = 0; o < 8; ++o) if (o != i0 && el[o] > l1) { l1 = el[o]; i1 = o; }
        const float e1 = __expf(l1 - l0), w0 = gprob / (1.f + e1), w1 = gprob * e1 / (1.f + e1);
        const int ex0 = gi * 8 + i0, ex1 = gi * 8 + i1;
        const int r0 = (int)__hip_atomic_fetch_add(lcnt + ex0, 1u, __ATOMIC_RELAXED, __HIP_MEMORY_SCOPE_WORKGROUP), r1 = (int)__hip_atomic_fetch_add(lcnt + ex1, 1u, __ATOMIC_RELAXED, __HIP_MEMORY_SCOPE_WORKGROUP);
        rtab[sl_ * 4 + 0] = (ex0 << 16) | r0; rtab[sl_ * 4 + 1] = (ex1 << 16) | r1; ((LAS float*)rtab)[sl_ * 4 + 2] = w0; ((LAS float*)rtab)[sl_ * 4 + 3] = w1;
    }
    __syncthreads();
    if (tid < 32) { const unsigned n = lcnt[tid]; lcnt[tid] = n ? (unsigned)atomicAdd(&cnt[tid * 64], (int)n) : 0u; }
    __syncthreads();
    for (int sl_ = tid; sl_ < ti * 16; sl_ += NWAVES * 64) {
        const int tok = 16 * (F.vcu + (sl_ >> 4) * F.G) + (sl_ & 15);
        const int a0 = rtab[sl_ * 4 + 0], a1 = rtab[sl_ * 4 + 1]; const float w0 = ((LAS float*)rtab)[sl_ * 4 + 2], w1 = ((LAS float*)rtab)[sl_ * 4 + 3];
        const int ex0 = a0 >> 16, ex1 = a1 >> 16, r0 = (a0 & 0xffff) + (int)lcnt[ex0], r1 = (a1 & 0xffff) + (int)lcnt[ex1];
        list[ex0 * NTOK + r0] = tok * 2; listw[ex0 * NTOK + r0] = w0;
        list[ex1 * NTOK + r1] = tok * 2 + 1; listw[ex1 * NTOK + r1] = w1;
    }
}

__device__ __forceinline__ void phase_final(Frame& F, const MArgs& a, const bf16_t* x1b, const bf16_t* po) {
    const float* g2 = a.in[18]; const float* b2 = a.in[19];
    const int gw = F.vcu * NWAVES + F.wave, NGW = F.G * NWAVES, lane = F.lane;
    f32x4 gg2[4], bb2[4];
#pragma unroll
    for (int j = 0; j < 4; ++j) { gg2[j] = *(const f32x4*)(g2 + lane * 4 + 256 * j); bb2[j] = *(const f32x4*)(b2 + lane * 4 + 256 * j); }
    pg8::u32x2 xn[2][4], pan[2][4], pbn[2][4];
#define FIN_LOAD(base_) do { _Pragma("unroll") for (int u = 0; u < 2; ++u) { const int tk = (base_) + u; \
        _Pragma("unroll") for (int j = 0; j < 4; ++j) { const int k0 = lane * 4 + 256 * j; xn[u][j] = *(const pg8::u32x2*)(x1b + (size_t)tk * DM + k0); \
            pan[u][j] = *(const pg8::u32x2*)(po + (size_t)tk * 2 * DM + k0); pbn[u][j] = *(const pg8::u32x2*)(po + (size_t)tk * 2 * DM + DM + k0); } } } while (0)
    FIN_LOAD(gw * 2);
    for (int base = gw * 2; base < NTOK; base += NGW * 2) {
        f32x4 v[2][4]; float s[2] = {0.f, 0.f};
#pragma unroll
        for (int u = 0; u < 2; ++u)
#pragma unroll
            for (int j = 0; j < 4; ++j) { f32x4 t;
                t[0] = ALPHA * pg8::bflo(xn[u][j].x) + (pg8::bflo(pan[u][j].x) + pg8::bflo(pbn[u][j].x)); t[1] = ALPHA * pg8::bfhi(xn[u][j].x) + (pg8::bfhi(pan[u][j].x) + pg8::bfhi(pbn[u][j].x));
                t[2] = ALPHA * pg8::bflo(xn[u][j].y) + (pg8::bflo(pan[u][j].y) + pg8::bflo(pbn[u][j].y)); t[3] = ALPHA * pg8::bfhi(xn[u][j].y) + (pg8::bfhi(pan[u][j].y) + pg8::bfhi(pbn[u][j].y));
                v[u][j] = t; s[u] += (t[0] + t[1]) + (t[2] + t[3]); }
        if (base + NGW * 2 < NTOK) FIN_LOAD(base + NGW * 2);
#pragma unroll
        for (int u = 0; u < 2; ++u) {
            const float mean = wave_sum(s[u]) * (1.f / DM); float s2 = 0.f;
#pragma unroll
            for (int j = 0; j < 4; ++j) { v[u][j] = v[u][j] - mean; s2 += (v[u][j][0] * v[u][j][0] + v[u][j][1] * v[u][j][1]) + (v[u][j][2] * v[u][j][2] + v[u][j][3] * v[u][j][3]); }
            const float rstd = 1.f / sqrtf(wave_sum(s2) * (1.f / DM) + LN_EPS);
            float* row = a.out + (size_t)(base + u) * DM;
#pragma unroll
            for (int j = 0; j < 4; ++j) { const int k0 = lane * 4 + 256 * j; *(f32x4*)(row + k0) = v[u][j] * rstd * gg2[j] + bb2[j]; }
        }
    }
#undef FIN_LOAD
}


__global__ void __launch_bounds__(NWAVES * 64, 2) mega(MArgs args) {
    extern __shared__ __attribute__((aligned(16))) unsigned char lds[];
    Frame F;
    F.lds = (LAS unsigned char*)lds;
    F.tid = threadIdx.x; F.lane = F.tid & 63; F.wave = __builtin_amdgcn_readfirstlane(F.tid >> 6);
    F.G = gridDim.x; { const int bx = blockIdx.x; F.vcu = (F.G % 8 == 0) ? (bx % 8) * (F.G / 8) + bx / 8 : bx; }
    unsigned char* ws = args.ws;
    gu32* ctl = (gu32*)(ws + WS_CTL);
    { int tid0 = F.tid; asm volatile("" : "+v"(tid0)); for (int u = tid0; u < (LDS_BYTES - LDSCTL_OFF) / 4; u += NWAVES * 64) ((LAS unsigned*)(F.lds + LDSCTL_OFF))[u] = 0u; }
    __syncthreads();
    const int lo = args.ph_lo, hi = args.ph_hi;
    const bool multi = (hi - lo) > 1;
    XcdBarrier bar; bar.bar = (unsigned*)(ctl + CW_BAR); bar.x = 0; bar.st = nullptr;
    if (multi) bar = xcd_barrier_post((unsigned*)(ctl + CW_BAR), (volatile LAS unsigned*)(F.lds + MISC_OFF) + 8);
    bf16_t* PROJ = (bf16_t*)(ws + WS_PROJ); bf16_t* MIXED = (bf16_t*)(ws + WS_MIXED); bf16_t* X1B = (bf16_t*)(ws + WS_X1B); bf16_t* XB = (bf16_t*)(ws + WS_XB);
    bf16_t* HID = (bf16_t*)(ws + WS_HID); bf16_t* PO = (bf16_t*)(ws + WS_PO); bf16_t* Y = (bf16_t*)(ws + WS_Z);
    bf16_t* AO = (bf16_t*)((unsigned char*)args.out + DO_AO); bf16_t* DIFF = (bf16_t*)((unsigned char*)args.out + DO_DIFF);
    bf16_t* AOG = (bf16_t*)((unsigned char*)args.out + DO_AOG); float* LSE = (float*)((unsigned char*)args.out + DO_LSE);
    int* cnt = (int*)(ws + WS_CTL) + CW_CNT; int* list = (int*)(ws + WS_LIST); float* listw = (float*)(ws + WS_LISTW);
#define PHASE_0 p0_prologue(F, args);
#define PHASE_1 { pg8::Gemm g{XB, (const bf16_t*)(ws + WT_WIN), DM}; pg8::StaticOrder S; S.init(NTOK, INW, F.G, (int)blockIdx.x); \
        pg8::EpiProj E{PROJ, args.in[2], QSCALE}; pg8::gemm_phase<pg8::EpiProj, pg8::StaticOrder, true>(F.lds + RING_OFF, g, S, E); \
          \
        { const int bx = (int)blockIdx.x; if (F.G == 256) { if (bx >= 128) tr_run(F, args, TR_DENSE + ((bx - 128) * NWAVES + F.wave), 1024, TR_DENSE + 10240); \
              else tr_run(F, args, TR_DENSE + 10240 + (bx * NWAVES + F.wave), 1024, TR_DENSE + TR_EXP); } \
          else tr_run(F, args, TR_DENSE + F.vcu * NWAVES + F.wave, F.G * NWAVES, TR_DENSE + TR_EXP); } }
#define PHASE_2 phase_attn(F, args, PROJ, AOG, LSE);
#define PHASE_3 { phase_pool(F, PROJ, DIFF); phase_combine(F, AOG, LSE, AO); }
#define PHASE_4 { pg8::Gemm2 g{AO, (const bf16_t*)(ws + WT_WPA), AOW, DIFF, (const bf16_t*)(ws + WT_WEFF), POOLW}; pg8::StaticOrder S; S.init(NTOK, DM, F.G, (int)blockIdx.x); \
        pg8::EpiMix E{MIXED, PROJ + GA_OFF, PROJ + GB_OFF}; pg8::gemm_phase2<pg8::EpiMix, pg8::StaticOrder, true>(F.lds + RING_OFF, g, S, E); }
#define PHASE_5 { }
#define PHASE_6 { pg8::Gemm g{MIXED, (const bf16_t*)(ws + WT_WOUT), DM}; pg8::StaticOrder S; S.init(NTOK, DM, F.G, (int)blockIdx.x); \
        pg8::EpiY E{Y}; pg8::gemm_phase<pg8::EpiY, pg8::StaticOrder, true>(F.lds + RING_OFF, g, S, E); }
#define PHASE_7 phase_ln_router(F, args, Y, X1B, cnt, list, listw);
#define PHASE_8 { const int ntiles = moe_tables(F, cnt); { pg8::Gemm g{X1B, (const bf16_t*)(ws + WT_WGU), DM}; \
        pg8::MoeOrder S{(const LAS int*)(F.lds + TILE_E_OFF), (const LAS int*)(F.lds + FIRST_OFF), cnt, list, 2, F.G, F.vcu, ntiles, true, (unsigned*)(ctl + CW_READY)}; \
        pg8::EpiMoe1 E{HID, cnt, listw}; pg8::gemm_phase<pg8::EpiMoe1, pg8::MoeOrder, true>(F.lds + RING_OFF, g, S, E); } \
          \
        { pg8::Gemm g{HID, (const bf16_t*)(ws + WT_WD), DEXP}; \
        pg8::DynMoeOrder S{(const LAS int*)(F.lds + TILE_E_OFF), (const LAS int*)(F.lds + FIRST_OFF), 4, ntiles, (unsigned*)(ctl + CW_Q9), (const unsigned*)(ctl + CW_READY), 16u, (unsigned*)(ctl + CW_TMO), (volatile LAS int*)(F.lds + MISC_OFF + 64)}; \
        pg8::EpiMoe2 E{PO, cnt, list}; pg8::gemm_phase<pg8::EpiMoe2, pg8::DynMoeOrder, true>(F.lds + RING_OFF, g, S, E); } }
#define PHASE_9 { }
#define PHASE_10 phase_final(F, args, X1B, PO);
#define IN(k) (lo <= (k) && (k) < hi)
#define SEAM(k) do { if (IN(k) && (k) + 1 < hi) xcd_barrier(bar); } while (0)
#define RUN(k, BODY) do { if (IN(k)) { BODY SEAM(k); } } while (0)
    RUN(0, PHASE_0);
    RUN(1, PHASE_1);
    RUN(2, PHASE_2);
    RUN(3, PHASE_3);
    RUN(4, PHASE_4);
    RUN(6, PHASE_6);
    RUN(7, PHASE_7);
    RUN(8, PHASE_8);
    RUN(10, PHASE_10);
#undef IN
#undef SEAM
#undef RUN
}

#ifndef SINGLE_LAUNCH
#define SINGLE_LAUNCH 1
#endif
constexpr int NPHASES = 11;
#ifndef DUP_MASK
#define DUP_MASK 0
#endif
extern "C" void kernel_launch(void* const* d_in, const int* in_sizes, int n_in, void* d_out, int out_size, void* d_ws, size_t ws_size, hipStream_t stream) {
    static int grid = 0;
    if (grid == 0) {
        if (n_in != 20 || in_sizes[0] != NTOK * DM || out_size != NTOK * DM || ws_size < WS_END) {
            fprintf(stderr, "kernel_launch: unexpected shapes (n_in %d, in0 %d, out %d, ws %zu)\n", n_in, n_in > 0 ? in_sizes[0] : -1, out_size, ws_size); grid = -1; return; }
        int dev = 0, cus = 0, per_cu = 0;
        if (hipGetDevice(&dev) != hipSuccess || hipDeviceGetAttribute(&cus, hipDeviceAttributeMultiprocessorCount, dev) != hipSuccess) { grid = -1; return; }
        if (hipFuncSetAttribute((const void*)mega, hipFuncAttributeMaxDynamicSharedMemorySize, LDS_BYTES) != hipSuccess) { fprintf(stderr, "kernel_launch: hipFuncSetAttribute failed\n"); grid = -1; return; }
        if (hipOccupancyMaxActiveBlocksPerMultiprocessor(&per_cu, (const void*)mega, NWAVES * 64, LDS_BYTES) != hipSuccess || per_cu < 1) {
            fprintf(stderr, "kernel_launch: occupancy query reports %d workgroups per CU\n", per_cu); (void)hipGetLastError(); grid = -1; return; }
        if (cus != 256) { fprintf(stderr, "kernel_launch: built for a 256-CU device (LDS tables of the LN/router phase are sized for 8 token tiles per workgroup); found %d CUs\n", cus); grid = -1; return; }
        grid = cus;
    }
    if (grid < 0) return;
    (void)hipMemsetAsync((unsigned char*)d_ws + WS_CTL, 0, CTL_ZERO_BYTES, stream);
    MArgs a{};
    for (int i = 0; i < 20; ++i) a.in[i] = (const float*)d_in[i];
    a.out = (float*)d_out; a.ws = (unsigned char*)d_ws;
    if (SINGLE_LAUNCH) { a.ph_lo = 0; a.ph_hi = NPHASES; hipLaunchKernelGGL(mega, dim3(grid), dim3(NWAVES * 64), LDS_BYTES, stream, a); return; }
    for (int p = 0; p < NPHASES; ++p) { a.ph_lo = p; a.ph_hi = p + 1;
        for (int rep = 0; rep < 1 + ((DUP_MASK >> p) & 1); ++rep) { if (rep && p == 7) (void)hipMemsetAsync((unsigned char*)d_ws + WS_CTL, 0, 8192, stream); hipLaunchKernelGGL(mega, dim3(grid), dim3(NWAVES * 64), LDS_BYTES, stream, a); } }
}
```

```cpp
#define SINGLE_LAUNCH 1
#include <hip/hip_runtime.h>
#include <cstdint>
#include <cstdio>

typedef unsigned short bf16_t;
typedef short bf16x8 __attribute__((ext_vector_type(8)));
typedef float f32x4 __attribute__((ext_vector_type(4)));

constexpr int BATCH = 16, SEQ = 2048, DM = 1024, NTOK = BATCH * SEQ;
constexpr int HD = 64, ATTW = 768, AOW = 256, POOLW = 512, INW = 4864;
constexpr int Q_OFF = 0, K_OFF = 768, V_OFF = 1536, POOL_OFF = 2304, GA_OFF = 2816, GB_OFF = 3840;
constexpr int NEXP = 32, DEXP = 256, NGRP = 4, EPG = 8;
constexpr float LN_EPS = 1e-5f;
constexpr float ALPHA = 1.189207115002721f;
constexpr int MAXROWS = 65536 + NEXP * 256;

constexpr size_t MiB = 1u << 20;
constexpr size_t WS_PROJ = 0;
constexpr size_t WS_PO = 0;
constexpr size_t WS_HID = 130 * MiB;
constexpr size_t WS_Z = 166 * MiB;
constexpr size_t WS_MIXED = 304 * MiB;
constexpr size_t WS_X1B = 368 * MiB;
constexpr size_t WS_WT = 432 * MiB;
constexpr size_t WS_CTL = 500 * MiB;
constexpr size_t WS_LIST = 501 * MiB;
constexpr size_t WS_LISTW = 505 * MiB;
constexpr size_t WS_TINFO = 509 * MiB;
constexpr size_t WS_END = 512 * MiB;
constexpr size_t DO_AO = 0, DO_DIFF = 16 * MiB, DO_AOG = 48 * MiB, DO_LSE = 96 * MiB;

__device__ __forceinline__ bf16_t f2bf(float f) { unsigned u = __float_as_uint(f); return (bf16_t)((u + 0x7fffu + ((u >> 16) & 1u)) >> 16); }
__device__ __forceinline__ float bf2f(bf16_t h) { return __uint_as_float(((unsigned)h) << 16); }
__device__ __forceinline__ bf16_t cvt_in(float v) { return f2bf(v); }
__device__ __forceinline__ bf16_t cvt_in(bf16_t v) { return v; }
__device__ __forceinline__ float sigmoidf_(float v) { return 1.f / (1.f + __expf(-v)); }
#define DPP_ADD(v, CTRL) ((v) + __builtin_bit_cast(float, __builtin_amdgcn_update_dpp(0, __builtin_bit_cast(int, (v)), (CTRL), 0xf, 0xf, true)))
__device__ __forceinline__ float wave_sum(float v) {
    v = DPP_ADD(v, 0xB1);
    v = DPP_ADD(v, 0x4E);
    v = DPP_ADD(v, 0x141);
    v = DPP_ADD(v, 0x140);
    const int iv = __builtin_bit_cast(int, v);
    return (__builtin_bit_cast(float, __builtin_amdgcn_readlane(iv, 0)) + __builtin_bit_cast(float, __builtin_amdgcn_readlane(iv, 16)))
         + (__builtin_bit_cast(float, __builtin_amdgcn_readlane(iv, 32)) + __builtin_bit_cast(float, __builtin_amdgcn_readlane(iv, 48)));
}
__device__ __forceinline__ float wave_max(float v) {
#pragma unroll
    for (int o = 1; o < 64; o <<= 1) v = fmaxf(v, __shfl_xor(v, o));
    return v;
}

__device__ __forceinline__ int t5_bucket(int dist) {
    if (dist < 16) return dist;
    const float d = (float)dist;
    int large = 16 + (int)(logf(d / 16.0f) / logf(128.0f) * 16.0f);
    return large < 31 ? large : 31;
}


namespace pg8 {
#define PG8_LAS __attribute__((address_space(3)))
typedef unsigned u32x4 __attribute__((ext_vector_type(4)));
typedef unsigned u32x2 __attribute__((ext_vector_type(2)));
constexpr int BM = 256, BK = 64, HALF = 128, HTB = HALF * BK * 2  , STAGE_BYTES = 8 * HTB, NXCD = 8, WGM = 8;

__host__ __device__ __forceinline__ int lds_byte(int r, int c) { const int st = (r >> 4) * 2 + (c >> 5), rr = r & 15, cc = c & 31, ob = rr * 64 + cc * 2; return st * 1024 + (ob ^ (((ob >> 9) & 1) << 5)); }
__host__ __device__ __forceinline__ void stage_rc(int b, int& R, int& C) { const int st = b / 1024, sb = b % 1024, swz = sb ^ (((sb >> 9) & 1) << 5); R = (st >> 1) * 16 + swz / 64; C = (st & 1) * 32 + (swz % 64) / 2; }
__host__ __device__ __forceinline__ int perm32(int rho) { const int n = rho >> 4, i = rho & 15; return 8 * (i >> 2) + 4 * n + (i & 3); }

struct Unit { int pm, pn, e, rt; };
struct Gemm { const bf16_t* A; const bf16_t* Bt; int K; };

struct StaticOrder {
    int nM, nN, nwg, G, c;
    __device__ void init(int M, int N, int G_, int c_) { nM = M / BM; nN = N / BM; nwg = nM * nN; G = G_; c = c_; }
    __device__ bool next(int i, Unit& u) const {
        const long L = (long)i * G + c; if (L >= nwg) return false;
        int wgid = (int)L; { const int q = nwg / NXCD, r = nwg % NXCD, xcd = wgid % NXCD, off = wgid / NXCD; wgid = (xcd < r ? xcd * (q + 1) : r * (q + 1) + (xcd - r) * q) + off; }
        const int nig = WGM * nN, gid = wgid / nig, fm = gid * WGM, gsz = (nM - fm) < WGM ? (nM - fm) : WGM;
        u.pm = fm + ((wgid % nig) % gsz); u.pn = (wgid % nig) / gsz; u.e = 0; u.rt = 0; return true;
    }
    __device__ __forceinline__ int arow(const Unit& u, int r) const { return u.pm * BM + r; }
    __device__ __forceinline__ void done(const Unit&) const {}
};

struct MoeOrder {
    const PG8_LAS int* tile_e; const PG8_LAS int* first; const int* cnt; const int* list; int nN, G, c, ntiles; bool gather; unsigned* ready;
    __device__ bool next(int i, Unit& u) const {
        const int L = i * G + c; if (L >= ntiles * nN) return false;
        const int rt = L / nN, pn = L - rt * nN, e = tile_e[rt];
        u.pm = rt; u.pn = e * nN + pn; u.e = e; u.rt = rt - first[e]; return true;
    }
    __device__ __forceinline__ int arow(const Unit& u, int r) const {
        if (!gather) return u.pm * BM + r;
        const int idx = u.rt * BM + r; return idx < cnt[u.e * 64] ? (list[u.e * NTOK + idx] >> 1) : 0;
    }
    __device__ __forceinline__ void done(const Unit& u) const {
        asm volatile("s_waitcnt vmcnt(0)" ::: "memory");
        if ((threadIdx.x & 63) == 0) __hip_atomic_fetch_add(ready + 64 * u.pm, 1u, __ATOMIC_RELAXED, __HIP_MEMORY_SCOPE_AGENT);
    }
};
struct DynMoeOrder {
    const PG8_LAS int* tile_e; const PG8_LAS int* first; int nN, ntiles; unsigned* queue; const unsigned* ready; unsigned need; unsigned* tmo; volatile PG8_LAS int* slot;
    __device__ bool next(int i, Unit& u) const {
        if (threadIdx.x < 64) {
            int L = 0; if (threadIdx.x == 0) L = (int)__hip_atomic_fetch_add(queue, 1u, __ATOMIC_RELAXED, __HIP_MEMORY_SCOPE_AGENT);
            L = __builtin_amdgcn_readfirstlane(L);
            if (L < ntiles * nN) {
                const int rt = L / nN; unsigned spins = 0;
                while ((unsigned)__builtin_amdgcn_readfirstlane(__hip_atomic_load(ready + 64 * rt, __ATOMIC_RELAXED, __HIP_MEMORY_SCOPE_AGENT)) < need) {
                    __builtin_amdgcn_s_sleep(2);
                    if (++spins > (1u << 20)) { if (threadIdx.x == 0) __hip_atomic_store(tmo, 1u, __ATOMIC_RELAXED, __HIP_MEMORY_SCOPE_AGENT); break; } }
                __builtin_amdgcn_fence(__ATOMIC_ACQUIRE, "agent");
                asm volatile("s_waitcnt vmcnt(0)" ::: "memory");
            } else L = -1;
            if (threadIdx.x == 0) slot[i & 1] = L;
            asm volatile("s_waitcnt lgkmcnt(0)" ::: "memory");
        }
        __builtin_amdgcn_s_barrier(); asm volatile("" ::: "memory");
        const int L = slot[i & 1]; if (L < 0) return false;
        const int rt = L / nN, pn = L - rt * nN, e = tile_e[rt];
        u.pm = rt; u.pn = e * nN + pn; u.e = e; u.rt = rt - first[e]; return true;
    }
    __device__ __forceinline__ int arow(const Unit& u, int r) const { return u.pm * BM + r; }
    __device__ __forceinline__ void done(const Unit&) const {}
};

__device__ __forceinline__ unsigned cvt_pk_bf16(float lo, float hi) { unsigned r; asm volatile("v_cvt_pk_bf16_f32 %0, %1, %2" : "=v"(r) : "v"(lo), "v"(hi)); return r; }
__device__ __forceinline__ float bflo(unsigned w) { return __uint_as_float(w << 16); }
__device__ __forceinline__ float bfhi(unsigned w) { return __uint_as_float(w & 0xffff0000u); }
__device__ __forceinline__ float fsig(float v) { return __builtin_amdgcn_rcpf(1.f + __builtin_amdgcn_exp2f(-1.4426950408889634f * v)); }
__device__ __forceinline__ float fsig_gate(float v) { return fmaxf(fsig(v), 1.0e-7f); }

struct EpiProj {
    static constexpr bool PERM = true;
    bf16_t* O; const float* bias; float qscale;
    __device__ __forceinline__ void operator()(const f32x4 (&acc)[2][2][4][2], const Unit& u, int wr, int wc, int fr, int fq) const {
        const int row0 = u.pm * BM + wr * 64 + fr, lc0 = wc * 32 + 8 * fq;
        const bool gate = u.pn >= 11;
        const int lg = (u.pn < 9) ? 2 * (u.pn % 3) : 0;
        const int cb0 = gate ? GA_OFF + (u.pn - 11) * HALF + lc0 : u.pn * BM + lc0, cb1 = gate ? GB_OFF + (u.pn - 11) * HALF + lc0 : u.pn * BM + HALF + lc0;
        f32x4 bv[2][2];
#pragma unroll
        for (int n = 0; n < 2; ++n) { bv[0][n] = *(const f32x4*)(bias + cb0 + 4 * n); bv[1][n] = *(const f32x4*)(bias + cb1 + 4 * n); }
#pragma unroll
        for (int ai = 0; ai < 2; ++ai)
#pragma unroll
            for (int m = 0; m < 4; ++m) { const int rg = row0 + ai * HALF + m * 16, t = rg & (SEQ - 1), prow = (rg & ~(SEQ - 1)) + ((t & ((1 << lg) - 1)) << (11 - lg)) + (t >> lg);
                bf16_t* rowp = O + (size_t)prow * INW;
                f32x4 a0 = acc[ai][0][m][0] + bv[0][0], a1 = acc[ai][0][m][1] + bv[0][1], b0 = acc[ai][1][m][0] + bv[1][0], b1 = acc[ai][1][m][1] + bv[1][1];
                if (u.pn < 3) { a0 = a0 * qscale; a1 = a1 * qscale; b0 = b0 * qscale; b1 = b1 * qscale; }
                if (gate) {
#pragma unroll
                    for (int i = 0; i < 4; ++i) { const float s0 = fsig_gate(b0[i]), s1 = fsig_gate(b1[i]); a0[i] = fsig(a0[i]) * __builtin_amdgcn_rcpf(s0); a1[i] = fsig(a1[i]) * __builtin_amdgcn_rcpf(s1); b0[i] = s0; b1[i] = s1; } }
                u32x4 w; w.x = cvt_pk_bf16(a0[0], a0[1]); w.y = cvt_pk_bf16(a0[2], a0[3]); w.z = cvt_pk_bf16(a1[0], a1[1]); w.w = cvt_pk_bf16(a1[2], a1[3]);
                *(u32x4*)(rowp + cb0) = w;
                w.x = cvt_pk_bf16(b0[0], b0[1]); w.y = cvt_pk_bf16(b0[2], b0[3]); w.z = cvt_pk_bf16(b1[0], b1[1]); w.w = cvt_pk_bf16(b1[2], b1[3]);
                *(u32x4*)(rowp + cb1) = w; }
    }
};
template <bool ACCUM> struct EpiGate {
    static constexpr bool PERM = true;
    bf16_t* O; const bf16_t* gate;
    __device__ __forceinline__ void operator()(const f32x4 (&acc)[2][2][4][2], const Unit& u, int wr, int wc, int fr, int fq) const {
        const int row0 = u.pm * BM + wr * 64 + fr, col0 = u.pn * BM + wc * 32 + 8 * fq;
#pragma unroll
        for (int ai = 0; ai < 2; ++ai)
#pragma unroll
            for (int m = 0; m < 4; ++m) { const size_t r = (size_t)(row0 + ai * HALF + m * 16);
#pragma unroll
                for (int bj = 0; bj < 2; ++bj) {
                    const u32x4 gw = *(const u32x4*)(gate + r * INW + col0 + bj * HALF);
                    bf16_t* op = O + r * DM + col0 + bj * HALF;
                    f32x4 v0 = acc[ai][bj][m][0], v1 = acc[ai][bj][m][1];
                    v0[0] *= bflo(gw.x); v0[1] *= bfhi(gw.x); v0[2] *= bflo(gw.y); v0[3] *= bfhi(gw.y);
                    v1[0] *= bflo(gw.z); v1[1] *= bfhi(gw.z); v1[2] *= bflo(gw.w); v1[3] *= bfhi(gw.w);
                    if (ACCUM) { const u32x4 ow = *(const u32x4*)op;
                        v0[0] += bflo(ow.x); v0[1] += bfhi(ow.x); v0[2] += bflo(ow.y); v0[3] += bfhi(ow.y);
                        v1[0] += bflo(ow.z); v1[1] += bfhi(ow.z); v1[2] += bflo(ow.w); v1[3] += bfhi(ow.w); }
                    u32x4 w; w.x = cvt_pk_bf16(v0[0], v0[1]); w.y = cvt_pk_bf16(v0[2], v0[3]); w.z = cvt_pk_bf16(v1[0], v1[1]); w.w = cvt_pk_bf16(v1[2], v1[3]);
                    *(u32x4*)op = w; } }
    }
};
struct EpiMix {
    static constexpr bool PERM = true;
    bf16_t* O; const bf16_t* ga; const bf16_t* gb;
    __device__ __forceinline__ void mid(f32x4 (&acc)[2][2][4][2], const Unit& u, int wr, int wc, int fr, int fq) const {
        int row0 = u.pm * BM + wr * 64 + fr, col0 = u.pn * BM + wc * 32 + 8 * fq;
        asm volatile("" : "+v"(row0), "+v"(col0));
#pragma unroll
        for (int ai = 0; ai < 2; ++ai)
#pragma unroll
            for (int m = 0; m < 4; ++m) { const size_t r = (size_t)(row0 + ai * HALF + m * 16);
#pragma unroll
                for (int bj = 0; bj < 2; ++bj) {
                    const u32x4 a = *(const u32x4*)(ga + r * INW + col0 + bj * HALF);
                    f32x4& v0 = acc[ai][bj][m][0]; f32x4& v1 = acc[ai][bj][m][1];
                    v0[0] *= bflo(a.x); v0[1] *= bfhi(a.x); v0[2] *= bflo(a.y); v0[3] *= bfhi(a.y);
                    v1[0] *= bflo(a.z); v1[1] *= bfhi(a.z); v1[2] *= bflo(a.w); v1[3] *= bfhi(a.w); }
                if (m == 3) asm volatile("" ::: "memory"); }
    }
    __device__ __forceinline__ void operator()(const f32x4 (&acc)[2][2][4][2], const Unit& u, int wr, int wc, int fr, int fq) const {
        const int row0 = u.pm * BM + wr * 64 + fr, col0 = u.pn * BM + wc * 32 + 8 * fq;
#pragma unroll
        for (int ai = 0; ai < 2; ++ai)
#pragma unroll
            for (int m = 0; m < 4; ++m) { const size_t r = (size_t)(row0 + ai * HALF + m * 16);
#pragma unroll
                for (int bj = 0; bj < 2; ++bj) {
                    const u32x4 b = *(const u32x4*)(gb + r * INW + col0 + bj * HALF);
                    const f32x4 v0 = acc[ai][bj][m][0], v1 = acc[ai][bj][m][1];
                    u32x4 w; w.x = cvt_pk_bf16(v0[0] * bflo(b.x), v0[1] * bfhi(b.x)); w.y = cvt_pk_bf16(v0[2] * bflo(b.y), v0[3] * bfhi(b.y));
                    w.z = cvt_pk_bf16(v1[0] * bflo(b.z), v1[1] * bfhi(b.z)); w.w = cvt_pk_bf16(v1[2] * bflo(b.w), v1[3] * bfhi(b.w));
                    *(u32x4*)(O + r * DM + col0 + bj * HALF) = w; }
                if (m == 3) asm volatile("" ::: "memory"); }
    }
};
struct EpiY {
    static constexpr bool PERM = true;
    bf16_t* Y;
    __device__ __forceinline__ void operator()(const f32x4 (&acc)[2][2][4][2], const Unit& u, int wr, int wc, int fr, int fq) const {
        const int col0 = u.pn * BM + wc * 32 + 8 * fq;
#pragma unroll
        for (int ai = 0; ai < 2; ++ai)
#pragma unroll
            for (int m = 0; m < 4; ++m) { bf16_t* rowp = Y + (size_t)(u.pm * BM + ai * HALF + wr * 64 + m * 16 + fr) * DM + col0;
#pragma unroll
                for (int bj = 0; bj < 2; ++bj) { const f32x4 v0 = acc[ai][bj][m][0], v1 = acc[ai][bj][m][1];
                    u32x4 w; w.x = cvt_pk_bf16(v0[0], v0[1]); w.y = cvt_pk_bf16(v0[2], v0[3]); w.z = cvt_pk_bf16(v1[0], v1[1]); w.w = cvt_pk_bf16(v1[2], v1[3]);
                    *(u32x4*)(rowp + bj * HALF) = w; } }
    }
};
struct EpiMoe1 {
    static constexpr bool PERM = true;
    bf16_t* hid; const int* cnt; const float* listw;
    __device__ __forceinline__ void operator()(const f32x4 (&acc)[2][2][4][2], const Unit& u, int wr, int wc, int fr, int fq) const {
        const int n_e = cnt[u.e * 64], pnl = u.pn & 1, hc0 = pnl * 128 + wc * 32 + 8 * fq;
        const __amdgpu_buffer_rsrc_t rs = __builtin_amdgcn_make_buffer_rsrc(hid, 0, MAXROWS * DEXP * 2, 0x00020000);
#pragma unroll
        for (int ai = 0; ai < 2; ++ai)
#pragma unroll
            for (int m = 0; m < 4; ++m) { const int r = ai * HALF + wr * 64 + m * 16 + fr, idx = u.rt * BM + r;
                const float w = idx < n_e ? listw[u.e * NTOK + idx] : 0.f;
                float h[8];
#pragma unroll
                for (int n = 0; n < 2; ++n)
#pragma unroll
                    for (int i = 0; i < 4; ++i) { const float g = acc[ai][0][m][n][i], uu = acc[ai][1][m][n][i]; h[n * 4 + i] = w * g * fsig(g) * uu; }
                u32x4 o; o.x = cvt_pk_bf16(h[0], h[1]); o.y = cvt_pk_bf16(h[2], h[3]); o.z = cvt_pk_bf16(h[4], h[5]); o.w = cvt_pk_bf16(h[6], h[7]);
                __builtin_amdgcn_raw_buffer_store_b128(o, rs, (unsigned)(((u.pm * BM + r) * DEXP + hc0) * 2), 0,   16); }
    }
};
struct EpiMoe2 {
    static constexpr bool PERM = true;
    bf16_t* po; const int* cnt; const int* list;
    __device__ __forceinline__ void operator()(const f32x4 (&acc)[2][2][4][2], const Unit& u, int wr, int wc, int fr, int fq) const {
        const int col0 = (u.pn & 3) * BM + wc * 32 + 8 * fq, n_e = cnt[u.e * 64];
#pragma unroll
        for (int ai = 0; ai < 2; ++ai)
#pragma unroll
            for (int m = 0; m < 4; ++m) { const int r = ai * HALF + wr * 64 + m * 16 + fr, idx = u.rt * BM + r;
                const int drow = idx < n_e ? list[u.e * NTOK + idx] : 2 * NTOK + r;
                bf16_t* rowp = po + (size_t)drow * DM + col0;
#pragma unroll
                for (int bj = 0; bj < 2; ++bj) { const f32x4 v0 = acc[ai][bj][m][0], v1 = acc[ai][bj][m][1];
                    u32x4 w; w.x = cvt_pk_bf16(v0[0], v0[1]); w.y = cvt_pk_bf16(v0[2], v0[3]); w.z = cvt_pk_bf16(v1[0], v1[1]); w.w = cvt_pk_bf16(v1[2], v1[3]);
                    *(u32x4*)(rowp + bj * HALF) = w; } }
    }
};

template <class Epi, class Sched, bool ALIGN_EPI>
__device__ __forceinline__ void gemm_phase(PG8_LAS unsigned char* lds, const Gemm g, const Sched& S, const Epi& E) {
    const int tid = threadIdx.x, wid = __builtin_amdgcn_readfirstlane(tid >> 6), lane = tid & 63, wr = wid >> 2, wc = wid & 3, fr = lane & 15, fq = lane >> 4;
    const int K = g.K, nt = K / BK;
    int RA[2]; unsigned CA[2], voffB[2];
#pragma unroll
    for (int i = 0; i < 2; ++i) { int R, C; stage_rc(tid * 16 + i * 8192, R, C); const int Rb = Epi::PERM ? ((R & ~31) + perm32(R & 31)) : R;
        RA[i] = R; CA[i] = (unsigned)C * 2u; voffB[i] = (unsigned)(Rb * K + C) * 2u; }
    const size_t kstep = (size_t)(BK * 2);
    const size_t hstep = (size_t)HALF * K * 2;
    const size_t tstep = 2 * hstep;
    const unsigned ldsw = (unsigned)wid * 1024u;
    const int aoff = lds_byte(wr * 64 + fr, fq * 8), boff = lds_byte(wc * 32 + fr, fq * 8);
#define PG8_SA(b, h) (((b) * 2 + (h)) * HTB)
#define PG8_SB(b, h) ((4 + (b) * 2 + (h)) * HTB)
#define PG8_STAGE(bufoff, gbase, voff) do { _Pragma("unroll") for (int _i = 0; _i < 2; ++_i) \
        __builtin_amdgcn_global_load_lds((const unsigned*)((const char*)(gbase) + (voff)[_i]), (PG8_LAS unsigned*)(lds + (bufoff) + ldsw + _i * 8192), 16, 0, 0); } while (0)
#define PG8_LDA(dst, b, h) do { _Pragma("unroll") for (int m = 0; m < 4; ++m) _Pragma("unroll") for (int k = 0; k < 2; ++k) dst[m][k] = *(const PG8_LAS bf16x8*)(lds + PG8_SA(b, h) + aoff + m * 2048 + k * 1024); } while (0)
#define PG8_LDB(dst, b, h) do { _Pragma("unroll") for (int n = 0; n < 2; ++n) _Pragma("unroll") for (int k = 0; k < 2; ++k) dst[n][k] = *(const PG8_LAS bf16x8*)(lds + PG8_SB(b, h) + boff + n * 2048 + k * 1024); } while (0)
#define PG8_MMA(ai, bj, At, Bt) do { __builtin_amdgcn_s_setprio(1); _Pragma("unroll") for (int m = 0; m < 4; ++m) _Pragma("unroll") for (int n = 0; n < 2; ++n) _Pragma("unroll") for (int k = 0; k < 2; ++k) \
        acc[ai][bj][m][n] = __builtin_amdgcn_mfma_f32_16x16x32_bf16(Bt[n][k], At[m][k], acc[ai][bj][m][n], 0, 0, 0); __builtin_amdgcn_s_setprio(0); } while (0)
#define PG8_WAIT_V(n) asm volatile("s_waitcnt vmcnt(" #n ")" ::: "memory")
#define PG8_WAIT_L(n) asm volatile("s_waitcnt lgkmcnt(" #n ")" ::: "memory")
#define PG8_BAR __builtin_amdgcn_s_barrier()
#define PG8_SCHED __builtin_amdgcn_sched_barrier(0)
#define PG8_AOFF(dst, U) do { _Pragma("unroll") for (int _h = 0; _h < 2; ++_h) _Pragma("unroll") for (int _i = 0; _i < 2; ++_i) \
        dst[_h][_i] = (unsigned)S.arow(U, _h * HALF + RA[_i]) * (unsigned)(K * 2) + CA[_i]; } while (0)
    Unit cur, nxt; int ui = 0;
    if (!S.next(0, cur)) return;
    f32x4 acc[2][2][4][2];
#pragma unroll
    for (int a = 0; a < 2; ++a)
#pragma unroll
        for (int b = 0; b < 2; ++b)
#pragma unroll
            for (int m = 0; m < 4; ++m)
#pragma unroll
                for (int n = 0; n < 2; ++n) acc[a][b][m][n] = (f32x4){0.f, 0.f, 0.f, 0.f};
    bf16x8 At[4][2], B0[2][2], B1[2][2];
    unsigned offC[2][2], offN[2][2];
    PG8_AOFF(offC, cur);
    const char* A0 = (const char*)g.A;
    const char* cB = (const char*)g.Bt + (size_t)cur.pn * tstep;
    PG8_STAGE(PG8_SB(0, 0), cB, voffB); PG8_STAGE(PG8_SB(0, 1), cB + hstep, voffB); PG8_STAGE(PG8_SA(0, 0), A0, offC[0]); PG8_STAGE(PG8_SA(0, 1), A0, offC[1]);
    if (wr == 1) PG8_BAR;
    PG8_WAIT_V(2); PG8_BAR;
    PG8_STAGE(PG8_SB(1, 0), cB + kstep, voffB); PG8_STAGE(PG8_SA(1, 0), A0 + kstep, offC[0]); PG8_STAGE(PG8_SB(1, 1), cB + hstep + kstep, voffB);
    PG8_WAIT_V(6); PG8_BAR;
    for (;;) {
        const bool has_next = S.next(ui + 1, nxt);
        if (has_next) PG8_AOFF(offN, nxt);
        const char* nB = has_next ? (const char*)g.Bt + (size_t)nxt.pn * tstep : cB;
#pragma unroll 1
        for (int t = 0; t < nt; t += 2) {
            const bool last = (t == nt - 2);
            const char* a1 = A0 + (size_t)(t + 1) * kstep;
            const char* a2 = last ? A0 : A0 + (size_t)(t + 2) * kstep; const char* b2 = last ? nB : cB + (size_t)(t + 2) * kstep;
            const char* a3 = a2 + kstep; const char* b3 = b2 + kstep;
            PG8_LDB(B0, 0, 0); PG8_LDB(B1, 0, 1); PG8_SCHED; PG8_LDA(At, 0, 0); PG8_STAGE(PG8_SA(1, 1), a1, offC[1]);
            if (last && has_next) {
#pragma unroll
                for (int _h = 0; _h < 2; ++_h)
#pragma unroll
                    for (int _i = 0; _i < 2; ++_i) offC[_h][_i] = offN[_h][_i];
            }
            PG8_WAIT_V(8); PG8_WAIT_L(0); PG8_BAR; PG8_MMA(0, 0, At, B0); PG8_MMA(0, 1, At, B1); PG8_BAR; PG8_SCHED;
            PG8_LDA(At, 0, 1); PG8_STAGE(PG8_SB(0, 0), b2, voffB); PG8_STAGE(PG8_SB(0, 1), b2 + hstep, voffB); PG8_STAGE(PG8_SA(0, 0), a2, offC[0]);
            PG8_WAIT_V(8); PG8_WAIT_L(0); PG8_BAR; PG8_MMA(1, 0, At, B0); PG8_MMA(1, 1, At, B1); PG8_BAR; PG8_SCHED;
            PG8_LDB(B0, 1, 0); PG8_LDB(B1, 1, 1); PG8_SCHED; PG8_LDA(At, 1, 0); PG8_STAGE(PG8_SA(0, 1), a2, offC[1]);
            PG8_WAIT_V(8); PG8_WAIT_L(0); PG8_BAR; PG8_MMA(0, 0, At, B0); PG8_MMA(0, 1, At, B1); PG8_BAR; PG8_SCHED;
            PG8_LDA(At, 1, 1); PG8_STAGE(PG8_SB(1, 0), b3, voffB); PG8_STAGE(PG8_SB(1, 1), b3 + hstep, voffB); PG8_STAGE(PG8_SA(1, 0), a3, offC[0]);
            PG8_WAIT_V(8); PG8_WAIT_L(0); PG8_BAR; PG8_MMA(1, 0, At, B0); PG8_MMA(1, 1, At, B1); PG8_BAR; PG8_SCHED;
        }
        if constexpr (ALIGN_EPI) { if (wr == 0) PG8_BAR; }
        E(acc, cur, wr, wc, fr, fq); S.done(cur);
        if (!has_next) break;
#pragma unroll
        for (int a = 0; a < 2; ++a)
#pragma unroll
            for (int b = 0; b < 2; ++b)
#pragma unroll
                for (int m = 0; m < 4; ++m)
#pragma unroll
                    for (int n = 0; n < 2; ++n) acc[a][b][m][n] = (f32x4){0.f, 0.f, 0.f, 0.f};
        cur = nxt; cB = nB; ++ui;
        if constexpr (ALIGN_EPI) { if (wr == 1) PG8_BAR; }
    }
    PG8_WAIT_V(0);
    if constexpr (!ALIGN_EPI) { if (wr == 0) PG8_BAR; }
    PG8_BAR;
#undef PG8_SA
#undef PG8_SB
#undef PG8_STAGE
#undef PG8_LDA
#undef PG8_LDB
#undef PG8_MMA
#undef PG8_WAIT_V
#undef PG8_WAIT_L
#undef PG8_BAR
#undef PG8_SCHED
#undef PG8_AOFF
}

struct Gemm2 { const bf16_t* A0; const bf16_t* B0; int K0; const bf16_t* A1; const bf16_t* B1; int K1; };
template <class Epi, class Sched, bool ALIGN_EPI>
__device__ __forceinline__ void gemm_phase2(PG8_LAS unsigned char* lds, const Gemm2 g, const Sched& S, const Epi& E) {
    const int tid = threadIdx.x, wid = __builtin_amdgcn_readfirstlane(tid >> 6), lane = tid & 63, wr = wid >> 2, wc = wid & 3, fr = lane & 15, fq = lane >> 4;
    const int nt0 = g.K0 / BK, nt = nt0 + g.K1 / BK;
    unsigned RA2[2], RB2[2], C2[2];
#pragma unroll
    for (int i = 0; i < 2; ++i) { int R, C; stage_rc(tid * 16 + i * 8192, R, C); const int Rb = Epi::PERM ? ((R & ~31) + perm32(R & 31)) : R;
        RA2[i] = (unsigned)R * 2u; RB2[i] = (unsigned)Rb * 2u; C2[i] = (unsigned)C * 2u; }
    const size_t kstep = (size_t)(BK * 2);
    const unsigned ldsw = (unsigned)wid * 1024u;
    const int aoff = lds_byte(wr * 64 + fr, fq * 8), boff = lds_byte(wc * 32 + fr, fq * 8);
#define PG8_SA(b, h) (((b) * 2 + (h)) * HTB)
#define PG8_SB(b, h) ((4 + (b) * 2 + (h)) * HTB)
#define PG8_STAGE(bufoff, gbase, R2, Kb) do { _Pragma("unroll") for (int _i = 0; _i < 2; ++_i) \
        __builtin_amdgcn_global_load_lds((const unsigned*)((const char*)(gbase) + ((R2)[_i] * (unsigned)(Kb) + C2[_i])), (PG8_LAS unsigned*)(lds + (bufoff) + ldsw + _i * 8192), 16, 0, 0); } while (0)
#define PG8_LDA(dst, b, h) do { _Pragma("unroll") for (int m = 0; m < 4; ++m) _Pragma("unroll") for (int k = 0; k < 2; ++k) dst[m][k] = *(const PG8_LAS bf16x8*)(lds + PG8_SA(b, h) + aoff + m * 2048 + k * 1024); } while (0)
#define PG8_LDB(dst, b, h) do { _Pragma("unroll") for (int n = 0; n < 2; ++n) _Pragma("unroll") for (int k = 0; k < 2; ++k) dst[n][k] = *(const PG8_LAS bf16x8*)(lds + PG8_SB(b, h) + boff + n * 2048 + k * 1024); } while (0)
#define PG8_MMA(ai, bj, At, Bt) do { __builtin_amdgcn_s_setprio(1); _Pragma("unroll") for (int m = 0; m < 4; ++m) _Pragma("unroll") for (int n = 0; n < 2; ++n) _Pragma("unroll") for (int k = 0; k < 2; ++k) \
        acc[ai][bj][m][n] = __builtin_amdgcn_mfma_f32_16x16x32_bf16(Bt[n][k], At[m][k], acc[ai][bj][m][n], 0, 0, 0); __builtin_amdgcn_s_setprio(0); } while (0)
#define PG8_WAIT_V(n) asm volatile("s_waitcnt vmcnt(" #n ")" ::: "memory")
#define PG8_WAIT_L(n) asm volatile("s_waitcnt lgkmcnt(" #n ")" ::: "memory")
#define PG8_BAR __builtin_amdgcn_s_barrier()
#define PG8_SCHED __builtin_amdgcn_sched_barrier(0)
#define PG8_APTR(pm_, h, tt) ((tt) < nt0 ? (const char*)g.A0 + ((size_t)((pm_) * BM + (h) * HALF) * g.K0 + (size_t)(tt) * BK) * 2 : (const char*)g.A1 + ((size_t)((pm_) * BM + (h) * HALF) * g.K1 + (size_t)((tt) - nt0) * BK) * 2)
#define PG8_BPTR(pn_, h, tt) ((tt) < nt0 ? (const char*)g.B0 + ((size_t)((pn_) * BM + (h) * HALF) * g.K0 + (size_t)(tt) * BK) * 2 : (const char*)g.B1 + ((size_t)((pn_) * BM + (h) * HALF) * g.K1 + (size_t)((tt) - nt0) * BK) * 2)
    Unit cur, nxt; int ui = 0;
    if (!S.next(0, cur)) return;
    f32x4 acc[2][2][4][2];
#pragma unroll
    for (int a = 0; a < 2; ++a)
#pragma unroll
        for (int b = 0; b < 2; ++b)
#pragma unroll
            for (int m = 0; m < 4; ++m)
#pragma unroll
                for (int n = 0; n < 2; ++n) acc[a][b][m][n] = (f32x4){0.f, 0.f, 0.f, 0.f};
    bf16x8 At[4][2], B0[2][2], B1[2][2];
    PG8_STAGE(PG8_SB(0, 0), PG8_BPTR(cur.pn, 0, 0), RB2, g.K0); PG8_STAGE(PG8_SB(0, 1), PG8_BPTR(cur.pn, 1, 0), RB2, g.K0); PG8_STAGE(PG8_SA(0, 0), PG8_APTR(cur.pm, 0, 0), RA2, g.K0); PG8_STAGE(PG8_SA(0, 1), PG8_APTR(cur.pm, 1, 0), RA2, g.K0);
    if (wr == 1) PG8_BAR;
    PG8_WAIT_V(2); PG8_BAR;
    PG8_STAGE(PG8_SB(1, 0), PG8_BPTR(cur.pn, 0, 1), RB2, g.K0); PG8_STAGE(PG8_SA(1, 0), PG8_APTR(cur.pm, 0, 1), RA2, g.K0); PG8_STAGE(PG8_SB(1, 1), PG8_BPTR(cur.pn, 1, 1), RB2, g.K0);
    PG8_WAIT_V(6); PG8_BAR;
    for (;;) {
        const bool has_next = S.next(ui + 1, nxt);
#pragma unroll 1
        for (int t = 0; t < nt; t += 2) {
            const bool last = (t == nt - 2);
            if (t == nt0) E.mid(acc, cur, wr, wc, fr, fq);
            const bool s1 = t >= nt0;
            const int t2 = last ? 0 : t + 2; const bool s2 = t2 >= nt0;
            const int pm2 = (last && has_next) ? nxt.pm : cur.pm, pn2 = (last && has_next) ? nxt.pn : cur.pn;
            const int Ks1 = s1 ? g.K1 : g.K0, Ks2 = s2 ? g.K1 : g.K0;
            const char* a1h1 = PG8_APTR(cur.pm, 1, t + 1);
            const char* a2h0 = PG8_APTR(pm2, 0, t2); const char* a2h1 = PG8_APTR(pm2, 1, t2);
            const char* b2h0 = PG8_BPTR(pn2, 0, t2); const char* b2h1 = PG8_BPTR(pn2, 1, t2);
            PG8_LDB(B0, 0, 0); PG8_LDB(B1, 0, 1); PG8_SCHED; PG8_LDA(At, 0, 0); PG8_STAGE(PG8_SA(1, 1), a1h1, RA2, Ks1);
            PG8_WAIT_V(8); PG8_WAIT_L(0); PG8_BAR; PG8_MMA(0, 0, At, B0); PG8_MMA(0, 1, At, B1); PG8_BAR; PG8_SCHED;
            PG8_LDA(At, 0, 1); PG8_STAGE(PG8_SB(0, 0), b2h0, RB2, Ks2); PG8_STAGE(PG8_SB(0, 1), b2h1, RB2, Ks2); PG8_STAGE(PG8_SA(0, 0), a2h0, RA2, Ks2);
            PG8_WAIT_V(8); PG8_WAIT_L(0); PG8_BAR; PG8_MMA(1, 0, At, B0); PG8_MMA(1, 1, At, B1); PG8_BAR; PG8_SCHED;
            PG8_LDB(B0, 1, 0); PG8_LDB(B1, 1, 1); PG8_SCHED; PG8_LDA(At, 1, 0); PG8_STAGE(PG8_SA(0, 1), a2h1, RA2, Ks2);
            PG8_WAIT_V(8); PG8_WAIT_L(0); PG8_BAR; PG8_MMA(0, 0, At, B0); PG8_MMA(0, 1, At, B1); PG8_BAR; PG8_SCHED;
            PG8_LDA(At, 1, 1); PG8_STAGE(PG8_SB(1, 0), b2h0 + kstep, RB2, Ks2); PG8_STAGE(PG8_SB(1, 1), b2h1 + kstep, RB2, Ks2); PG8_STAGE(PG8_SA(1, 0), a2h0 + kstep, RA2, Ks2);
            PG8_WAIT_V(8); PG8_WAIT_L(0); PG8_BAR; PG8_MMA(1, 0, At, B0); PG8_MMA(1, 1, At, B1); PG8_BAR; PG8_SCHED;
        }
        if constexpr (ALIGN_EPI) { if (wr == 0) PG8_BAR; }
        E(acc, cur, wr, wc, fr, fq);
        if (!has_next) break;
#pragma unroll
        for (int a = 0; a < 2; ++a)
#pragma unroll
            for (int b = 0; b < 2; ++b)
#pragma unroll
                for (int m = 0; m < 4; ++m)
#pragma unroll
                    for (int n = 0; n < 2; ++n) acc[a][b][m][n] = (f32x4){0.f, 0.f, 0.f, 0.f};
        cur = nxt; ++ui;
        if constexpr (ALIGN_EPI) { if (wr == 1) PG8_BAR; }
    }
    PG8_WAIT_V(0);
    if constexpr (!ALIGN_EPI) { if (wr == 0) PG8_BAR; }
    PG8_BAR;
#undef PG8_SA
#undef PG8_SB
#undef PG8_STAGE
#undef PG8_LDA
#undef PG8_LDB
#undef PG8_MMA
#undef PG8_WAIT_V
#undef PG8_WAIT_L
#undef PG8_BAR
#undef PG8_SCHED
#undef PG8_APTR
#undef PG8_BPTR
}
struct GemmGM { const bf16_t* XB; const bf16_t* WinT; const bf16_t* AO; const bf16_t* WpaT; const bf16_t* DIFF; const bf16_t* WeffT; const float* bias; bf16_t* MIXED; };
template <class Sched>
__device__ __forceinline__ void gemm_phase_gm(PG8_LAS unsigned char* lds, const GemmGM g, const Sched& S) {
    const int tid = threadIdx.x, wid = __builtin_amdgcn_readfirstlane(tid >> 6), lane = tid & 63, wr = wid >> 2, wc = wid & 3, fr = lane & 15, fq = lane >> 4;
    constexpr int NTG = DM / BK, NTA = AOW / BK, NTP = POOLW / BK, NT = NTG + NTA + NTP;
    static_assert(NTG % 2 == 0 && NTA % 2 == 0 && NTP % 2 == 0, "segment boundaries on even K-tiles");
    unsigned RCB[2];
#pragma unroll
    for (int i = 0; i < 2; ++i) { int R, C; stage_rc(tid * 16 + i * 8192, R, C); const int Rb = (R & ~31) + perm32(R & 31);
        RCB[i] = ((unsigned)Rb << 16) | ((unsigned)R << 8) | (unsigned)C; }
    const size_t kstep = (size_t)(BK * 2);
    const unsigned ldsw = (unsigned)wid * 1024u;
    const int aoff = lds_byte(wr * 64 + fr, fq * 8), boff = lds_byte(wc * 32 + fr, fq * 8);
#define PG8_SA(b, h) (((b) * 2 + (h)) * HTB)
#define PG8_SB(b, h) ((4 + (b) * 2 + (h)) * HTB)
#define RA2 8
#define RB2 16
#define PG8_STAGE(bufoff, gbase, SH, Kb) do { _Pragma("unroll") for (int _i = 0; _i < 2; ++_i) \
        __builtin_amdgcn_global_load_lds((const unsigned*)((const char*)(gbase) + ((((RCB[_i] >> (SH)) & 0xffu) * (unsigned)(Kb) + (RCB[_i] & 0xffu)) * 2u)), (PG8_LAS unsigned*)(lds + (bufoff) + ldsw + _i * 8192), 16, 0, 0); } while (0)
#define PG8_LDA(dst, b, h) do { _Pragma("unroll") for (int m = 0; m < 4; ++m) _Pragma("unroll") for (int k = 0; k < 2; ++k) dst[m][k] = *(const PG8_LAS bf16x8*)(lds + PG8_SA(b, h) + aoff + m * 2048 + k * 1024); } while (0)
#define PG8_LDB(dst, b, h) do { _Pragma("unroll") for (int n = 0; n < 2; ++n) _Pragma("unroll") for (int k = 0; k < 2; ++k) dst[n][k] = *(const PG8_LAS bf16x8*)(lds + PG8_SB(b, h) + boff + n * 2048 + k * 1024); } while (0)
#define PG8_MMA(ai, bj, At, Bt) do { __builtin_amdgcn_s_setprio(1); _Pragma("unroll") for (int m = 0; m < 4; ++m) _Pragma("unroll") for (int n = 0; n < 2; ++n) _Pragma("unroll") for (int k = 0; k < 2; ++k) \
        acc[ai][bj][m][n] = __builtin_amdgcn_mfma_f32_16x16x32_bf16(Bt[n][k], At[m][k], acc[ai][bj][m][n], 0, 0, 0); __builtin_amdgcn_s_setprio(0); } while (0)
#define PG8_WAIT_V(n) asm volatile("s_waitcnt vmcnt(" #n ")" ::: "memory")
#define PG8_WAIT_L(n) asm volatile("s_waitcnt lgkmcnt(" #n ")" ::: "memory")
#define PG8_BAR __builtin_amdgcn_s_barrier()
#define PG8_SCHED __builtin_amdgcn_sched_barrier(0)
    int kG = DM, kA = AOW, kP = POOLW; asm volatile("" : "+s"(kG), "+s"(kA), "+s"(kP));
#define GM_K(tt) ((tt) < NTG ? kG : ((tt) < NTG + NTA ? kA : kP))
#define GM_APTR(pm_, h, tt) ((tt) < NTG ? (const char*)g.XB + ((size_t)((pm_) * BM + (h) * HALF) * DM + (size_t)(tt) * BK) * 2 : \
        ((tt) < NTG + NTA ? (const char*)g.AO + ((size_t)((pm_) * BM + (h) * HALF) * AOW + (size_t)((tt) - NTG) * BK) * 2 : (const char*)g.DIFF + ((size_t)((pm_) * BM + (h) * HALF) * POOLW + (size_t)((tt) - NTG - NTA) * BK) * 2))
#define GM_BPTR(tc_, h, tt) ((tt) < NTG ? (const char*)g.WinT + ((size_t)((11 + (tc_)) * BM + (h) * HALF) * DM + (size_t)(tt) * BK) * 2 : \
        ((tt) < NTG + NTA ? (const char*)g.WpaT + ((size_t)((tc_) * HALF) * AOW + (size_t)((tt) - NTG) * BK) * 2 : (const char*)g.WeffT + ((size_t)((tc_) * HALF) * POOLW + (size_t)((tt) - NTG - NTA) * BK) * 2))
#define GM_ITER(CM, SM) do { \
        PG8_LDB(B0, 0, 0); if (CM) PG8_LDB(B1, 0, 1); PG8_SCHED; PG8_LDA(At, 0, 0); PG8_STAGE(PG8_SA(1, 1), a1h1, RA2, Kc); \
        if (CM) PG8_WAIT_V(8); else PG8_WAIT_V(6); PG8_WAIT_L(0); PG8_BAR; PG8_MMA(0, 0, At, B0); if (CM) PG8_MMA(0, 1, At, B1); PG8_BAR; PG8_SCHED; \
        PG8_LDA(At, 0, 1); PG8_STAGE(PG8_SB(0, 0), b2h0, RB2, Ks); if (SM) PG8_STAGE(PG8_SB(0, 1), b2h1, RB2, Ks); PG8_STAGE(PG8_SA(0, 0), a2h0, RA2, Ks); \
        if (SM) PG8_WAIT_V(8); else PG8_WAIT_V(6); PG8_WAIT_L(0); PG8_BAR; PG8_MMA(1, 0, At, B0); if (CM) PG8_MMA(1, 1, At, B1); PG8_BAR; PG8_SCHED; \
        PG8_LDB(B0, 1, 0); if (CM) PG8_LDB(B1, 1, 1); PG8_SCHED; PG8_LDA(At, 1, 0); PG8_STAGE(PG8_SA(0, 1), a2h1, RA2, Ks); \
        if (SM) PG8_WAIT_V(8); else PG8_WAIT_V(6); PG8_WAIT_L(0); PG8_BAR; PG8_MMA(0, 0, At, B0); if (CM) PG8_MMA(0, 1, At, B1); PG8_BAR; PG8_SCHED; \
        PG8_LDA(At, 1, 1); PG8_STAGE(PG8_SB(1, 0), b2h0 + kstep, RB2, Ks); if (SM) PG8_STAGE(PG8_SB(1, 1), b2h1 + kstep, RB2, Ks); PG8_STAGE(PG8_SA(1, 0), a2h0 + kstep, RA2, Ks); \
        if (SM) PG8_WAIT_V(8); else PG8_WAIT_V(6); PG8_WAIT_L(0); PG8_BAR; PG8_MMA(1, 0, At, B0); if (CM) PG8_MMA(1, 1, At, B1); PG8_BAR; PG8_SCHED; } while (0)
    Unit cur, nxt; int ui = 0;
    if (!S.next(0, cur)) return;
    f32x4 acc[2][2][4][2];
#pragma unroll
    for (int a = 0; a < 2; ++a)
#pragma unroll
        for (int b = 0; b < 2; ++b)
#pragma unroll
            for (int m = 0; m < 4; ++m)
#pragma unroll
                for (int n = 0; n < 2; ++n) acc[a][b][m][n] = (f32x4){0.f, 0.f, 0.f, 0.f};
    bf16x8 At[4][2], B0[2][2], B1[2][2];
    PG8_STAGE(PG8_SB(0, 0), GM_BPTR(cur.pn, 0, 0), RB2, kG); PG8_STAGE(PG8_SB(0, 1), GM_BPTR(cur.pn, 1, 0), RB2, kG); PG8_STAGE(PG8_SA(0, 0), GM_APTR(cur.pm, 0, 0), RA2, kG); PG8_STAGE(PG8_SA(0, 1), GM_APTR(cur.pm, 1, 0), RA2, kG);
    if (wr == 1) PG8_BAR;
    PG8_WAIT_V(2); PG8_BAR;
    PG8_STAGE(PG8_SB(1, 0), GM_BPTR(cur.pn, 0, 1), RB2, kG); PG8_STAGE(PG8_SA(1, 0), GM_APTR(cur.pm, 0, 1), RA2, kG); PG8_STAGE(PG8_SB(1, 1), GM_BPTR(cur.pn, 1, 1), RB2, kG);
    PG8_WAIT_V(6); PG8_BAR;
    for (;;) {
        const bool has_next = S.next(ui + 1, nxt);
        u32x2 rho[2][4][2], sgb[2][4][2];
#define GM_SETUP(t_, last_) const int t2 = (last_) ? 0 : (t_) + 2; const int pm2 = ((last_) && has_next) ? nxt.pm : cur.pm, tc2 = ((last_) && has_next) ? nxt.pn : cur.pn; \
            int Kc = GM_K(t_), Ks = GM_K(t2); asm volatile("" : "+s"(Kc), "+s"(Ks)); const char* a1h1 = GM_APTR(cur.pm, 1, (t_) + 1); \
            const char* a2h0 = GM_APTR(pm2, 0, t2); const char* a2h1 = GM_APTR(pm2, 1, t2); const char* b2h0 = GM_BPTR(tc2, 0, t2); const char* b2h1 = GM_BPTR(tc2, 1, t2)
#pragma unroll 1
        for (int t = 0; t < NTG - 2; t += 2) { GM_SETUP(t, false); GM_ITER(1, 1); }
        { GM_SETUP(NTG - 2, false); GM_ITER(1, 0); }
        {
            int lc0 = wc * 32 + 8 * fq; asm volatile("" : "+v"(lc0));
            const float* bga = g.bias + GA_OFF + cur.pn * HALF + lc0; const float* bgb = g.bias + GB_OFF + cur.pn * HALF + lc0;
            const f32x4 ba0 = *(const f32x4*)bga, ba1 = *(const f32x4*)(bga + 4), bb0 = *(const f32x4*)bgb, bb1 = *(const f32x4*)(bgb + 4);
#pragma unroll
            for (int ai = 0; ai < 2; ++ai)
#pragma unroll
                for (int m = 0; m < 4; ++m)
#pragma unroll
                    for (int n = 0; n < 2; ++n) { const f32x4 ga = acc[ai][0][m][n] + (n ? ba1 : ba0), gb = acc[ai][1][m][n] + (n ? bb1 : bb0); float r[4], sb[4];
#pragma unroll
                        for (int i = 0; i < 4; ++i) { sb[i] = fsig_gate(gb[i]); r[i] = fsig(ga[i]) * __builtin_amdgcn_rcpf(sb[i]); }
                        rho[ai][m][n].x = cvt_pk_bf16(r[0], r[1]); rho[ai][m][n].y = cvt_pk_bf16(r[2], r[3]); sgb[ai][m][n].x = cvt_pk_bf16(sb[0], sb[1]); sgb[ai][m][n].y = cvt_pk_bf16(sb[2], sb[3]);
                        acc[ai][0][m][n] = (f32x4){0.f, 0.f, 0.f, 0.f}; }
        }
#pragma unroll 1
        for (int t = NTG; t < NTG + NTA; t += 2) { GM_SETUP(t, false); GM_ITER(0, 0); }
#pragma unroll
        for (int ai = 0; ai < 2; ++ai)
#pragma unroll
            for (int m = 0; m < 4; ++m)
#pragma unroll
                for (int n = 0; n < 2; ++n) { f32x4& v = acc[ai][0][m][n]; const u32x2 rr = rho[ai][m][n]; v[0] *= bflo(rr.x); v[1] *= bfhi(rr.x); v[2] *= bflo(rr.y); v[3] *= bfhi(rr.y); }
#pragma unroll 1
        for (int t = NTG + NTA; t < NT - 2; t += 2) { GM_SETUP(t, false); GM_ITER(0, 0); }
        { GM_SETUP(NT - 2, true); GM_ITER(0, 1); }
        if (wr == 0) PG8_BAR;
        {
            const int row0 = cur.pm * BM + wr * 64 + fr, col0 = cur.pn * HALF + wc * 32 + 8 * fq;
#pragma unroll
            for (int ai = 0; ai < 2; ++ai)
#pragma unroll
                for (int m = 0; m < 4; ++m) { const f32x4 v0 = acc[ai][0][m][0], v1 = acc[ai][0][m][1]; const u32x2 s0 = sgb[ai][m][0], s1 = sgb[ai][m][1];
                    u32x4 w; w.x = cvt_pk_bf16(v0[0] * bflo(s0.x), v0[1] * bfhi(s0.x)); w.y = cvt_pk_bf16(v0[2] * bflo(s0.y), v0[3] * bfhi(s0.y));
                    w.z = cvt_pk_bf16(v1[0] * bflo(s1.x), v1[1] * bfhi(s1.x)); w.w = cvt_pk_bf16(v1[2] * bflo(s1.y), v1[3] * bfhi(s1.y));
                    *(u32x4*)(g.MIXED + (size_t)(row0 + ai * HALF + m * 16) * DM + col0) = w; }
        }
        if (!has_next) break;
#pragma unroll
        for (int a = 0; a < 2; ++a)
#pragma unroll
            for (int b = 0; b < 2; ++b)
#pragma unroll
                for (int m = 0; m < 4; ++m)
#pragma unroll
                    for (int n = 0; n < 2; ++n) acc[a][b][m][n] = (f32x4){0.f, 0.f, 0.f, 0.f};
        cur = nxt; ++ui;
        if (wr == 1) PG8_BAR;
    }
    PG8_WAIT_V(0);
    PG8_BAR;
#undef PG8_SA
#undef PG8_SB
#undef PG8_STAGE
#undef PG8_LDA
#undef PG8_LDB
#undef PG8_MMA
#undef PG8_WAIT_V
#undef PG8_WAIT_L
#undef PG8_BAR
#undef PG8_SCHED
#undef GM_K
#undef GM_APTR
#undef GM_BPTR
#undef GM_ITER
#undef GM_SETUP
#undef RA2
#undef RB2
}
}

constexpr int NWAVES = 8;
constexpr int RING_OFF = 0, RING_BYTES = 131072;
constexpr int ATTN_LDS = 147456;
constexpr int BIAS_OFF = ATTN_LDS;
constexpr int LDSCTL_OFF = BIAS_OFF + 3 * 4 * 192 * 4;
constexpr int MISC_OFF = LDSCTL_OFF, TILE_E_OFF = LDSCTL_OFF + 256, FIRST_OFF = TILE_E_OFF + 320 * 4;
constexpr int LDS_BYTES = 163840;
static_assert(FIRST_OFF + 64 * 4 <= LDS_BYTES, "LDS map");
constexpr size_t WS_XB = WS_X1B;
constexpr size_t WT_WIN = WS_WT;
constexpr size_t WT_WPA = WT_WIN + (size_t)INW * DM * 2;
constexpr size_t WT_WEFF = WT_WPA + (size_t)DM * AOW * 2;
constexpr size_t WT_WOUT = WT_WEFF + (size_t)DM * POOLW * 2;
constexpr size_t WT_WGU = WT_WOUT + (size_t)DM * DM * 2;
constexpr size_t WT_WD = WT_WGU + (size_t)NEXP * 512 * DM * 2;
static_assert(WT_WD + (size_t)NEXP * DM * DEXP * 2 <= WS_CTL, "weights fit");
constexpr int CW_CNT = 0;
constexpr int CW_BAR = 4096;
constexpr int CW_READY = 8192;
constexpr int CW_Q9 = 30720, CW_TMO = 30784;
constexpr size_t CTL_ZERO_BYTES = 262144;

#define GAS __attribute__((address_space(1)))
#define LAS __attribute__((address_space(3)))
typedef GAS unsigned gu32;
#define RLX_AGENT __ATOMIC_RELAXED, __HIP_MEMORY_SCOPE_AGENT
#define LDS_WAIT() asm volatile("s_waitcnt lgkmcnt(0)" ::: "memory")
#define VM_WAIT() asm volatile("s_waitcnt vmcnt(0)" ::: "memory")
typedef unsigned v4u __attribute__((ext_vector_type(4)));
__device__ __forceinline__ unsigned pk2(float lo, float hi) { return (unsigned)f2bf(lo) | ((unsigned)f2bf(hi) << 16); }

#define XB_TMO      128
#define XB_XCNT(j)  (256  + 64 * (j))
#define XB_XSUB(j)  (1280 + 64 * (j))
#define XB_XGEN(j)  (2304 + 64 * (j))
#define XB_TOP      3328
#define XB_TOPGEN   3392
#define XCD_BAR_WORDS 3456
#define XB_SPIN_CAP (1u << 18)

__device__ __forceinline__ unsigned xb_ld(unsigned* p)              { return __hip_atomic_load(p, __ATOMIC_RELAXED, __HIP_MEMORY_SCOPE_AGENT); }
__device__ __forceinline__ unsigned xb_add(unsigned* p, unsigned v) { return __hip_atomic_fetch_add(p, v, __ATOMIC_RELAXED, __HIP_MEMORY_SCOPE_AGENT); }
__device__ __forceinline__ unsigned xb_xcc_id() { return (unsigned)__builtin_amdgcn_s_getreg((3 << 11) | 20) & 0xFu; }
#define XB_SPIN(cond, bar) do { unsigned _sp = 0; while (cond) { __builtin_amdgcn_s_sleep(1); \
    if ((++_sp & 255u) == 0u) { if (xb_ld(&(bar)[XB_TMO])) break; if (_sp > XB_SPIN_CAP) { atomicAdd(&(bar)[XB_TMO], 1u); break; } } } } while (0)

struct XcdBarrier {
    unsigned* bar; unsigned x;
    volatile LAS unsigned* st;
};

__device__ __forceinline__ XcdBarrier xcd_barrier_post(unsigned* bar, volatile LAS unsigned* st) {
    XcdBarrier b; b.bar = bar; b.x = xb_xcc_id(); b.st = st;
    if (threadIdx.x == 0) (void)xb_add(&bar[XB_XCNT(b.x)], 1u);
    return b;
}
__device__ __forceinline__ void xcd_barrier_complete(unsigned* bar, unsigned x, unsigned& nloc, unsigned& nx) {
    const unsigned G = gridDim.x * gridDim.y * gridDim.z;
    unsigned sum, cnt, mine, sp = 0u;
    for (;;) {
        sum = 0u; cnt = 0u; mine = 0u;
#pragma unroll
        for (unsigned j = 0; j < 16; ++j) { const unsigned c = xb_ld(&bar[XB_XCNT(j)]); sum += c; cnt += (c > 0u) ? 1u : 0u; mine = (j == x) ? c : mine; }
        if (sum == G) break;
        __builtin_amdgcn_s_sleep(1);
        if ((++sp & 255u) == 0u) { if (xb_ld(&bar[XB_TMO])) break; if (sp > XB_SPIN_CAP) { atomicAdd(&bar[XB_TMO], 1u); break; } }
    }
    nloc = mine > 0u ? mine : 1u; nx = cnt > 0u ? cnt : 1u;
}

__device__ __forceinline__ void xcd_barrier(const XcdBarrier& b) {
    asm volatile("s_waitcnt vmcnt(0)" ::: "memory");
    __syncthreads();
    if (threadIdx.x == 0) {
        unsigned* bar = b.bar;
        __builtin_amdgcn_s_waitcnt(0);
        unsigned nloc = b.st[0], nx = b.st[1];
        if (nloc == 0u) { xcd_barrier_complete(bar, b.x, nloc, nx); b.st[0] = nloc; b.st[1] = nx; }
        const unsigned old = xb_add(&bar[XB_XSUB(b.x)], 1u);
        const unsigned gen = old / nloc;
        if (old + 1u == (gen + 1u) * nloc) {
            __builtin_amdgcn_fence(__ATOMIC_RELEASE, "agent");
            asm volatile("s_waitcnt vmcnt(0)" ::: "memory");
            const unsigned og = xb_add(&bar[XB_TOP], 1u);
            const unsigned tg = og / nx;
            if (og + 1u == (tg + 1u) * nx) xb_add(&bar[XB_TOPGEN], 1u);
            else XB_SPIN(xb_ld(&bar[XB_TOPGEN]) == tg, bar);
            __builtin_amdgcn_fence(__ATOMIC_ACQUIRE, "agent");
            xb_add(&bar[XB_XGEN(b.x)], 1u);
            asm volatile("s_waitcnt vmcnt(0)" ::: "memory");
        } else {
            XB_SPIN(xb_ld(&bar[XB_XGEN(b.x)]) == gen, bar);
            __builtin_amdgcn_fence(__ATOMIC_ACQUIRE, "agent");
            asm volatile("s_waitcnt vmcnt(0)" ::: "memory");
        }
    }
    __syncthreads();
}


struct Frame {
    LAS unsigned char* lds;
    int tid, lane, wave, vcu, G;
};
struct MArgs { const float* in[20]; float* out; unsigned char* ws; int ph_lo, ph_hi; };

struct TrItem { const float* W; bf16_t* WT; int K, N, k0, n0, drow0; };
__device__ __forceinline__ void tr_load(const TrItem& t, float (&v)[32], int lane) {
#pragma unroll
    for (int i = 0; i < 32; ++i) v[i] = t.W[(size_t)(t.k0 + 2 * i + (lane >> 5)) * t.N + t.n0 + (lane & 31)];
}
__device__ __forceinline__ void tr_store(const TrItem& t, const float (&v)[32], LAS float* scr, int lane) {
#pragma unroll
    for (int i = 0; i < 32; ++i) scr[(2 * i + (lane >> 5)) * 33 + (lane & 31)] = v[i];
    LDS_WAIT(); asm volatile("" ::: "memory");
    const int c = lane & 7;
#pragma unroll
    for (int j = 0; j < 4; ++j) { const int n = (lane >> 3) + 8 * j; const LAS float* s = scr + (8 * c) * 33 + n;
        v4u o; o.x = pk2(s[0 * 33], s[1 * 33]); o.y = pk2(s[2 * 33], s[3 * 33]); o.z = pk2(s[4 * 33], s[5 * 33]); o.w = pk2(s[6 * 33], s[7 * 33]);
        *(GAS v4u*)(t.WT + (size_t)(t.drow0 + n) * t.K + t.k0 + 8 * c) = o; }
    LDS_WAIT(); asm volatile("" ::: "memory");
}
constexpr int TR_IN = (DM / 64) * (INW / 32), TR_PA = (AOW / 64) * (DM / 32), TR_OUT = (DM / 64) * (DM / 32), TR_G = (DM / 64) * (DEXP / 32), TR_D = (DEXP / 64) * (DM / 32);
constexpr int TR_DENSE = TR_IN + TR_PA + TR_OUT, TR_EXP = NEXP * (2 * TR_G + TR_D);
__device__ __forceinline__ TrItem tr_item(const MArgs& a, int it) {
    unsigned char* ws = a.ws; TrItem t; int r = it;
    if (r < TR_IN) { const int nb = INW / 32; t.W = a.in[1]; t.WT = (bf16_t*)(ws + WT_WIN); t.K = DM; t.N = INW; t.k0 = (r / nb) * 64; t.n0 = (r % nb) * 32;
        t.drow0 = t.n0 < GA_OFF ? t.n0 : (t.n0 < GB_OFF ? GA_OFF + ((t.n0 - GA_OFF) >> 7) * 256 + ((t.n0 - GA_OFF) & 127) : GA_OFF + ((t.n0 - GB_OFF) >> 7) * 256 + 128 + ((t.n0 - GB_OFF) & 127)); return t; } r -= TR_IN;
    if (r < TR_PA) { const int nb = DM / 32; t.W = a.in[6]; t.WT = (bf16_t*)(ws + WT_WPA); t.K = AOW; t.N = DM; t.k0 = (r / nb) * 64; t.n0 = (r % nb) * 32; t.drow0 = t.n0; return t; } r -= TR_PA;
    if (r < TR_OUT) { const int nb = DM / 32; t.W = a.in[8]; t.WT = (bf16_t*)(ws + WT_WOUT); t.K = DM; t.N = DM; t.k0 = (r / nb) * 64; t.n0 = (r % nb) * 32; t.drow0 = t.n0; return t; } r -= TR_OUT;
    const int e = r / (2 * TR_G + TR_D); r -= e * (2 * TR_G + TR_D);
    if (r < 2 * TR_G) { const int up = r >= TR_G; if (up) r -= TR_G; const int nb = DEXP / 32; t.W = (up ? a.in[16] : a.in[15]) + (size_t)e * DM * DEXP; t.WT = (bf16_t*)(ws + WT_WGU); t.K = DM; t.N = DEXP;
        t.k0 = (r / nb) * 64; t.n0 = (r % nb) * 32; t.drow0 = e * 512 + (t.n0 >> 7) * 256 + up * 128 + (t.n0 & 127); return t; }
    r -= 2 * TR_G;
    { const int nb = DM / 32; t.W = a.in[17] + (size_t)e * DEXP * DM; t.WT = (bf16_t*)(ws + WT_WD) + (size_t)e * DM * DEXP; t.K = DEXP; t.N = DM; t.k0 = (r / nb) * 64; t.n0 = (r % nb) * 32; t.drow0 = t.n0; return t; }
}
__device__ __forceinline__ void tr_run(Frame& F, const MArgs& a, int first, int stride, int end) {
    LAS float* scr = (LAS float*)(F.lds + RING_OFF + F.wave * 16384);
    if (first >= end) return;
    float vn[32]; TrItem tn = tr_item(a, first); tr_load(tn, vn, F.lane);
    for (int it = first; it < end; it += stride) {
        float v[32]; TrItem t = tn;
#pragma unroll
        for (int i = 0; i < 32; ++i) v[i] = vn[i];
        if (it + stride < end) { tn = tr_item(a, it + stride); tr_load(tn, vn, F.lane); }
        tr_store(t, v, scr, F.lane);
    }
}
__device__ __forceinline__ void p0_prologue(Frame& F, const MArgs& a) {
    unsigned char* ws = a.ws;
    const int gw = F.vcu * NWAVES + F.wave, NGW = F.G * NWAVES, lane = F.lane;
    const float* w_pool = a.in[4]; const float* pscale = a.in[5]; const float* w_pp = a.in[7];
    bf16_t* WeffT = (bf16_t*)(ws + WT_WEFF);
    tr_run(F, a, gw, NGW, TR_DENSE);
    for (int it = gw; it < (DM / 32) * (POOLW / 32); it += NGW) {
        const int nb = it >> 4, kb = it & 15, g = kb >> 2, n0 = nb * 32, c0 = (kb & 3) * 32, rr = lane & 31, kk = lane >> 5;
        typedef float f32x16 __attribute__((ext_vector_type(16)));
        f32x16 acc = {0.f, 0.f, 0.f, 0.f, 0.f, 0.f, 0.f, 0.f, 0.f, 0.f, 0.f, 0.f, 0.f, 0.f, 0.f, 0.f};
        const float* ap = w_pp + (size_t)(g * 128 + kk) * DM + n0 + rr;
        const float* sp = pscale + g * 128 + kk;
        const float* bp = w_pool + (size_t)(g * 128 + c0 + rr) * 128 + kk;
#pragma unroll 16
        for (int ks = 0; ks < 64; ++ks) { const float av = ap[(size_t)(2 * ks) * DM] * sp[2 * ks], bv = bp[2 * ks];
            acc = __builtin_amdgcn_mfma_f32_32x32x2f32(av, bv, acc, 0, 0, 0); }
#pragma unroll
        for (int i = 0; i < 16; ++i) { const int n = n0 + (i & 3) + 8 * (i >> 2) + 4 * kk;
            WeffT[(size_t)n * POOLW + g * 128 + c0 + rr] = f2bf(acc[i]); }
    }
    const float* x = a.in[0]; bf16_t* XB = (bf16_t*)(ws + WS_XB);
    for (int it = gw * 8; it < NTOK * DM / 512; it += NGW * 8) {
        f32x4 a0[8], a1[8];
#pragma unroll
        for (int u = 0; u < 8; ++u) { const size_t o = (size_t)(it + u) * 512 + lane * 8; a0[u] = *(const f32x4*)(x + o); a1[u] = *(const f32x4*)(x + o + 4); }
#pragma unroll
        for (int u = 0; u < 8; ++u) { const size_t o = (size_t)(it + u) * 512 + lane * 8;
            v4u w; w.x = pk2(a0[u][0], a0[u][1]); w.y = pk2(a0[u][2], a0[u][3]); w.z = pk2(a1[u][0], a1[u][1]); w.w = pk2(a1[u][2], a1[u][3]);
            *(GAS v4u*)(XB + o) = w; } }
}

__device__ __forceinline__ int moe_tables(Frame& F, const int* cnt) {
    LAS int* tile_e = (LAS int*)(F.lds + TILE_E_OFF); LAS int* first = (LAS int*)(F.lds + FIRST_OFF);
    __syncthreads();
    if (F.tid < 64) {
        const int e = F.tid, nt = (e < NEXP) ? ((__hip_atomic_load(cnt + (e & 31) * 64, RLX_AGENT) + 255) >> 8) : 0;
        int incl = nt;
#pragma unroll
        for (int o = 1; o < 32; o <<= 1) { const int t = __shfl_up(incl, o); if ((e & 31) >= o) incl += t; }
        const int f0 = incl - nt;
        if (e < NEXP) { first[e] = f0; for (int i = 0; i < nt; ++i) tile_e[f0 + i] = e; if (e == NEXP - 1) first[NEXP] = incl; }
    }
    __syncthreads();
    return first[NEXP];
}


typedef float f32x16 __attribute__((ext_vector_type(16)));
typedef short s16x4 __attribute__((ext_vector_type(4)));
constexpr float LOG2E = 1.4426950408889634f;
constexpr float QSCALE = 0.125f * LOG2E;
constexpr int VROW = 192;
__device__ __forceinline__ s16x4 vtr(const LAS unsigned char* p) { return __builtin_bit_cast(s16x4, __builtin_amdgcn_ds_read_tr16_b64_v4i16((LAS s16x4*)p)); }
constexpr int AT_K = 0, AT_V0 = 49152, AT_V1 = 98304;
__device__ __forceinline__ void attn_unit_decode(int un, int& b, int& h, int& g, int& dil, int& L, int& c0, int& l0) {
    const int j = un & 7, bh = un >> 3; h = bh % 12; b = bh / 12; g = h >> 2; dil = 1 << (2 * g); L = SEQ >> (2 * g);
    if (g == 0) { c0 = 0; l0 = 256 * j; } else if (g == 1) { c0 = j >> 1; l0 = 256 * (j & 1); } else { c0 = 2 * j; l0 = 0; }
}
__device__ __forceinline__ size_t attn_krow(int b, int g, int L, int c0, int l0, int wr_) {
    if (g == 2) { const int cls = c0 + ((wr_ >> 7) & 1), l = wr_ & 127; return (size_t)b * SEQ + (size_t)cls * L + l; }
    int l = l0 - 128 + wr_; l = l < 0 ? 0 : l; return (size_t)b * SEQ + (size_t)c0 * L + l;
}
__device__ __forceinline__ void attn_wave_q(int g, int c0, int l0, int w, int& cq, int& lq0) { cq = (g == 2) ? c0 + (w >> 2) : c0; lq0 = (g == 2) ? 32 * (w & 3) : l0 + 32 * w; }
__device__ __forceinline__ void phase_attn(Frame& F, const MArgs& a, const bf16_t* proj, bf16_t* aog, float* lse) {
    LAS float* bias2 = (LAS float*)(F.lds + BIAS_OFF);
    const float* rel_bias = a.in[3];
    int tid0 = F.tid; asm volatile("" : "+v"(tid0));
    for (int i = tid0; i < 3 * 4 * 192; i += NWAVES * 64) { const int gs = i / 192, j = i - gs * 192 - 32, g = gs >> 2, dil = 1 << (2 * g);
        bias2[i] = (j >= 0 && j <= 128) ? rel_bias[t5_bucket(j * dil) * 12 + gs] * LOG2E : -1.0e30f; }
    asm volatile("s_waitcnt vmcnt(0) lgkmcnt(0)" ::: "memory"); __builtin_amdgcn_s_barrier(); asm volatile("" ::: "memory");
    LAS unsigned char* ring = F.lds;
    const unsigned lds0 = (unsigned)(size_t)F.lds;
    const int lane = F.lane, w = F.wave, r = lane & 31, hh = lane >> 5;
    const int NU = BATCH * 12 * 8;
    const int drow = lane >> 3, schunk = (lane & 7) ^ (lane >> 3);
    int koff[4];
#pragma unroll
    for (int ks = 0; ks < 4; ++ks) koff[ks] = r * 128 + ((((2 * ks + hh) ^ (r & 7))) << 4);
    const int trow = 4 * hh + ((lane & 15) >> 2);
    int toff[2];
#pragma unroll
    for (int dt = 0; dt < 2; ++dt) toff[dt] = trow * 128 + (((4 * dt + 2 * ((lane >> 4) & 1) + ((lane & 3) >> 1)) ^ (trow & 7)) << 4) + (lane & 1) * 8;
#define AT_DMA(dst_off, col_off) do { _Pragma("unroll") for (int _p = 0; _p < 6; ++_p) { const int _pc = w + 8 * _p; \
        const bf16_t* _src = proj + attn_krow(b_, g_, L_, c0_, l0_, _pc * 8 + drow) * INW + (col_off) + h_ * HD + schunk * 8; \
        unsigned _keep; const unsigned _dst = (unsigned)__builtin_amdgcn_readfirstlane((int)(lds0 + (unsigned)(dst_off) + (unsigned)_pc * 1024u)); \
        asm volatile("s_mov_b32 %0, m0\n\ts_mov_b32 m0, %2\n\ts_nop 0\n\tglobal_load_lds_dwordx4 %1, off\n\ts_mov_b32 m0, %0" : "=&s"(_keep) : "v"(_src), "s"(_dst) : "memory"); } } while (0)
#define AT_QLOAD(dst) do { int cq_, lq_; attn_wave_q(g_, c0_, l0_, w, cq_, lq_); const bf16_t* _qp = proj + ((size_t)b_ * SEQ + (size_t)cq_ * L_ + lq_ + r) * INW + Q_OFF + h_ * HD + 8 * hh; \
        _Pragma("unroll") for (int ks = 0; ks < 4; ++ks) dst[ks] = *(const bf16x8*)(_qp + 16 * ks); } while (0)
    bf16x8 qn[4];
    int un = F.vcu;
    { int b_, h_, g_, dil_, L_, c0_, l0_; attn_unit_decode(un, b_, h_, g_, dil_, L_, c0_, l0_); (void)dil_;
      AT_QLOAD(qn); AT_DMA(AT_K, K_OFF); AT_DMA(AT_V0, V_OFF); }
    bool first = true;
    for (int par = 0; un < NU; un += F.G, par ^= 1) {
        int b, h, g, dil, L, c0, l0; attn_unit_decode(un, b, h, g, dil, L, c0, l0);
        const bool has_next = (un + F.G) < NU;
        int cq, lq0; attn_wave_q(g, c0, l0, w, cq, lq0);
        const int wbase = (g == 2) ? 128 * (w >> 2) + 32 * (w & 3) - 128 : 32 * w;
        bf16x8 qf[4];
#pragma unroll
        for (int ks = 0; ks < 4; ++ks) qf[ks] = qn[ks];
        if (first) asm volatile("s_waitcnt vmcnt(0)" ::: "memory"); else asm volatile("s_waitcnt vmcnt(9)" ::: "memory");
        first = false;
        __builtin_amdgcn_s_barrier(); asm volatile("" ::: "memory");
        if (has_next) { int b_, h_, g_, dil_, L_, c0_, l0_; attn_unit_decode(un + F.G, b_, h_, g_, dil_, L_, c0_, l0_); (void)dil_;
            AT_QLOAD(qn); if (par == 0) AT_DMA(AT_V1, V_OFF); else AT_DMA(AT_V0, V_OFF); }
        f32x16 st[5];
#pragma unroll
        for (int kt = 0; kt < 5; ++kt) {
            int wrow = wbase + 32 * kt; if (g == 2) { const int lo_ = 128 * (w >> 2); wrow = wrow < lo_ ? lo_ : wrow; }
            f32x16 acc = {0.f, 0.f, 0.f, 0.f, 0.f, 0.f, 0.f, 0.f, 0.f, 0.f, 0.f, 0.f, 0.f, 0.f, 0.f, 0.f};
#pragma unroll
            for (int ks = 0; ks < 4; ++ks) { const bf16x8 kf = *(const LAS bf16x8*)(ring + AT_K + wrow * 128 + koff[ks]);
                acc = __builtin_amdgcn_mfma_f32_32x32x16_bf16(kf, qf[ks], acc, 0, 0, 0); }
            st[kt] = acc;
        }
        asm volatile("s_waitcnt lgkmcnt(0)" ::: "memory"); __builtin_amdgcn_s_barrier(); asm volatile("" ::: "memory");
        if (has_next) { int b_, h_, g_, dil_, L_, c0_, l0_; attn_unit_decode(un + F.G, b_, h_, g_, dil_, L_, c0_, l0_); (void)dil_; AT_DMA(AT_K, K_OFF); }
        const LAS float* bt = bias2 + h * 192 + 32 + 128 + (r - 4 * hh);
        float mx = -1.0e30f;
        if (lq0 >= 128) {
#pragma unroll
            for (int kt = 0; kt < 5; ++kt)
#pragma unroll
                for (int hb = 0; hb < 2; ++hb) { float bvv[8];
#pragma unroll
                    for (int i = 0; i < 8; ++i) bvv[i] = bt[-32 * kt - ((i & 3) + 8 * (2 * hb + (i >> 2)))];
                    asm volatile("" : "+v"(bvv[0]), "+v"(bvv[1]), "+v"(bvv[2]), "+v"(bvv[3]), "+v"(bvv[4]), "+v"(bvv[5]), "+v"(bvv[6]), "+v"(bvv[7]));
#pragma unroll
                    for (int i = 0; i < 8; ++i) { const float sv = st[kt][8 * hb + i] + bvv[i]; st[kt][8 * hb + i] = sv; mx = fmaxf(mx, sv); } }
        } else {
            const int jmax = lq0 + r, jl = 128 + r - 4 * hh;
#pragma unroll
            for (int kt = 0; kt < 5; ++kt)
#pragma unroll
                for (int hb = 0; hb < 2; ++hb) { float bvv[8];
#pragma unroll
                    for (int i = 0; i < 8; ++i) bvv[i] = bt[-32 * kt - ((i & 3) + 8 * (2 * hb + (i >> 2)))];
                    asm volatile("" : "+v"(bvv[0]), "+v"(bvv[1]), "+v"(bvv[2]), "+v"(bvv[3]), "+v"(bvv[4]), "+v"(bvv[5]), "+v"(bvv[6]), "+v"(bvv[7]));
#pragma unroll
                    for (int i = 0; i < 8; ++i) { const int jc = -32 * kt - ((i & 3) + 8 * (2 * hb + (i >> 2)));
                        const float sv = (jl + jc <= jmax) ? st[kt][8 * hb + i] + bvv[i] : -1.0e30f; st[kt][8 * hb + i] = sv; mx = fmaxf(mx, sv); } }
        }
        mx = fmaxf(mx, __shfl_xor(mx, 32));
        float lsum = 0.f;
#pragma unroll
        for (int kt = 0; kt < 5; ++kt)
#pragma unroll
            for (int i = 0; i < 16; ++i) { const float pv = __builtin_amdgcn_exp2f(st[kt][i] - mx); st[kt][i] = pv; lsum += pv; }
        lsum += __shfl_xor(lsum, 32);
        f32x16 o0 = {0.f, 0.f, 0.f, 0.f, 0.f, 0.f, 0.f, 0.f, 0.f, 0.f, 0.f, 0.f, 0.f, 0.f, 0.f, 0.f}, o1 = o0;
        const int vbuf = par ? AT_V1 : AT_V0;
#pragma unroll
        for (int kt = 0; kt < 5; ++kt) {
            int wrow = wbase + 32 * kt; if (g == 2) { const int lo_ = 128 * (w >> 2); wrow = wrow < lo_ ? lo_ : wrow; }
            const LAS unsigned char* vb = ring + vbuf + wrow * 128;
#pragma unroll
            for (int s2 = 0; s2 < 2; ++s2) {
                pg8::u32x4 pw; pw.x = pg8::cvt_pk_bf16(st[kt][8 * s2 + 0], st[kt][8 * s2 + 1]); pw.y = pg8::cvt_pk_bf16(st[kt][8 * s2 + 2], st[kt][8 * s2 + 3]);
                pw.z = pg8::cvt_pk_bf16(st[kt][8 * s2 + 4], st[kt][8 * s2 + 5]); pw.w = pg8::cvt_pk_bf16(st[kt][8 * s2 + 6], st[kt][8 * s2 + 7]);
                const bf16x8 pf = __builtin_bit_cast(bf16x8, pw);
#pragma unroll
                for (int dt = 0; dt < 2; ++dt) {
                    const s16x4 lo = vtr(vb + (16 * s2) * 128 + toff[dt]), hi = vtr(vb + (16 * s2 + 8) * 128 + toff[dt]);
                    const bf16x8 vf = {lo[0], lo[1], lo[2], lo[3], hi[0], hi[1], hi[2], hi[3]};
                    if (dt == 0) o0 = __builtin_amdgcn_mfma_f32_32x32x16_bf16(vf, pf, o0, 0, 0, 0); else o1 = __builtin_amdgcn_mfma_f32_32x32x16_bf16(vf, pf, o1, 0, 0, 0);
                }
            }
        }
        const float inv = 1.f / lsum;
        const int tok = b * SEQ + cq + dil * (lq0 + r);
        bf16_t* op = aog + ((size_t)g * NTOK + tok) * AOW + (h & 3) * HD + 4 * hh;
#pragma unroll
        for (int dt = 0; dt < 2; ++dt)
#pragma unroll
            for (int q4 = 0; q4 < 4; ++q4) { const f32x16& o = dt == 0 ? o0 : o1;
                pg8::u32x2 wv; wv.x = pg8::cvt_pk_bf16(o[4 * q4] * inv, o[4 * q4 + 1] * inv); wv.y = pg8::cvt_pk_bf16(o[4 * q4 + 2] * inv, o[4 * q4 + 3] * inv);
                *(pg8::u32x2*)(op + 32 * dt + 8 * q4) = wv; }
        if (hh == 0) lse[((size_t)g * NTOK + tok) * 4 + (h & 3)] = mx + __builtin_amdgcn_logf(lsum);
        asm volatile("s_waitcnt lgkmcnt(0)" ::: "memory");
    }
    asm volatile("s_waitcnt vmcnt(0) lgkmcnt(0)" ::: "memory"); __builtin_amdgcn_s_barrier(); asm volatile("" ::: "memory");
#undef AT_DMA
#undef AT_QLOAD
}
template <int W, int NI> __device__ __forceinline__ void pool_items(const bf16_t* proj, bf16_t* diff, int tok0, int ch) {
    pg8::u32x4 v[NI][W];
#pragma unroll
    for (int u = 0; u < NI; ++u) { const int tok = tok0 + 8 * u, t = tok & (SEQ - 1); const bf16_t* p = proj + (size_t)tok * INW + POOL_OFF + ch * 8;
#pragma unroll
        for (int j = 0; j < W; ++j) v[u][j] = *(const pg8::u32x4*)(p - (size_t)((t >= j) ? j : 0) * INW); }
#pragma unroll
    for (int u = 0; u < NI; ++u) { const int tok = tok0 + 8 * u, t = tok & (SEQ - 1);
        float s[8];
#pragma unroll
        for (int e = 0; e < 8; ++e) s[e] = 0.f;
#pragma unroll
        for (int j = 0; j < W; ++j) { const float m = (t >= j) ? 1.f : 0.f;
            s[0] += m * pg8::bflo(v[u][j].x); s[1] += m * pg8::bfhi(v[u][j].x); s[2] += m * pg8::bflo(v[u][j].y); s[3] += m * pg8::bfhi(v[u][j].y);
            s[4] += m * pg8::bflo(v[u][j].z); s[5] += m * pg8::bfhi(v[u][j].z); s[6] += m * pg8::bflo(v[u][j].w); s[7] += m * pg8::bfhi(v[u][j].w); }
        const float ic = 1.f / (float)((t + 1 < W) ? t + 1 : W);
        pg8::u32x4 o;
        o.x = pg8::cvt_pk_bf16(s[0] * ic - pg8::bflo(v[u][0].x), s[1] * ic - pg8::bfhi(v[u][0].x)); o.y = pg8::cvt_pk_bf16(s[2] * ic - pg8::bflo(v[u][0].y), s[3] * ic - pg8::bfhi(v[u][0].y));
        o.z = pg8::cvt_pk_bf16(s[4] * ic - pg8::bflo(v[u][0].z), s[5] * ic - pg8::bfhi(v[u][0].z)); o.w = pg8::cvt_pk_bf16(s[6] * ic - pg8::bflo(v[u][0].w), s[7] * ic - pg8::bfhi(v[u][0].w));
        *(pg8::u32x4*)(diff + (size_t)tok * POOLW + ch * 8) = o; }
}
__device__ __forceinline__ void phase_pool(Frame& F, const bf16_t* proj, bf16_t* diff) {
    const int gw = F.vcu * NWAVES + F.wave, NGW = F.G * NWAVES, lane = F.lane;
    for (int it = gw; it < NTOK / 4; it += NGW) {
        const int tg = it >> 3, cg = ((it & 7) + 2 * (it / NGW)) & 7, tok0 = tg * 32 + (lane >> 3), ch = cg * 8 + (lane & 7), gi = cg >> 1;
        if (gi == 0) pool_items<2, 4>(proj, diff, tok0, ch); else if (gi == 1) pool_items<4, 4>(proj, diff, tok0, ch);
        else if (gi == 2) { pool_items<8, 2>(proj, diff, tok0, ch); pool_items<8, 2>(proj, diff, tok0 + 16, ch); }
        else { pool_items<16, 1>(proj, diff, tok0, ch); pool_items<16, 1>(proj, diff, tok0 + 8, ch); pool_items<16, 1>(proj, diff, tok0 + 16, ch); pool_items<16, 1>(proj, diff, tok0 + 24, ch); }
    }
}
__device__ __forceinline__ void phase_combine(Frame& F, const bf16_t* aog, const float* lse, bf16_t* ao) {
    const int gt = (F.vcu * NWAVES + F.wave) * 64 + F.lane, NGT = F.G * NWAVES * 64;
    for (int it = gt; it < NTOK * 32; it += NGT) {
        const int tok = it >> 5, ch = it & 31, slot = ch >> 3;
        const float l0 = lse[((size_t)0 * NTOK + tok) * 4 + slot], l1 = lse[((size_t)1 * NTOK + tok) * 4 + slot], l2 = lse[((size_t)2 * NTOK + tok) * 4 + slot];
        const float M = fmaxf(l0, fmaxf(l1, l2));
        float w0 = __builtin_amdgcn_exp2f(l0 - M), w1 = __builtin_amdgcn_exp2f(l1 - M), w2 = __builtin_amdgcn_exp2f(l2 - M);
        const float iw = 1.f / (w0 + w1 + w2); w0 *= iw; w1 *= iw; w2 *= iw;
        const pg8::u32x4 a0 = *(const pg8::u32x4*)(aog + ((size_t)0 * NTOK + tok) * AOW + ch * 8), a1 = *(const pg8::u32x4*)(aog + ((size_t)1 * NTOK + tok) * AOW + ch * 8),
                         a2 = *(const pg8::u32x4*)(aog + ((size_t)2 * NTOK + tok) * AOW + ch * 8);
        pg8::u32x4 o;
#define CMB(f) pg8::cvt_pk_bf16(w0 * pg8::bflo(a0.f) + w1 * pg8::bflo(a1.f) + w2 * pg8::bflo(a2.f), w0 * pg8::bfhi(a0.f) + w1 * pg8::bfhi(a1.f) + w2 * pg8::bfhi(a2.f))
        o.x = CMB(x); o.y = CMB(y); o.z = CMB(z); o.w = CMB(w);
#undef CMB
        *(pg8::u32x4*)(ao + (size_t)tok * AOW + ch * 8) = o;
    }
}

constexpr int XS = 1028;
__device__ __forceinline__ void phase_ln_router(Frame& F, const MArgs& a, const bf16_t* y, bf16_t* x1b, int* cnt, int* list, float* listw) {
    const float* x = a.in[0];
    LAS float* xs = (LAS float*)(F.lds + RING_OFF);
    LAS float* part = xs + 16 * XS;
    LAS float* lgs = part + 8 * 16 * 48;
    LAS unsigned* lcnt = (LAS unsigned*)(lgs + 8 * 16 * 40);
    LAS int* rtab = (LAS int*)(lcnt + 32);
    if (F.tid < 32) lcnt[F.tid] = 0u;
    const float* g1 = a.in[9]; const float* b1 = a.in[10]; const float* wrg = a.in[11]; const float* brg = a.in[12]; const float* wre = a.in[13]; const float* bre = a.in[14];
    LAS float* gb1 = (LAS float*)(F.lds + RING_OFF + 122880);
    { int tid0 = F.tid; asm volatile("" : "+v"(tid0)); for (int i = tid0; i < 2 * DM; i += NWAVES * 64) gb1[i] = (i < DM) ? g1[i] : b1[i - DM]; }
    __syncthreads();
    const int lane = F.lane, w = F.wave, t16 = lane & 15, q = lane >> 4, tid = F.tid;
    bf16x8 wBh[4][3], wBl[4][3];
#pragma unroll
    for (int ks = 0; ks < 4; ++ks)
#pragma unroll
        for (int ct = 0; ct < 3; ++ct) { const int o = 16 * ct + t16; float wv[8];
#pragma unroll
            for (int j = 0; j < 8; ++j) { const int k = 128 * w + 32 * ks + 8 * q + j; wv[j] = (o < 4) ? wrg[k * 4 + o] : ((o < 36) ? wre[k * 32 + o - 4] : 0.f); }
            pg8::u32x4 hw, lw;
#pragma unroll
            for (int j2 = 0; j2 < 4; ++j2) { const unsigned hp = pg8::cvt_pk_bf16(wv[2 * j2], wv[2 * j2 + 1]);
                const unsigned lp = pg8::cvt_pk_bf16(wv[2 * j2] - pg8::bflo(hp), wv[2 * j2 + 1] - pg8::bfhi(hp)); hw[j2] = hp; lw[j2] = lp; }
            wBh[ks][ct] = __builtin_bit_cast(bf16x8, hw); wBl[ks][ct] = __builtin_bit_cast(bf16x8, lw); }
    const int ntile = NTOK / 16;
    f32x4 vn[2][4]; pg8::u32x2 yn[2][4];
#define LNR_LOAD(T_) do { _Pragma("unroll") for (int rr = 0; rr < 2; ++rr) _Pragma("unroll") for (int j = 0; j < 4; ++j) { const size_t o_ = (size_t)(16 * (T_) + 2 * w + rr) * DM + lane * 4 + 256 * j; \
        vn[rr][j] = *(const f32x4*)(x + o_); yn[rr][j] = *(const pg8::u32x2*)(y + o_); } } while (0)
    LNR_LOAD(F.vcu);
    const float rb0 = ((tid % 36) < 4) ? brg[tid % 36] : bre[(tid % 36) - 4], rb1 = (((tid + NWAVES * 64) % 36) < 4) ? brg[(tid + NWAVES * 64) % 36] : bre[((tid + NWAVES * 64) % 36) - 4];
    int ti = 0;
    for (int T = F.vcu; T < ntile; T += F.G, ++ti) {
        f32x4 v[2][4];
#pragma unroll
        for (int rr = 0; rr < 2; ++rr)
#pragma unroll
            for (int j = 0; j < 4; ++j) { f32x4 z = vn[rr][j] * ALPHA; z[0] += pg8::bflo(yn[rr][j].x); z[1] += pg8::bfhi(yn[rr][j].x); z[2] += pg8::bflo(yn[rr][j].y); z[3] += pg8::bfhi(yn[rr][j].y); v[rr][j] = z; }
        if (T + F.G < ntile) LNR_LOAD(T + F.G);
#pragma unroll
        for (int rr = 0; rr < 2; ++rr) {
            const int tok = 16 * T + 2 * w + rr;
            float s = 0.f;
#pragma unroll
            for (int j = 0; j < 4; ++j) s += (v[rr][j][0] + v[rr][j][1]) + (v[rr][j][2] + v[rr][j][3]);
            const float mean = wave_sum(s) * (1.f / DM); float s2 = 0.f;
#pragma unroll
            for (int j = 0; j < 4; ++j) { const f32x4 d = v[rr][j] - mean; s2 += (d[0] * d[0] + d[1] * d[1]) + (d[2] * d[2] + d[3] * d[3]); }
            const float rstd = 1.f / sqrtf(wave_sum(s2) * (1.f / DM) + LN_EPS);
#pragma unroll
            for (int j = 0; j < 4; ++j) { const int k0 = lane * 4 + 256 * j;
                const f32x4 x1 = (v[rr][j] - mean) * rstd * *(const LAS f32x4*)(gb1 + k0) + *(const LAS f32x4*)(gb1 + DM + k0);
                *(LAS f32x4*)(xs + (2 * w + rr) * XS + k0) = x1;
                pg8::u32x2 pk; pk.x = pg8::cvt_pk_bf16(x1[0], x1[1]); pk.y = pg8::cvt_pk_bf16(x1[2], x1[3]);
                *(pg8::u32x2*)(x1b + (size_t)tok * DM + k0) = pk; }
        }
        __syncthreads();
        f32x4 acc[3];
#pragma unroll
        for (int ct = 0; ct < 3; ++ct) acc[ct] = (f32x4){0.f, 0.f, 0.f, 0.f};
        const LAS float* xr = xs + t16 * XS + 128 * w + 8 * q;
#pragma unroll
        for (int ks = 0; ks < 4; ++ks) { const f32x4 xa = *(const LAS f32x4*)(xr + 32 * ks), xb = *(const LAS f32x4*)(xr + 32 * ks + 4);
            pg8::u32x4 hw, lw;
            hw.x = pg8::cvt_pk_bf16(xa[0], xa[1]); hw.y = pg8::cvt_pk_bf16(xa[2], xa[3]); hw.z = pg8::cvt_pk_bf16(xb[0], xb[1]); hw.w = pg8::cvt_pk_bf16(xb[2], xb[3]);
            lw.x = pg8::cvt_pk_bf16(xa[0] - pg8::bflo(hw.x), xa[1] - pg8::bfhi(hw.x)); lw.y = pg8::cvt_pk_bf16(xa[2] - pg8::bflo(hw.y), xa[3] - pg8::bfhi(hw.y));
            lw.z = pg8::cvt_pk_bf16(xb[0] - pg8::bflo(hw.z), xb[1] - pg8::bfhi(hw.z)); lw.w = pg8::cvt_pk_bf16(xb[2] - pg8::bflo(hw.w), xb[3] - pg8::bfhi(hw.w));
            const bf16x8 ah = __builtin_bit_cast(bf16x8, hw), al = __builtin_bit_cast(bf16x8, lw);
#pragma unroll
            for (int ct = 0; ct < 3; ++ct) {
                acc[ct] = __builtin_amdgcn_mfma_f32_16x16x32_bf16(ah, wBh[ks][ct], acc[ct], 0, 0, 0);
                acc[ct] = __builtin_amdgcn_mfma_f32_16x16x32_bf16(al, wBh[ks][ct], acc[ct], 0, 0, 0);
                acc[ct] = __builtin_amdgcn_mfma_f32_16x16x32_bf16(ah, wBl[ks][ct], acc[ct], 0, 0, 0); } }
#pragma unroll
        for (int ct = 0; ct < 3; ++ct)
#pragma unroll
            for (int rg = 0; rg < 4; ++rg) part[(w * 16 + 4 * q + rg) * 48 + 16 * ct + t16] = acc[ct][rg];
        __syncthreads();
        for (int i = tid; i < 16 * 36; i += NWAVES * 64) { const int tk = i / 36, o = i - tk * 36; float sum = (i < NWAVES * 64) ? rb0 : rb1;
#pragma unroll
            for (int ww = 0; ww < 8; ++ww) sum += part[(ww * 16 + tk) * 48 + o];
            lgs[(ti * 16 + tk) * 40 + o] = sum; }
    }
#undef LNR_LOAD
    __syncthreads();
    for (int sl_ = tid; sl_ < ti * 16; sl_ += NWAVES * 64) {
        const LAS float* sl = lgs + sl_ * 40;
        int gi = 0; float gm = sl[0];
        for (int o = 1; o < 4; ++o) if (sl[o] > gm) { gm = sl[o]; gi = o; }
        float gs = 0.f; for (int o = 0; o < 4; ++o) gs += __expf(sl[o] - gm);
        const float gprob = 1.f / gs;
        const LAS float* el = sl + 4 + gi * 8;
        int i0 = 0; float l0 = el[0];
        for (int o = 1; o < 8; ++o) if (el[o] > l0) { l0 = el[o]; i0 = o; }
        int i1 = -1; float l1 = -3.0e38f;
        for (int o = 0; o < 8; ++o) if (o != i0 && el[o] > l1) { l1 = el[o]; i1 = o; }
        const float e1 = __expf(l1 - l0), w0 = gprob / (1.f + e1), w1 = gprob * e1 / (1.f + e1);
        const int ex0 = gi * 8 + i0, ex1 = gi * 8 + i1;
        const int r0 = (int)__hip_atomic_fetch_add(lcnt + ex0, 1u, __ATOMIC_RELAXED, __HIP_MEMORY_SCOPE_WORKGROUP), r1 = (int)__hip_atomic_fetch_add(lcnt + ex1, 1u, __ATOMIC_RELAXED, __HIP_MEMORY_SCOPE_WORKGROUP);
        rtab[sl_ * 4 + 0] = (ex0 << 16) | r0; rtab[sl_ * 4 + 1] = (ex1 << 16) | r1; ((LAS float*)rtab)[sl_ * 4 + 2] = w0; ((LAS float*)rtab)[sl_ * 4 + 3] = w1;
    }
    __syncthreads();
    if (tid < 32) { const unsigned n = lcnt[tid]; lcnt[tid] = n ? (unsigned)atomicAdd(&cnt[tid * 64], (int)n) : 0u; }
    __syncthreads();
    for (int sl_ = tid; sl_ < ti * 16; sl_ += NWAVES * 64) {
        const int tok = 16 * (F.vcu + (sl_ >> 4) * F.G) + (sl_ & 15);
        const int a0 = rtab[sl_ * 4 + 0], a1 = rtab[sl_ * 4 + 1]; const float w0 = ((LAS float*)rtab)[sl_ * 4 + 2], w1 = ((LAS float*)rtab)[sl_ * 4 + 3];
        const int ex0 = a0 >> 16, ex1 = a1 >> 16, r0 = (a0 & 0xffff) + (int)lcnt[ex0], r1 = (a1 & 0xffff) + (int)lcnt[ex1];
        list[ex0 * NTOK + r0] = tok * 2; listw[ex0 * NTOK + r0] = w0;
        list[ex1 * NTOK + r1] = tok * 2 + 1; listw[ex1 * NTOK + r1] = w1;
    }
}

__device__ __forceinline__ void phase_final(Frame& F, const MArgs& a, const bf16_t* x1b, const bf16_t* po) {
    const float* g2 = a.in[18]; const float* b2 = a.in[19];
    const int gw = F.vcu * NWAVES + F.wave, NGW = F.G * NWAVES, lane = F.lane;
    f32x4 gg2[4], bb2[4];
#pragma unroll
    for (int j = 0; j < 4; ++j) { gg2[j] = *(const f32x4*)(g2 + lane * 4 + 256 * j); bb2[j] = *(const f32x4*)(b2 + lane * 4 + 256 * j); }
    pg8::u32x2 xn[2][4], pan[2][4], pbn[2][4];
#define FIN_LOAD(base_) do { _Pragma("unroll") for (int u = 0; u < 2; ++u) { const int tk = (base_) + u; \
        _Pragma("unroll") for (int j = 0; j < 4; ++j) { const int k0 = lane * 4 + 256 * j; xn[u][j] = *(const pg8::u32x2*)(x1b + (size_t)tk * DM + k0); \
            pan[u][j] = *(const pg8::u32x2*)(po + (size_t)tk * 2 * DM + k0); pbn[u][j] = *(const pg8::u32x2*)(po + (size_t)tk * 2 * DM + DM + k0); } } } while (0)
    FIN_LOAD(gw * 2);
    for (int base = gw * 2; base < NTOK; base += NGW * 2) {
        f32x4 v[2][4]; float s[2] = {0.f, 0.f};
#pragma unroll
        for (int u = 0; u < 2; ++u)
#pragma unroll
            for (int j = 0; j < 4; ++j) { f32x4 t;
                t[0] = ALPHA * pg8::bflo(xn[u][j].x) + (pg8::bflo(pan[u][j].x) + pg8::bflo(pbn[u][j].x)); t[1] = ALPHA * pg8::bfhi(xn[u][j].x) + (pg8::bfhi(pan[u][j].x) + pg8::bfhi(pbn[u][j].x));
                t[2] = ALPHA * pg8::bflo(xn[u][j].y) + (pg8::bflo(pan[u][j].y) + pg8::bflo(pbn[u][j].y)); t[3] = ALPHA * pg8::bfhi(xn[u][j].y) + (pg8::bfhi(pan[u][j].y) + pg8::bfhi(pbn[u][j].y));
                v[u][j] = t; s[u] += (t[0] + t[1]) + (t[2] + t[3]); }
        if (base + NGW * 2 < NTOK) FIN_LOAD(base + NGW * 2);
#pragma unroll
        for (int u = 0; u < 2; ++u) {
            const float mean = wave_sum(s[u]) * (1.f / DM); float s2 = 0.f;
#pragma unroll
            for (int j = 0; j < 4; ++j) { v[u][j] = v[u][j] - mean; s2 += (v[u][j][0] * v[u][j][0] + v[u][j][1] * v[u][j][1]) + (v[u][j][2] * v[u][j][2] + v[u][j][3] * v[u][j][3]); }
            const float rstd = 1.f / sqrtf(wave_sum(s2) * (1.f / DM) + LN_EPS);
            float* row = a.out + (size_t)(base + u) * DM;
#pragma unroll
            for (int j = 0; j < 4; ++j) { const int k0 = lane * 4 + 256 * j; *(f32x4*)(row + k0) = v[u][j] * rstd * gg2[j] + bb2[j]; }
        }
    }
#undef FIN_LOAD
}


__global__ void __launch_bounds__(NWAVES * 64, 2) mega(MArgs args) {
    extern __shared__ __attribute__((aligned(16))) unsigned char lds[];
    Frame F;
    F.lds = (LAS unsigned char*)lds;
    F.tid = threadIdx.x; F.lane = F.tid & 63; F.wave = __builtin_amdgcn_readfirstlane(F.tid >> 6);
    F.G = gridDim.x; { const int bx = blockIdx.x; F.vcu = (F.G % 8 == 0) ? (bx % 8) * (F.G / 8) + bx / 8 : bx; }
    unsigned char* ws = args.ws;
    gu32* ctl = (gu32*)(ws + WS_CTL);
    { int tid0 = F.tid; asm volatile("" : "+v"(tid0)); for (int u = tid0; u < (LDS_BYTES - LDSCTL_OFF) / 4; u += NWAVES * 64) ((LAS unsigned*)(F.lds + LDSCTL_OFF))[u] = 0u; }
    __syncthreads();
    const int lo = args.ph_lo, hi = args.ph_hi;
    const bool multi = (hi - lo) > 1;
    XcdBarrier bar; bar.bar = (unsigned*)(ctl + CW_BAR); bar.x = 0; bar.st = nullptr;
    if (multi) bar = xcd_barrier_post((unsigned*)(ctl + CW_BAR), (volatile LAS unsigned*)(F.lds + MISC_OFF) + 8);
    bf16_t* PROJ = (bf16_t*)(ws + WS_PROJ); bf16_t* MIXED = (bf16_t*)(ws + WS_MIXED); bf16_t* X1B = (bf16_t*)(ws + WS_X1B); bf16_t* XB = (bf16_t*)(ws + WS_XB);
    bf16_t* HID = (bf16_t*)(ws + WS_HID); bf16_t* PO = (bf16_t*)(ws + WS_PO); bf16_t* Y = (bf16_t*)(ws + WS_Z);
    bf16_t* AO = (bf16_t*)((unsigned char*)args.out + DO_AO); bf16_t* DIFF = (bf16_t*)((unsigned char*)args.out + DO_DIFF);
    bf16_t* AOG = (bf16_t*)((unsigned char*)args.out + DO_AOG); float* LSE = (float*)((unsigned char*)args.out + DO_LSE);
    int* cnt = (int*)(ws + WS_CTL) + CW_CNT; int* list = (int*)(ws + WS_LIST); float* listw = (float*)(ws + WS_LISTW);
#define PHASE_0 p0_prologue(F, args);
#define PHASE_1 { pg8::Gemm g{XB, (const bf16_t*)(ws + WT_WIN), DM}; pg8::StaticOrder S; S.init(NTOK, GA_OFF, F.G, (int)blockIdx.x);     \
        pg8::EpiProj E{PROJ, args.in[2], QSCALE}; pg8::gemm_phase<pg8::EpiProj, pg8::StaticOrder, true>(F.lds + RING_OFF, g, S, E); \
          \
        { const int bx = (int)blockIdx.x; if (F.G == 256) { if (bx >= 128) tr_run(F, args, TR_DENSE + ((bx - 128) * NWAVES + F.wave), 1024, TR_DENSE + 10240); \
              else tr_run(F, args, TR_DENSE + 10240 + (bx * NWAVES + F.wave), 1024, TR_DENSE + TR_EXP); } \
          else tr_run(F, args, TR_DENSE + F.vcu * NWAVES + F.wave, F.G * NWAVES, TR_DENSE + TR_EXP); } }
#define PHASE_2 phase_attn(F, args, PROJ, AOG, LSE);
#define PHASE_3 { phase_pool(F, PROJ, DIFF); phase_combine(F, AOG, LSE, AO); }
#define PHASE_4 { pg8::GemmGM g{XB, (const bf16_t*)(ws + WT_WIN), AO, (const bf16_t*)(ws + WT_WPA), DIFF, (const bf16_t*)(ws + WT_WEFF), args.in[2], MIXED}; \
        pg8::StaticOrder S; S.init(NTOK, 2 * DM, F.G, (int)blockIdx.x);     \
        pg8::gemm_phase_gm<pg8::StaticOrder>(F.lds + RING_OFF, g, S); }
#define PHASE_5 { }
#define PHASE_6 { pg8::Gemm g{MIXED, (const bf16_t*)(ws + WT_WOUT), DM}; pg8::StaticOrder S; S.init(NTOK, DM, F.G, (int)blockIdx.x); \
        pg8::EpiY E{Y}; pg8::gemm_phase<pg8::EpiY, pg8::StaticOrder, true>(F.lds + RING_OFF, g, S, E); }
#define PHASE_7 phase_ln_router(F, args, Y, X1B, cnt, list, listw);
#define PHASE_8 { const int ntiles = moe_tables(F, cnt); { pg8::Gemm g{X1B, (const bf16_t*)(ws + WT_WGU), DM}; \
        pg8::MoeOrder S{(const LAS int*)(F.lds + TILE_E_OFF), (const LAS int*)(F.lds + FIRST_OFF), cnt, list, 2, F.G, F.vcu, ntiles, true, (unsigned*)(ctl + CW_READY)}; \
        pg8::EpiMoe1 E{HID, cnt, listw}; pg8::gemm_phase<pg8::EpiMoe1, pg8::MoeOrder, true>(F.lds + RING_OFF, g, S, E); } \
          \
        { pg8::Gemm g{HID, (const bf16_t*)(ws + WT_WD), DEXP}; \
        pg8::DynMoeOrder S{(const LAS int*)(F.lds + TILE_E_OFF), (const LAS int*)(F.lds + FIRST_OFF), 4, ntiles, (unsigned*)(ctl + CW_Q9), (const unsigned*)(ctl + CW_READY), 16u, (unsigned*)(ctl + CW_TMO), (volatile LAS int*)(F.lds + MISC_OFF + 64)}; \
        pg8::EpiMoe2 E{PO, cnt, list}; pg8::gemm_phase<pg8::EpiMoe2, pg8::DynMoeOrder, true>(F.lds + RING_OFF, g, S, E); } }
#define PHASE_9 { }
#define PHASE_10 phase_final(F, args, X1B, PO);
#define IN(k) (lo <= (k) && (k) < hi)
#define SEAM(k) do { if (IN(k) && (k) + 1 < hi) xcd_barrier(bar); } while (0)
#define RUN(k, BODY) do { if (IN(k)) { BODY SEAM(k); } } while (0)
    RUN(0, PHASE_0);
    RUN(1, PHASE_1);
    RUN(2, PHASE_2);
    RUN(3, PHASE_3);
    RUN(4, PHASE_4);
    RUN(6, PHASE_6);
    RUN(7, PHASE_7);
    RUN(8, PHASE_8);
    RUN(10, PHASE_10);
#undef IN
#undef SEAM
#undef RUN
}

#ifndef SINGLE_LAUNCH
#define SINGLE_LAUNCH 1
#endif
constexpr int NPHASES = 11;
#ifndef DUP_MASK
#define DUP_MASK 0
#endif
extern "C" void kernel_launch(void* const* d_in, const int* in_sizes, int n_in, void* d_out, int out_size, void* d_ws, size_t ws_size, hipStream_t stream) {
    static int grid = 0;
    if (grid == 0) {
        if (n_in != 20 || in_sizes[0] != NTOK * DM || out_size != NTOK * DM || ws_size < WS_END) {
            fprintf(stderr, "kernel_launch: unexpected shapes (n_in %d, in0 %d, out %d, ws %zu)\n", n_in, n_in > 0 ? in_sizes[0] : -1, out_size, ws_size); grid = -1; return; }
        int dev = 0, cus = 0, per_cu = 0;
        if (hipGetDevice(&dev) != hipSuccess || hipDeviceGetAttribute(&cus, hipDeviceAttributeMultiprocessorCount, dev) != hipSuccess) { grid = -1; return; }
        if (hipFuncSetAttribute((const void*)mega, hipFuncAttributeMaxDynamicSharedMemorySize, LDS_BYTES) != hipSuccess) { fprintf(stderr, "kernel_launch: hipFuncSetAttribute failed\n"); grid = -1; return; }
        if (hipOccupancyMaxActiveBlocksPerMultiprocessor(&per_cu, (const void*)mega, NWAVES * 64, LDS_BYTES) != hipSuccess || per_cu < 1) {
            fprintf(stderr, "kernel_launch: occupancy query reports %d workgroups per CU\n", per_cu); (void)hipGetLastError(); grid = -1; return; }
        if (cus != 256) { fprintf(stderr, "kernel_launch: built for a 256-CU device (LDS tables of the LN/router phase are sized for 8 token tiles per workgroup); found %d CUs\n", cus); grid = -1; return; }
        grid = cus;
    }
    if (grid < 0) return;
    (void)hipMemsetAsync((unsigned char*)d_ws + WS_CTL, 0, CTL_ZERO_BYTES, stream);
    MArgs a{};
    for (int i = 0; i < 20; ++i) a.in[i] = (const float*)d_in[i];
    a.out = (float*)d_out; a.ws = (unsigned char*)d_ws;
    if (SINGLE_LAUNCH) { a.ph_lo = 0; a.ph_hi = NPHASES; hipLaunchKernelGGL(mega, dim3(grid), dim3(NWAVES * 64), LDS_BYTES, stream, a); return; }
    for (int p = 0; p < NPHASES; ++p) { a.ph_lo = p; a.ph_hi = p + 1;
        for (int rep = 0; rep < 1 + ((DUP_MASK >> p) & 1); ++rep) { if (rep && p == 7) (void)hipMemsetAsync((unsigned char*)d_ws + WS_CTL, 0, 8192, stream); hipLaunchKernelGGL(mega, dim3(grid), dim3(NWAVES * 64), LDS_BYTES, stream, a); } }
}
```

```cpp
#define SINGLE_LAUNCH 1
#include <hip/hip_runtime.h>
#include <cstdint>
#include <cstdio>

typedef unsigned short bf16_t;
typedef short bf16x8 __attribute__((ext_vector_type(8)));
typedef float f32x4 __attribute__((ext_vector_type(4)));

constexpr int BATCH = 16, SEQ = 2048, DM = 1024, NTOK = BATCH * SEQ;
constexpr int HD = 64, ATTW = 768, AOW = 256, POOLW = 512, INW = 4864;
constexpr int Q_OFF = 0, K_OFF = 768, V_OFF = 1536, POOL_OFF = 2304, GA_OFF = 2816, GB_OFF = 3840;
constexpr int NEXP = 32, DEXP = 256, NGRP = 4, EPG = 8;
constexpr float LN_EPS = 1e-5f;
constexpr float ALPHA = 1.189207115002721f;
constexpr int MAXROWS = 65536 + NEXP * 256;

constexpr size_t MiB = 1u << 20;
constexpr size_t WS_PROJ = 0;
constexpr size_t WS_PO = 0;
constexpr size_t WS_HID = 130 * MiB;
constexpr size_t WS_Z = 166 * MiB;
constexpr size_t WS_MIXED = 304 * MiB;
constexpr size_t WS_X1B = 368 * MiB;
constexpr size_t WS_WT = 432 * MiB;
constexpr size_t WS_CTL = 500 * MiB;
constexpr size_t WS_LIST = 501 * MiB;
constexpr size_t WS_LISTW = 505 * MiB;
constexpr size_t WS_TINFO = 509 * MiB;
constexpr size_t WS_END = 512 * MiB;
constexpr size_t DO_AO = 0, DO_DIFF = 16 * MiB, DO_AOG = 48 * MiB, DO_LSE = 96 * MiB;

__device__ __forceinline__ int lane_id() { int l; asm volatile("v_mbcnt_lo_u32_b32 %0, -1, 0\n\tv_mbcnt_hi_u32_b32 %0, -1, %0" : "=v"(l)); return l; }
__device__ __forceinline__ bf16_t f2bf(float f) { unsigned u = __float_as_uint(f); return (bf16_t)((u + 0x7fffu + ((u >> 16) & 1u)) >> 16); }
__device__ __forceinline__ float bf2f(bf16_t h) { return __uint_as_float(((unsigned)h) << 16); }
__device__ __forceinline__ bf16_t cvt_in(float v) { return f2bf(v); }
__device__ __forceinline__ bf16_t cvt_in(bf16_t v) { return v; }
__device__ __forceinline__ float sigmoidf_(float v) { return 1.f / (1.f + __expf(-v)); }
#define DPP_ADD(v, CTRL) ((v) + __builtin_bit_cast(float, __builtin_amdgcn_update_dpp(0, __builtin_bit_cast(int, (v)), (CTRL), 0xf, 0xf, true)))
__device__ __forceinline__ float wave_sum(float v) {
    v = DPP_ADD(v, 0xB1);
    v = DPP_ADD(v, 0x4E);
    v = DPP_ADD(v, 0x141);
    v = DPP_ADD(v, 0x140);
    const int iv = __builtin_bit_cast(int, v);
    return (__builtin_bit_cast(float, __builtin_amdgcn_readlane(iv, 0)) + __builtin_bit_cast(float, __builtin_amdgcn_readlane(iv, 16)))
         + (__builtin_bit_cast(float, __builtin_amdgcn_readlane(iv, 32)) + __builtin_bit_cast(float, __builtin_amdgcn_readlane(iv, 48)));
}
__device__ __forceinline__ float wave_max(float v) {
#pragma unroll
    for (int o = 1; o < 64; o <<= 1) v = fmaxf(v, __shfl_xor(v, o));
    return v;
}

__device__ __forceinline__ int t5_bucket(int dist) {
    if (dist < 16) return dist;
    const float d = (float)dist;
    int large = 16 + (int)(logf(d / 16.0f) / logf(128.0f) * 16.0f);
    return large < 31 ? large : 31;
}


namespace pg8 {
#define PG8_LAS __attribute__((address_space(3)))
typedef unsigned u32x4 __attribute__((ext_vector_type(4)));
typedef unsigned u32x2 __attribute__((ext_vector_type(2)));
constexpr int BM = 256, BK = 64, HALF = 128, HTB = HALF * BK * 2  , STAGE_BYTES = 8 * HTB, NXCD = 8, WGM = 8;

__host__ __device__ __forceinline__ int lds_byte(int r, int c) { const int st = (r >> 4) * 2 + (c >> 5), rr = r & 15, cc = c & 31, ob = rr * 64 + cc * 2; return st * 1024 + (ob ^ (((ob >> 9) & 1) << 5)); }
__host__ __device__ __forceinline__ void stage_rc(int b, int& R, int& C) { const int st = b / 1024, sb = b % 1024, swz = sb ^ (((sb >> 9) & 1) << 5); R = (st >> 1) * 16 + swz / 64; C = (st & 1) * 32 + (swz % 64) / 2; }
__host__ __device__ __forceinline__ int perm32(int rho) { const int n = rho >> 4, i = rho & 15; return 8 * (i >> 2) + 4 * n + (i & 3); }

struct Unit { int pm, pn, e, rt; };
struct Gemm { const bf16_t* A; const bf16_t* Bt; int K; int wave; };

struct StaticOrder {
    int nM, nN, nwg, G, c;
    __device__ void init(int M, int N, int G_, int c_) { nM = M / BM; nN = N / BM; nwg = nM * nN; G = G_; c = c_; }
    __device__ bool next(int i, Unit& u) const {
        const long L = (long)i * G + c; if (L >= nwg) return false;
        int wgid = (int)L; { const int q = nwg / NXCD, r = nwg % NXCD, xcd = wgid % NXCD, off = wgid / NXCD; wgid = (xcd < r ? xcd * (q + 1) : r * (q + 1) + (xcd - r) * q) + off; }
        const int nig = WGM * nN, gid = wgid / nig, fm = gid * WGM, gsz = (nM - fm) < WGM ? (nM - fm) : WGM;
        u.pm = fm + ((wgid % nig) % gsz); u.pn = (wgid % nig) / gsz; u.e = 0; u.rt = 0; return true;
    }
    __device__ __forceinline__ int arow(const Unit& u, int r) const { return u.pm * BM + r; }
    __device__ __forceinline__ void done(const Unit&) const {}
};

struct MoeOrder {
    const PG8_LAS int* tile_e; const PG8_LAS int* first; const int* cnt; const int* list; int nN, G, c, ntiles; bool gather; unsigned* ready;
    __device__ bool next(int i, Unit& u) const {
        const int L = i * G + c; if (L >= ntiles * nN) return false;
        const int rt = L / nN, pn = L - rt * nN, e = tile_e[rt];
        u.pm = rt; u.pn = e * nN + pn; u.e = e; u.rt = rt - first[e]; return true;
    }
    __device__ __forceinline__ int arow(const Unit& u, int r) const {
        if (!gather) return u.pm * BM + r;
        const int idx = u.rt * BM + r; return idx < cnt[u.e * 64] ? (list[u.e * NTOK + idx] >> 1) : 0;
    }
    __device__ __forceinline__ void done(const Unit& u) const {
        asm volatile("s_waitcnt vmcnt(0)" ::: "memory");
        if (lane_id() == 0) __hip_atomic_fetch_add(ready + 64 * u.pm, 1u, __ATOMIC_RELAXED, __HIP_MEMORY_SCOPE_AGENT);
    }
};
struct DynMoeOrder {
    const PG8_LAS int* tile_e; const PG8_LAS int* first; int nN, ntiles; unsigned* queue; const unsigned* ready; unsigned need; unsigned* tmo; volatile PG8_LAS int* slot; int wave;
    __device__ bool next(int i, Unit& u) const {
        if (wave == 0) {
            int L = 0; if (lane_id() == 0) L = (int)__hip_atomic_fetch_add(queue, 1u, __ATOMIC_RELAXED, __HIP_MEMORY_SCOPE_AGENT);
            L = __builtin_amdgcn_readfirstlane(L);
            if (L < ntiles * nN) {
                const int rt = L / nN; unsigned spins = 0;
                while ((unsigned)__builtin_amdgcn_readfirstlane(__hip_atomic_load(ready + 64 * rt, __ATOMIC_RELAXED, __HIP_MEMORY_SCOPE_AGENT)) < need) {
                    __builtin_amdgcn_s_sleep(2);
                    if (++spins > (1u << 20)) { if (lane_id() == 0) __hip_atomic_store(tmo, 1u, __ATOMIC_RELAXED, __HIP_MEMORY_SCOPE_AGENT); break; } }
                __builtin_amdgcn_fence(__ATOMIC_ACQUIRE, "agent");
                asm volatile("s_waitcnt vmcnt(0)" ::: "memory");
            } else L = -1;
            if (lane_id() == 0) slot[i & 1] = L;
            asm volatile("s_waitcnt lgkmcnt(0)" ::: "memory");
        }
        __builtin_amdgcn_s_barrier(); asm volatile("" ::: "memory");
        const int L = slot[i & 1]; if (L < 0) return false;
        const int rt = L / nN, pn = L - rt * nN, e = tile_e[rt];
        u.pm = rt; u.pn = e * nN + pn; u.e = e; u.rt = rt - first[e]; return true;
    }
    __device__ __forceinline__ int arow(const Unit& u, int r) const { return u.pm * BM + r; }
    __device__ __forceinline__ void done(const Unit&) const {}
};

__device__ __forceinline__ unsigned cvt_pk_bf16(float lo, float hi) { unsigned r; asm volatile("v_cvt_pk_bf16_f32 %0, %1, %2" : "=v"(r) : "v"(lo), "v"(hi)); return r; }
__device__ __forceinline__ float bflo(unsigned w) { return __uint_as_float(w << 16); }
__device__ __forceinline__ float bfhi(unsigned w) { return __uint_as_float(w & 0xffff0000u); }
__device__ __forceinline__ float fsig(float v) { return __builtin_amdgcn_rcpf(1.f + __builtin_amdgcn_exp2f(-1.4426950408889634f * v)); }
__device__ __forceinline__ float fsig_gate(float v) { return fmaxf(fsig(v), 1.0e-7f); }

struct EpiProj {
    static constexpr bool PERM = true;
    bf16_t* O; const float* bias; float qscale;
    __device__ __forceinline__ void operator()(const f32x4 (&acc)[2][2][4][2], const Unit& u, int wr, int wc, int fr, int fq) const {
        const int row0 = u.pm * BM + wr * 64 + fr, lc0 = wc * 32 + 8 * fq;
        const bool gate = u.pn >= 11;
        const int lg = (u.pn < 9) ? 2 * (u.pn % 3) : 0;
        const int cb0 = gate ? GA_OFF + (u.pn - 11) * HALF + lc0 : u.pn * BM + lc0, cb1 = gate ? GB_OFF + (u.pn - 11) * HALF + lc0 : u.pn * BM + HALF + lc0;
        f32x4 bv[2][2];
#pragma unroll
        for (int n = 0; n < 2; ++n) { bv[0][n] = *(const f32x4*)(bias + cb0 + 4 * n); bv[1][n] = *(const f32x4*)(bias + cb1 + 4 * n); }
#pragma unroll
        for (int ai = 0; ai < 2; ++ai)
#pragma unroll
            for (int m = 0; m < 4; ++m) { const int rg = row0 + ai * HALF + m * 16, t = rg & (SEQ - 1), prow = (rg & ~(SEQ - 1)) + ((t & ((1 << lg) - 1)) << (11 - lg)) + (t >> lg);
                bf16_t* rowp = O + (size_t)prow * INW;
                f32x4 a0 = acc[ai][0][m][0] + bv[0][0], a1 = acc[ai][0][m][1] + bv[0][1], b0 = acc[ai][1][m][0] + bv[1][0], b1 = acc[ai][1][m][1] + bv[1][1];
                if (u.pn < 3) { a0 = a0 * qscale; a1 = a1 * qscale; b0 = b0 * qscale; b1 = b1 * qscale; }
                if (gate) {
#pragma unroll
                    for (int i = 0; i < 4; ++i) { const float s0 = fsig_gate(b0[i]), s1 = fsig_gate(b1[i]); a0[i] = fsig(a0[i]) * __builtin_amdgcn_rcpf(s0); a1[i] = fsig(a1[i]) * __builtin_amdgcn_rcpf(s1); b0[i] = s0; b1[i] = s1; } }
                u32x4 w; w.x = cvt_pk_bf16(a0[0], a0[1]); w.y = cvt_pk_bf16(a0[2], a0[3]); w.z = cvt_pk_bf16(a1[0], a1[1]); w.w = cvt_pk_bf16(a1[2], a1[3]);
                *(u32x4*)(rowp + cb0) = w;
                w.x = cvt_pk_bf16(b0[0], b0[1]); w.y = cvt_pk_bf16(b0[2], b0[3]); w.z = cvt_pk_bf16(b1[0], b1[1]); w.w = cvt_pk_bf16(b1[2], b1[3]);
                *(u32x4*)(rowp + cb1) = w; }
    }
};
template <bool ACCUM> struct EpiGate {
    static constexpr bool PERM = true;
    bf16_t* O; const bf16_t* gate;
    __device__ __forceinline__ void operator()(const f32x4 (&acc)[2][2][4][2], const Unit& u, int wr, int wc, int fr, int fq) const {
        const int row0 = u.pm * BM + wr * 64 + fr, col0 = u.pn * BM + wc * 32 + 8 * fq;
#pragma unroll
        for (int ai = 0; ai < 2; ++ai)
#pragma unroll
            for (int m = 0; m < 4; ++m) { const size_t r = (size_t)(row0 + ai * HALF + m * 16);
#pragma unroll
                for (int bj = 0; bj < 2; ++bj) {
                    const u32x4 gw = *(const u32x4*)(gate + r * INW + col0 + bj * HALF);
                    bf16_t* op = O + r * DM + col0 + bj * HALF;
                    f32x4 v0 = acc[ai][bj][m][0], v1 = acc[ai][bj][m][1];
                    v0[0] *= bflo(gw.x); v0[1] *= bfhi(gw.x); v0[2] *= bflo(gw.y); v0[3] *= bfhi(gw.y);
                    v1[0] *= bflo(gw.z); v1[1] *= bfhi(gw.z); v1[2] *= bflo(gw.w); v1[3] *= bfhi(gw.w);
                    if (ACCUM) { const u32x4 ow = *(const u32x4*)op;
                        v0[0] += bflo(ow.x); v0[1] += bfhi(ow.x); v0[2] += bflo(ow.y); v0[3] += bfhi(ow.y);
                        v1[0] += bflo(ow.z); v1[1] += bfhi(ow.z); v1[2] += bflo(ow.w); v1[3] += bfhi(ow.w); }
                    u32x4 w; w.x = cvt_pk_bf16(v0[0], v0[1]); w.y = cvt_pk_bf16(v0[2], v0[3]); w.z = cvt_pk_bf16(v1[0], v1[1]); w.w = cvt_pk_bf16(v1[2], v1[3]);
                    *(u32x4*)op = w; } }
    }
};
struct EpiMix {
    static constexpr bool PERM = true;
    bf16_t* O; const bf16_t* ga; const bf16_t* gb;
    __device__ __forceinline__ void mid(f32x4 (&acc)[2][2][4][2], const Unit& u, int wr, int wc, int fr, int fq) const {
        int row0 = u.pm * BM + wr * 64 + fr, col0 = u.pn * BM + wc * 32 + 8 * fq;
        asm volatile("" : "+v"(row0), "+v"(col0));
#pragma unroll
        for (int ai = 0; ai < 2; ++ai)
#pragma unroll
            for (int m = 0; m < 4; ++m) { const size_t r = (size_t)(row0 + ai * HALF + m * 16);
#pragma unroll
                for (int bj = 0; bj < 2; ++bj) {
                    const u32x4 a = *(const u32x4*)(ga + r * INW + col0 + bj * HALF);
                    f32x4& v0 = acc[ai][bj][m][0]; f32x4& v1 = acc[ai][bj][m][1];
                    v0[0] *= bflo(a.x); v0[1] *= bfhi(a.x); v0[2] *= bflo(a.y); v0[3] *= bfhi(a.y);
                    v1[0] *= bflo(a.z); v1[1] *= bfhi(a.z); v1[2] *= bflo(a.w); v1[3] *= bfhi(a.w); }
                if (m == 3) asm volatile("" ::: "memory"); }
    }
    __device__ __forceinline__ void operator()(const f32x4 (&acc)[2][2][4][2], const Unit& u, int wr, int wc, int fr, int fq) const {
        const int row0 = u.pm * BM + wr * 64 + fr, col0 = u.pn * BM + wc * 32 + 8 * fq;
#pragma unroll
        for (int ai = 0; ai < 2; ++ai)
#pragma unroll
            for (int m = 0; m < 4; ++m) { const size_t r = (size_t)(row0 + ai * HALF + m * 16);
#pragma unroll
                for (int bj = 0; bj < 2; ++bj) {
                    const u32x4 b = *(const u32x4*)(gb + r * INW + col0 + bj * HALF);
                    const f32x4 v0 = acc[ai][bj][m][0], v1 = acc[ai][bj][m][1];
                    u32x4 w; w.x = cvt_pk_bf16(v0[0] * bflo(b.x), v0[1] * bfhi(b.x)); w.y = cvt_pk_bf16(v0[2] * bflo(b.y), v0[3] * bfhi(b.y));
                    w.z = cvt_pk_bf16(v1[0] * bflo(b.z), v1[1] * bfhi(b.z)); w.w = cvt_pk_bf16(v1[2] * bflo(b.w), v1[3] * bfhi(b.w));
                    *(u32x4*)(O + r * DM + col0 + bj * HALF) = w; }
                if (m == 3) asm volatile("" ::: "memory"); }
    }
};
struct EpiY {
    static constexpr bool PERM = true;
    bf16_t* Y;
    __device__ __forceinline__ void operator()(const f32x4 (&acc)[2][2][4][2], const Unit& u, int wr, int wc, int fr, int fq) const {
        const int col0 = u.pn * BM + wc * 32 + 8 * fq;
#pragma unroll
        for (int ai = 0; ai < 2; ++ai)
#pragma unroll
            for (int m = 0; m < 4; ++m) { bf16_t* rowp = Y + (size_t)(u.pm * BM + ai * HALF + wr * 64 + m * 16 + fr) * DM + col0;
#pragma unroll
                for (int bj = 0; bj < 2; ++bj) { const f32x4 v0 = acc[ai][bj][m][0], v1 = acc[ai][bj][m][1];
                    u32x4 w; w.x = cvt_pk_bf16(v0[0], v0[1]); w.y = cvt_pk_bf16(v0[2], v0[3]); w.z = cvt_pk_bf16(v1[0], v1[1]); w.w = cvt_pk_bf16(v1[2], v1[3]);
                    *(u32x4*)(rowp + bj * HALF) = w; } }
    }
};
struct EpiMoe1 {
    static constexpr bool PERM = true;
    bf16_t* hid; const int* cnt; const float* listw;
    __device__ __forceinline__ void operator()(const f32x4 (&acc)[2][2][4][2], const Unit& u, int wr, int wc, int fr, int fq) const {
        const int n_e = cnt[u.e * 64], pnl = u.pn & 1, hc0 = pnl * 128 + wc * 32 + 8 * fq;
        const __amdgpu_buffer_rsrc_t rs = __builtin_amdgcn_make_buffer_rsrc(hid, 0, MAXROWS * DEXP * 2, 0x00020000);
#pragma unroll
        for (int ai = 0; ai < 2; ++ai)
#pragma unroll
            for (int m = 0; m < 4; ++m) { const int r = ai * HALF + wr * 64 + m * 16 + fr, idx = u.rt * BM + r;
                const float w = idx < n_e ? listw[u.e * NTOK + idx] : 0.f;
                float h[8];
#pragma unroll
                for (int n = 0; n < 2; ++n)
#pragma unroll
                    for (int i = 0; i < 4; ++i) { const float g = acc[ai][0][m][n][i], uu = acc[ai][1][m][n][i]; h[n * 4 + i] = w * g * fsig(g) * uu; }
                u32x4 o; o.x = cvt_pk_bf16(h[0], h[1]); o.y = cvt_pk_bf16(h[2], h[3]); o.z = cvt_pk_bf16(h[4], h[5]); o.w = cvt_pk_bf16(h[6], h[7]);
                __builtin_amdgcn_raw_buffer_store_b128(o, rs, (unsigned)(((u.pm * BM + r) * DEXP + hc0) * 2), 0,   16); }
    }
};
struct EpiMoe2 {
    static constexpr bool PERM = true;
    bf16_t* po; const int* cnt; const int* list;
    __device__ __forceinline__ void operator()(const f32x4 (&acc)[2][2][4][2], const Unit& u, int wr, int wc, int fr, int fq) const {
        const int col0 = (u.pn & 3) * BM + wc * 32 + 8 * fq, n_e = cnt[u.e * 64];
#pragma unroll
        for (int ai = 0; ai < 2; ++ai)
#pragma unroll
            for (int m = 0; m < 4; ++m) { const int r = ai * HALF + wr * 64 + m * 16 + fr, idx = u.rt * BM + r;
                const int drow = idx < n_e ? list[u.e * NTOK + idx] : 2 * NTOK + r;
                bf16_t* rowp = po + (size_t)drow * DM + col0;
#pragma unroll
                for (int bj = 0; bj < 2; ++bj) { const f32x4 v0 = acc[ai][bj][m][0], v1 = acc[ai][bj][m][1];
                    u32x4 w; w.x = cvt_pk_bf16(v0[0], v0[1]); w.y = cvt_pk_bf16(v0[2], v0[3]); w.z = cvt_pk_bf16(v1[0], v1[1]); w.w = cvt_pk_bf16(v1[2], v1[3]);
                    *(u32x4*)(rowp + bj * HALF) = w; } }
    }
};

template <class Epi, class Sched, bool ALIGN_EPI>
__device__ __forceinline__ void gemm_phase(PG8_LAS unsigned char* lds, const Gemm g, const Sched& S, const Epi& E) {
    const int wid = g.wave, lane = lane_id(), tid = wid * 64 + lane, wr = wid >> 2, wc = wid & 3, fr = lane & 15, fq = lane >> 4;
    const int K = g.K, nt = K / BK;
    int RA[2]; unsigned CA[2], voffB[2];
#pragma unroll
    for (int i = 0; i < 2; ++i) { int R, C; stage_rc(tid * 16 + i * 8192, R, C); const int Rb = Epi::PERM ? ((R & ~31) + perm32(R & 31)) : R;
        RA[i] = R; CA[i] = (unsigned)C * 2u; voffB[i] = (unsigned)(Rb * K + C) * 2u; }
    const size_t kstep = (size_t)(BK * 2);
    const size_t hstep = (size_t)HALF * K * 2;
    const size_t tstep = 2 * hstep;
    const unsigned ldsw = (unsigned)wid * 1024u;
    const int aoff = lds_byte(wr * 64 + fr, fq * 8), boff = lds_byte(wc * 32 + fr, fq * 8);
#define PG8_SA(b, h) (((b) * 2 + (h)) * HTB)
#define PG8_SB(b, h) ((4 + (b) * 2 + (h)) * HTB)
#define PG8_STAGE(bufoff, gbase, voff) do { _Pragma("unroll") for (int _i = 0; _i < 2; ++_i) \
        __builtin_amdgcn_global_load_lds((const unsigned*)((const char*)(gbase) + (voff)[_i]), (PG8_LAS unsigned*)(lds + (bufoff) + ldsw + _i * 8192), 16, 0, 0); } while (0)
#define PG8_LDA(dst, b, h) do { _Pragma("unroll") for (int m = 0; m < 4; ++m) _Pragma("unroll") for (int k = 0; k < 2; ++k) dst[m][k] = *(const PG8_LAS bf16x8*)(lds + PG8_SA(b, h) + aoff + m * 2048 + k * 1024); } while (0)
#define PG8_LDB(dst, b, h) do { _Pragma("unroll") for (int n = 0; n < 2; ++n) _Pragma("unroll") for (int k = 0; k < 2; ++k) dst[n][k] = *(const PG8_LAS bf16x8*)(lds + PG8_SB(b, h) + boff + n * 2048 + k * 1024); } while (0)
#define PG8_MMA(ai, bj, At, Bt) do { __builtin_amdgcn_s_setprio(1); _Pragma("unroll") for (int m = 0; m < 4; ++m) _Pragma("unroll") for (int n = 0; n < 2; ++n) _Pragma("unroll") for (int k = 0; k < 2; ++k) \
        acc[ai][bj][m][n] = __builtin_amdgcn_mfma_f32_16x16x32_bf16(Bt[n][k], At[m][k], acc[ai][bj][m][n], 0, 0, 0); __builtin_amdgcn_s_setprio(0); } while (0)
#define PG8_WAIT_V(n) asm volatile("s_waitcnt vmcnt(" #n ")" ::: "memory")
#define PG8_WAIT_L(n) asm volatile("s_waitcnt lgkmcnt(" #n ")" ::: "memory")
#define PG8_BAR __builtin_amdgcn_s_barrier()
#define PG8_SCHED __builtin_amdgcn_sched_barrier(0)
#define PG8_AOFF(dst, U) do { _Pragma("unroll") for (int _h = 0; _h < 2; ++_h) _Pragma("unroll") for (int _i = 0; _i < 2; ++_i) \
        dst[_h][_i] = (unsigned)S.arow(U, _h * HALF + RA[_i]) * (unsigned)(K * 2) + CA[_i]; } while (0)
    Unit cur, nxt; int ui = 0;
    if (!S.next(0, cur)) return;
    f32x4 acc[2][2][4][2];
#pragma unroll
    for (int a = 0; a < 2; ++a)
#pragma unroll
        for (int b = 0; b < 2; ++b)
#pragma unroll
            for (int m = 0; m < 4; ++m)
#pragma unroll
                for (int n = 0; n < 2; ++n) acc[a][b][m][n] = (f32x4){0.f, 0.f, 0.f, 0.f};
    bf16x8 At[4][2], B0[2][2], B1[2][2];
    unsigned offC[2][2], offN[2][2];
    PG8_AOFF(offC, cur);
    const char* A0 = (const char*)g.A;
    const char* cB = (const char*)g.Bt + (size_t)cur.pn * tstep;
    PG8_STAGE(PG8_SB(0, 0), cB, voffB); PG8_STAGE(PG8_SB(0, 1), cB + hstep, voffB); PG8_STAGE(PG8_SA(0, 0), A0, offC[0]); PG8_STAGE(PG8_SA(0, 1), A0, offC[1]);
    if (wr == 1) PG8_BAR;
    PG8_WAIT_V(2); PG8_BAR;
    PG8_STAGE(PG8_SB(1, 0), cB + kstep, voffB); PG8_STAGE(PG8_SA(1, 0), A0 + kstep, offC[0]); PG8_STAGE(PG8_SB(1, 1), cB + hstep + kstep, voffB);
    PG8_WAIT_V(6); PG8_BAR;
    for (;;) {
        const bool has_next = S.next(ui + 1, nxt);
        if (has_next) PG8_AOFF(offN, nxt);
        const char* nB = has_next ? (const char*)g.Bt + (size_t)nxt.pn * tstep : cB;
#pragma unroll 1
        for (int t = 0; t < nt; t += 2) {
            const bool last = (t == nt - 2);
            const char* a1 = A0 + (size_t)(t + 1) * kstep;
            const char* a2 = last ? A0 : A0 + (size_t)(t + 2) * kstep; const char* b2 = last ? nB : cB + (size_t)(t + 2) * kstep;
            const char* a3 = a2 + kstep; const char* b3 = b2 + kstep;
            PG8_LDB(B0, 0, 0); PG8_LDB(B1, 0, 1); PG8_SCHED; PG8_LDA(At, 0, 0); PG8_STAGE(PG8_SA(1, 1), a1, offC[1]);
            if (last && has_next) {
#pragma unroll
                for (int _h = 0; _h < 2; ++_h)
#pragma unroll
                    for (int _i = 0; _i < 2; ++_i) offC[_h][_i] = offN[_h][_i];
            }
            PG8_WAIT_V(8); PG8_WAIT_L(0); PG8_BAR; PG8_MMA(0, 0, At, B0); PG8_MMA(0, 1, At, B1); PG8_BAR; PG8_SCHED;
            PG8_LDA(At, 0, 1); PG8_STAGE(PG8_SB(0, 0), b2, voffB); PG8_STAGE(PG8_SB(0, 1), b2 + hstep, voffB); PG8_STAGE(PG8_SA(0, 0), a2, offC[0]);
            PG8_WAIT_V(8); PG8_WAIT_L(0); PG8_BAR; PG8_MMA(1, 0, At, B0); PG8_MMA(1, 1, At, B1); PG8_BAR; PG8_SCHED;
            PG8_LDB(B0, 1, 0); PG8_LDB(B1, 1, 1); PG8_SCHED; PG8_LDA(At, 1, 0); PG8_STAGE(PG8_SA(0, 1), a2, offC[1]);
            PG8_WAIT_V(8); PG8_WAIT_L(0); PG8_BAR; PG8_MMA(0, 0, At, B0); PG8_MMA(0, 1, At, B1); PG8_BAR; PG8_SCHED;
            PG8_LDA(At, 1, 1); PG8_STAGE(PG8_SB(1, 0), b3, voffB); PG8_STAGE(PG8_SB(1, 1), b3 + hstep, voffB); PG8_STAGE(PG8_SA(1, 0), a3, offC[0]);
            PG8_WAIT_V(8); PG8_WAIT_L(0); PG8_BAR; PG8_MMA(1, 0, At, B0); PG8_MMA(1, 1, At, B1); PG8_BAR; PG8_SCHED;
        }
        if constexpr (ALIGN_EPI) { if (wr == 0) PG8_BAR; }
        E(acc, cur, wr, wc, fr, fq); S.done(cur);
        if (!has_next) break;
#pragma unroll
        for (int a = 0; a < 2; ++a)
#pragma unroll
            for (int b = 0; b < 2; ++b)
#pragma unroll
                for (int m = 0; m < 4; ++m)
#pragma unroll
                    for (int n = 0; n < 2; ++n) acc[a][b][m][n] = (f32x4){0.f, 0.f, 0.f, 0.f};
        cur = nxt; cB = nB; ++ui;
        if constexpr (ALIGN_EPI) { if (wr == 1) PG8_BAR; }
    }
    PG8_WAIT_V(0);
    if constexpr (!ALIGN_EPI) { if (wr == 0) PG8_BAR; }
    PG8_BAR;
#undef PG8_SA
#undef PG8_SB
#undef PG8_STAGE
#undef PG8_LDA
#undef PG8_LDB
#undef PG8_MMA
#undef PG8_WAIT_V
#undef PG8_WAIT_L
#undef PG8_BAR
#undef PG8_SCHED
#undef PG8_AOFF
}

struct Gemm2 { const bf16_t* A0; const bf16_t* B0; int K0; const bf16_t* A1; const bf16_t* B1; int K1; int wave; };
template <class Epi, class Sched, bool ALIGN_EPI>
__device__ __forceinline__ void gemm_phase2(PG8_LAS unsigned char* lds, const Gemm2 g, const Sched& S, const Epi& E) {
    const int wid = g.wave, lane = lane_id(), tid = wid * 64 + lane, wr = wid >> 2, wc = wid & 3, fr = lane & 15, fq = lane >> 4;
    const int nt0 = g.K0 / BK, nt = nt0 + g.K1 / BK;
    unsigned RA2[2], RB2[2], C2[2];
#pragma unroll
    for (int i = 0; i < 2; ++i) { int R, C; stage_rc(tid * 16 + i * 8192, R, C); const int Rb = Epi::PERM ? ((R & ~31) + perm32(R & 31)) : R;
        RA2[i] = (unsigned)R * 2u; RB2[i] = (unsigned)Rb * 2u; C2[i] = (unsigned)C * 2u; }
    const size_t kstep = (size_t)(BK * 2);
    const unsigned ldsw = (unsigned)wid * 1024u;
    const int aoff = lds_byte(wr * 64 + fr, fq * 8), boff = lds_byte(wc * 32 + fr, fq * 8);
#define PG8_SA(b, h) (((b) * 2 + (h)) * HTB)
#define PG8_SB(b, h) ((4 + (b) * 2 + (h)) * HTB)
#define PG8_STAGE(bufoff, gbase, R2, Kb) do { _Pragma("unroll") for (int _i = 0; _i < 2; ++_i) \
        __builtin_amdgcn_global_load_lds((const unsigned*)((const char*)(gbase) + ((R2)[_i] * (unsigned)(Kb) + C2[_i])), (PG8_LAS unsigned*)(lds + (bufoff) + ldsw + _i * 8192), 16, 0, 0); } while (0)
#define PG8_LDA(dst, b, h) do { _Pragma("unroll") for (int m = 0; m < 4; ++m) _Pragma("unroll") for (int k = 0; k < 2; ++k) dst[m][k] = *(const PG8_LAS bf16x8*)(lds + PG8_SA(b, h) + aoff + m * 2048 + k * 1024); } while (0)
#define PG8_LDB(dst, b, h) do { _Pragma("unroll") for (int n = 0; n < 2; ++n) _Pragma("unroll") for (int k = 0; k < 2; ++k) dst[n][k] = *(const PG8_LAS bf16x8*)(lds + PG8_SB(b, h) + boff + n * 2048 + k * 1024); } while (0)
#define PG8_MMA(ai, bj, At, Bt) do { __builtin_amdgcn_s_setprio(1); _Pragma("unroll") for (int m = 0; m < 4; ++m) _Pragma("unroll") for (int n = 0; n < 2; ++n) _Pragma("unroll") for (int k = 0; k < 2; ++k) \
        acc[ai][bj][m][n] = __builtin_amdgcn_mfma_f32_16x16x32_bf16(Bt[n][k], At[m][k], acc[ai][bj][m][n], 0, 0, 0); __builtin_amdgcn_s_setprio(0); } while (0)
#define PG8_WAIT_V(n) asm volatile("s_waitcnt vmcnt(" #n ")" ::: "memory")
#define PG8_WAIT_L(n) asm volatile("s_waitcnt lgkmcnt(" #n ")" ::: "memory")
#define PG8_BAR __builtin_amdgcn_s_barrier()
#define PG8_SCHED __builtin_amdgcn_sched_barrier(0)
#define PG8_APTR(pm_, h, tt) ((tt) < nt0 ? (const char*)g.A0 + ((size_t)((pm_) * BM + (h) * HALF) * g.K0 + (size_t)(tt) * BK) * 2 : (const char*)g.A1 + ((size_t)((pm_) * BM + (h) * HALF) * g.K1 + (size_t)((tt) - nt0) * BK) * 2)
#define PG8_BPTR(pn_, h, tt) ((tt) < nt0 ? (const char*)g.B0 + ((size_t)((pn_) * BM + (h) * HALF) * g.K0 + (size_t)(tt) * BK) * 2 : (const char*)g.B1 + ((size_t)((pn_) * BM + (h) * HALF) * g.K1 + (size_t)((tt) - nt0) * BK) * 2)
    Unit cur, nxt; int ui = 0;
    if (!S.next(0, cur)) return;
    f32x4 acc[2][2][4][2];
#pragma unroll
    for (int a = 0; a < 2; ++a)
#pragma unroll
        for (int b = 0; b < 2; ++b)
#pragma unroll
            for (int m = 0; m < 4; ++m)
#pragma unroll
                for (int n = 0; n < 2; ++n) acc[a][b][m][n] = (f32x4){0.f, 0.f, 0.f, 0.f};
    bf16x8 At[4][2], B0[2][2], B1[2][2];
    PG8_STAGE(PG8_SB(0, 0), PG8_BPTR(cur.pn, 0, 0), RB2, g.K0); PG8_STAGE(PG8_SB(0, 1), PG8_BPTR(cur.pn, 1, 0), RB2, g.K0); PG8_STAGE(PG8_SA(0, 0), PG8_APTR(cur.pm, 0, 0), RA2, g.K0); PG8_STAGE(PG8_SA(0, 1), PG8_APTR(cur.pm, 1, 0), RA2, g.K0);
    if (wr == 1) PG8_BAR;
    PG8_WAIT_V(2); PG8_BAR;
    PG8_STAGE(PG8_SB(1, 0), PG8_BPTR(cur.pn, 0, 1), RB2, g.K0); PG8_STAGE(PG8_SA(1, 0), PG8_APTR(cur.pm, 0, 1), RA2, g.K0); PG8_STAGE(PG8_SB(1, 1), PG8_BPTR(cur.pn, 1, 1), RB2, g.K0);
    PG8_WAIT_V(6); PG8_BAR;
    for (;;) {
        const bool has_next = S.next(ui + 1, nxt);
#pragma unroll 1
        for (int t = 0; t < nt; t += 2) {
            const bool last = (t == nt - 2);
            if (t == nt0) E.mid(acc, cur, wr, wc, fr, fq);
            const bool s1 = t >= nt0;
            const int t2 = last ? 0 : t + 2; const bool s2 = t2 >= nt0;
            const int pm2 = (last && has_next) ? nxt.pm : cur.pm, pn2 = (last && has_next) ? nxt.pn : cur.pn;
            const int Ks1 = s1 ? g.K1 : g.K0, Ks2 = s2 ? g.K1 : g.K0;
            const char* a1h1 = PG8_APTR(cur.pm, 1, t + 1);
            const char* a2h0 = PG8_APTR(pm2, 0, t2); const char* a2h1 = PG8_APTR(pm2, 1, t2);
            const char* b2h0 = PG8_BPTR(pn2, 0, t2); const char* b2h1 = PG8_BPTR(pn2, 1, t2);
            PG8_LDB(B0, 0, 0); PG8_LDB(B1, 0, 1); PG8_SCHED; PG8_LDA(At, 0, 0); PG8_STAGE(PG8_SA(1, 1), a1h1, RA2, Ks1);
            PG8_WAIT_V(8); PG8_WAIT_L(0); PG8_BAR; PG8_MMA(0, 0, At, B0); PG8_MMA(0, 1, At, B1); PG8_BAR; PG8_SCHED;
            PG8_LDA(At, 0, 1); PG8_STAGE(PG8_SB(0, 0), b2h0, RB2, Ks2); PG8_STAGE(PG8_SB(0, 1), b2h1, RB2, Ks2); PG8_STAGE(PG8_SA(0, 0), a2h0, RA2, Ks2);
            PG8_WAIT_V(8); PG8_WAIT_L(0); PG8_BAR; PG8_MMA(1, 0, At, B0); PG8_MMA(1, 1, At, B1); PG8_BAR; PG8_SCHED;
            PG8_LDB(B0, 1, 0); PG8_LDB(B1, 1, 1); PG8_SCHED; PG8_LDA(At, 1, 0); PG8_STAGE(PG8_SA(0, 1), a2h1, RA2, Ks2);
            PG8_WAIT_V(8); PG8_WAIT_L(0); PG8_BAR; PG8_MMA(0, 0, At, B0); PG8_MMA(0, 1, At, B1); PG8_BAR; PG8_SCHED;
            PG8_LDA(At, 1, 1); PG8_STAGE(PG8_SB(1, 0), b2h0 + kstep, RB2, Ks2); PG8_STAGE(PG8_SB(1, 1), b2h1 + kstep, RB2, Ks2); PG8_STAGE(PG8_SA(1, 0), a2h0 + kstep, RA2, Ks2);
            PG8_WAIT_V(8); PG8_WAIT_L(0); PG8_BAR; PG8_MMA(1, 0, At, B0); PG8_MMA(1, 1, At, B1); PG8_BAR; PG8_SCHED;
        }
        if constexpr (ALIGN_EPI) { if (wr == 0) PG8_BAR; }
        E(acc, cur, wr, wc, fr, fq);
        if (!has_next) break;
#pragma unroll
        for (int a = 0; a < 2; ++a)
#pragma unroll
            for (int b = 0; b < 2; ++b)
#pragma unroll
                for (int m = 0; m < 4; ++m)
#pragma unroll
                    for (int n = 0; n < 2; ++n) acc[a][b][m][n] = (f32x4){0.f, 0.f, 0.f, 0.f};
        cur = nxt; ++ui;
        if constexpr (ALIGN_EPI) { if (wr == 1) PG8_BAR; }
    }
    PG8_WAIT_V(0);
    if constexpr (!ALIGN_EPI) { if (wr == 0) PG8_BAR; }
    PG8_BAR;
#undef PG8_SA
#undef PG8_SB
#undef PG8_STAGE
#undef PG8_LDA
#undef PG8_LDB
#undef PG8_MMA
#undef PG8_WAIT_V
#undef PG8_WAIT_L
#undef PG8_BAR
#undef PG8_SCHED
#undef PG8_APTR
#undef PG8_BPTR
}
struct GemmGM { const bf16_t* XB; const bf16_t* WinT; const bf16_t* AO; const bf16_t* WpaT; const bf16_t* DIFF; const bf16_t* WeffT; const float* bias; bf16_t* MIXED; int wave; };
template <class Sched, class Pre>
__device__ __forceinline__ void gemm_phase_gm(PG8_LAS unsigned char* lds, const GemmGM g, const Sched& S, const Pre& pre) {
    const int wid = g.wave, lane = lane_id(), tid = wid * 64 + lane, wr = wid >> 2, wc = wid & 3, fr = lane & 15, fq = lane >> 4;
    constexpr int NTG = DM / BK, NTA = AOW / BK, NTP = POOLW / BK, NT = NTG + NTA + NTP;
    static_assert(NTG % 2 == 0 && NTA % 2 == 0 && NTP % 2 == 0, "segment boundaries on even K-tiles");
    unsigned RCB[2];
#pragma unroll
    for (int i = 0; i < 2; ++i) { int R, C; stage_rc(tid * 16 + i * 8192, R, C); const int Rb = (R & ~31) + perm32(R & 31);
        RCB[i] = ((unsigned)Rb << 16) | ((unsigned)R << 8) | (unsigned)C; }
    const size_t kstep = (size_t)(BK * 2);
    const unsigned ldsw = (unsigned)wid * 1024u;
    const int aoff = lds_byte(wr * 64 + fr, fq * 8), boff = lds_byte(wc * 32 + fr, fq * 8);
#define PG8_SA(b, h) (((b) * 2 + (h)) * HTB)
#define PG8_SB(b, h) ((4 + (b) * 2 + (h)) * HTB)
#define RA2 8
#define RB2 16
#define PG8_STAGE(bufoff, gbase, SH, Kb) do { _Pragma("unroll") for (int _i = 0; _i < 2; ++_i) \
        __builtin_amdgcn_global_load_lds((const unsigned*)((const char*)(gbase) + ((((RCB[_i] >> (SH)) & 0xffu) * (unsigned)(Kb) + (RCB[_i] & 0xffu)) * 2u)), (PG8_LAS unsigned*)(lds + (bufoff) + ldsw + _i * 8192), 16, 0, 0); } while (0)
#define PG8_LDA(dst, b, h) do { _Pragma("unroll") for (int m = 0; m < 4; ++m) _Pragma("unroll") for (int k = 0; k < 2; ++k) dst[m][k] = *(const PG8_LAS bf16x8*)(lds + PG8_SA(b, h) + aoff + m * 2048 + k * 1024); } while (0)
#define PG8_LDB(dst, b, h) do { _Pragma("unroll") for (int n = 0; n < 2; ++n) _Pragma("unroll") for (int k = 0; k < 2; ++k) dst[n][k] = *(const PG8_LAS bf16x8*)(lds + PG8_SB(b, h) + boff + n * 2048 + k * 1024); } while (0)
#define PG8_MMA(ai, bj, At, Bt) do { __builtin_amdgcn_s_setprio(1); _Pragma("unroll") for (int m = 0; m < 4; ++m) _Pragma("unroll") for (int n = 0; n < 2; ++n) _Pragma("unroll") for (int k = 0; k < 2; ++k) \
        acc[ai][bj][m][n] = __builtin_amdgcn_mfma_f32_16x16x32_bf16(Bt[n][k], At[m][k], acc[ai][bj][m][n], 0, 0, 0); __builtin_amdgcn_s_setprio(0); } while (0)
#define PG8_WAIT_V(n) asm volatile("s_waitcnt vmcnt(" #n ")" ::: "memory")
#define PG8_WAIT_L(n) asm volatile("s_waitcnt lgkmcnt(" #n ")" ::: "memory")
#define PG8_BAR __builtin_amdgcn_s_barrier()
#define PG8_SCHED __builtin_amdgcn_sched_barrier(0)
    int kG = DM, kA = AOW, kP = POOLW; asm volatile("" : "+s"(kG), "+s"(kA), "+s"(kP));
#define GM_K(tt) ((tt) < NTG ? kG : ((tt) < NTG + NTA ? kA : kP))
#define GM_APTR(pm_, h, tt) ((tt) < NTG ? (const char*)g.XB + ((size_t)((pm_) * BM + (h) * HALF) * DM + (size_t)(tt) * BK) * 2 : \
        ((tt) < NTG + NTA ? (const char*)g.AO + ((size_t)((pm_) * BM + (h) * HALF) * AOW + (size_t)((tt) - NTG) * BK) * 2 : (const char*)g.DIFF + ((size_t)((pm_) * BM + (h) * HALF) * POOLW + (size_t)((tt) - NTG - NTA) * BK) * 2))
#define GM_BPTR(tc_, h, tt) ((tt) < NTG ? (const char*)g.WinT + ((size_t)((11 + (tc_)) * BM + (h) * HALF) * DM + (size_t)(tt) * BK) * 2 : \
        ((tt) < NTG + NTA ? (const char*)g.WpaT + ((size_t)((tc_) * HALF) * AOW + (size_t)((tt) - NTG) * BK) * 2 : (const char*)g.WeffT + ((size_t)((tc_) * HALF) * POOLW + (size_t)((tt) - NTG - NTA) * BK) * 2))
#define GM_ITER(CM, SM) do { \
        PG8_LDB(B0, 0, 0); if (CM) PG8_LDB(B1, 0, 1); PG8_SCHED; PG8_LDA(At, 0, 0); PG8_STAGE(PG8_SA(1, 1), a1h1, RA2, Kc); \
        if (CM) PG8_WAIT_V(8); else PG8_WAIT_V(6); PG8_WAIT_L(0); PG8_BAR; PG8_MMA(0, 0, At, B0); if (CM) PG8_MMA(0, 1, At, B1); PG8_BAR; PG8_SCHED; \
        PG8_LDA(At, 0, 1); PG8_STAGE(PG8_SB(0, 0), b2h0, RB2, Ks); if (SM) PG8_STAGE(PG8_SB(0, 1), b2h1, RB2, Ks); PG8_STAGE(PG8_SA(0, 0), a2h0, RA2, Ks); \
        if (SM) PG8_WAIT_V(8); else PG8_WAIT_V(6); PG8_WAIT_L(0); PG8_BAR; PG8_MMA(1, 0, At, B0); if (CM) PG8_MMA(1, 1, At, B1); PG8_BAR; PG8_SCHED; \
        PG8_LDB(B0, 1, 0); if (CM) PG8_LDB(B1, 1, 1); PG8_SCHED; PG8_LDA(At, 1, 0); PG8_STAGE(PG8_SA(0, 1), a2h1, RA2, Ks); \
        if (SM) PG8_WAIT_V(8); else PG8_WAIT_V(6); PG8_WAIT_L(0); PG8_BAR; PG8_MMA(0, 0, At, B0); if (CM) PG8_MMA(0, 1, At, B1); PG8_BAR; PG8_SCHED; \
        PG8_LDA(At, 1, 1); PG8_STAGE(PG8_SB(1, 0), b2h0 + kstep, RB2, Ks); if (SM) PG8_STAGE(PG8_SB(1, 1), b2h1 + kstep, RB2, Ks); PG8_STAGE(PG8_SA(1, 0), a2h0 + kstep, RA2, Ks); \
        if (SM) PG8_WAIT_V(8); else PG8_WAIT_V(6); PG8_WAIT_L(0); PG8_BAR; PG8_MMA(1, 0, At, B0); if (CM) PG8_MMA(1, 1, At, B1); PG8_BAR; PG8_SCHED; } while (0)
    Unit cur, nxt; int ui = 0;
    if (!S.next(0, cur)) return;
    f32x4 acc[2][2][4][2];
#pragma unroll
    for (int a = 0; a < 2; ++a)
#pragma unroll
        for (int b = 0; b < 2; ++b)
#pragma unroll
            for (int m = 0; m < 4; ++m)
#pragma unroll
                for (int n = 0; n < 2; ++n) acc[a][b][m][n] = (f32x4){0.f, 0.f, 0.f, 0.f};
    bf16x8 At[4][2], B0[2][2], B1[2][2];
    PG8_STAGE(PG8_SB(0, 0), GM_BPTR(cur.pn, 0, 0), RB2, kG); PG8_STAGE(PG8_SB(0, 1), GM_BPTR(cur.pn, 1, 0), RB2, kG); PG8_STAGE(PG8_SA(0, 0), GM_APTR(cur.pm, 0, 0), RA2, kG); PG8_STAGE(PG8_SA(0, 1), GM_APTR(cur.pm, 1, 0), RA2, kG);
    if (wr == 1) PG8_BAR;
    PG8_WAIT_V(2); PG8_BAR;
    PG8_STAGE(PG8_SB(1, 0), GM_BPTR(cur.pn, 0, 1), RB2, kG); PG8_STAGE(PG8_SA(1, 0), GM_APTR(cur.pm, 0, 1), RA2, kG); PG8_STAGE(PG8_SB(1, 1), GM_BPTR(cur.pn, 1, 1), RB2, kG);
    PG8_WAIT_V(6); PG8_BAR;
    for (;;) {
        const bool has_next = S.next(ui + 1, nxt);
        u32x2 rho[2][4][2], sgb[2][4][2];
#define GM_SETUP(t_, last_) const int t2 = (last_) ? 0 : (t_) + 2; const int pm2 = ((last_) && has_next) ? nxt.pm : cur.pm, tc2 = ((last_) && has_next) ? nxt.pn : cur.pn; \
            int Kc = GM_K(t_), Ks = GM_K(t2); asm volatile("" : "+s"(Kc), "+s"(Ks)); const char* a1h1 = GM_APTR(cur.pm, 1, (t_) + 1); \
            const char* a2h0 = GM_APTR(pm2, 0, t2); const char* a2h1 = GM_APTR(pm2, 1, t2); const char* b2h0 = GM_BPTR(tc2, 0, t2); const char* b2h1 = GM_BPTR(tc2, 1, t2)
#pragma unroll 1
        for (int t = 0; t < NTG - 2; t += 2) { GM_SETUP(t, false); GM_ITER(1, 1); }
        if (ui == 0) pre();
        { GM_SETUP(NTG - 2, false); GM_ITER(1, 0); }
        {
            int lc0 = wc * 32 + 8 * fq; asm volatile("" : "+v"(lc0));
            const float* bga = g.bias + GA_OFF + cur.pn * HALF + lc0; const float* bgb = g.bias + GB_OFF + cur.pn * HALF + lc0;
            const f32x4 ba0 = *(const f32x4*)bga, ba1 = *(const f32x4*)(bga + 4), bb0 = *(const f32x4*)bgb, bb1 = *(const f32x4*)(bgb + 4);
#pragma unroll
            for (int ai = 0; ai < 2; ++ai)
#pragma unroll
                for (int m = 0; m < 4; ++m)
#pragma unroll
                    for (int n = 0; n < 2; ++n) { const f32x4 ga = acc[ai][0][m][n] + (n ? ba1 : ba0), gb = acc[ai][1][m][n] + (n ? bb1 : bb0); float r[4], sb[4];
#pragma unroll
                        for (int i = 0; i < 4; ++i) { sb[i] = fsig_gate(gb[i]); r[i] = fsig(ga[i]) * __builtin_amdgcn_rcpf(sb[i]); }
                        rho[ai][m][n].x = cvt_pk_bf16(r[0], r[1]); rho[ai][m][n].y = cvt_pk_bf16(r[2], r[3]); sgb[ai][m][n].x = cvt_pk_bf16(sb[0], sb[1]); sgb[ai][m][n].y = cvt_pk_bf16(sb[2], sb[3]);
                        acc[ai][0][m][n] = (f32x4){0.f, 0.f, 0.f, 0.f}; }
        }
#pragma unroll 1
        for (int t = NTG; t < NTG + NTA; t += 2) { GM_SETUP(t, false); GM_ITER(0, 0); }
#pragma unroll
        for (int ai = 0; ai < 2; ++ai)
#pragma unroll
            for (int m = 0; m < 4; ++m)
#pragma unroll
                for (int n = 0; n < 2; ++n) { f32x4& v = acc[ai][0][m][n]; const u32x2 rr = rho[ai][m][n]; v[0] *= bflo(rr.x); v[1] *= bfhi(rr.x); v[2] *= bflo(rr.y); v[3] *= bfhi(rr.y); }
#pragma unroll 1
        for (int t = NTG + NTA; t < NT - 2; t += 2) { GM_SETUP(t, false); GM_ITER(0, 0); }
        { GM_SETUP(NT - 2, true); GM_ITER(0, 1); }
        if (wr == 0) PG8_BAR;
        {
            const int row0 = cur.pm * BM + wr * 64 + fr, col0 = cur.pn * HALF + wc * 32 + 8 * fq;
#pragma unroll
            for (int ai = 0; ai < 2; ++ai)
#pragma unroll
                for (int m = 0; m < 4; ++m) { const f32x4 v0 = acc[ai][0][m][0], v1 = acc[ai][0][m][1]; const u32x2 s0 = sgb[ai][m][0], s1 = sgb[ai][m][1];
                    u32x4 w; w.x = cvt_pk_bf16(v0[0] * bflo(s0.x), v0[1] * bfhi(s0.x)); w.y = cvt_pk_bf16(v0[2] * bflo(s0.y), v0[3] * bfhi(s0.y));
                    w.z = cvt_pk_bf16(v1[0] * bflo(s1.x), v1[1] * bfhi(s1.x)); w.w = cvt_pk_bf16(v1[2] * bflo(s1.y), v1[3] * bfhi(s1.y));
                    *(u32x4*)(g.MIXED + (size_t)(row0 + ai * HALF + m * 16) * DM + col0) = w; }
        }
        if (!has_next) break;
#pragma unroll
        for (int a = 0; a < 2; ++a)
#pragma unroll
            for (int b = 0; b < 2; ++b)
#pragma unroll
                for (int m = 0; m < 4; ++m)
#pragma unroll
                    for (int n = 0; n < 2; ++n) acc[a][b][m][n] = (f32x4){0.f, 0.f, 0.f, 0.f};
        cur = nxt; ++ui;
        if (wr == 1) PG8_BAR;
    }
    PG8_WAIT_V(0);
    PG8_BAR;
#undef PG8_SA
#undef PG8_SB
#undef PG8_STAGE
#undef PG8_LDA
#undef PG8_LDB
#undef PG8_MMA
#undef PG8_WAIT_V
#undef PG8_WAIT_L
#undef PG8_BAR
#undef PG8_SCHED
#undef GM_K
#undef GM_APTR
#undef GM_BPTR
#undef GM_ITER
#undef GM_SETUP
#undef RA2
#undef RB2
}
}

constexpr int NWAVES = 8;
constexpr int RING_OFF = 0, RING_BYTES = 131072;
constexpr int ATTN_LDS = 147456;
constexpr int BIAS_OFF = ATTN_LDS;
constexpr int LDSCTL_OFF = BIAS_OFF + 3 * 4 * 192 * 4;
constexpr int MISC_OFF = LDSCTL_OFF, TILE_E_OFF = LDSCTL_OFF + 256, FIRST_OFF = TILE_E_OFF + 320 * 4;
constexpr int LDS_BYTES = 163840;
static_assert(FIRST_OFF + 64 * 4 <= LDS_BYTES, "LDS map");
constexpr size_t WS_XB = WS_X1B;
constexpr size_t WT_WIN = WS_WT;
constexpr size_t WT_WPA = WT_WIN + (size_t)INW * DM * 2;
constexpr size_t WT_WEFF = WT_WPA + (size_t)DM * AOW * 2;
constexpr size_t WT_WOUT = WT_WEFF + (size_t)DM * POOLW * 2;
constexpr size_t WT_WGU = WT_WOUT + (size_t)DM * DM * 2;
constexpr size_t WT_WD = WT_WGU + (size_t)NEXP * 512 * DM * 2;
static_assert(WT_WD + (size_t)NEXP * DM * DEXP * 2 <= WS_CTL, "weights fit");
constexpr int CW_CNT = 0;
constexpr int CW_BAR = 4096;
constexpr int CW_READY = 8192;
constexpr int CW_Q9 = 30720, CW_TMO = 30784;
constexpr size_t CTL_ZERO_BYTES = 262144;

#define GAS __attribute__((address_space(1)))
#define LAS __attribute__((address_space(3)))
typedef GAS unsigned gu32;
#define RLX_AGENT __ATOMIC_RELAXED, __HIP_MEMORY_SCOPE_AGENT
#define LDS_WAIT() asm volatile("s_waitcnt lgkmcnt(0)" ::: "memory")
#define VM_WAIT() asm volatile("s_waitcnt vmcnt(0)" ::: "memory")
typedef unsigned v4u __attribute__((ext_vector_type(4)));
__device__ __forceinline__ unsigned pk2(float lo, float hi) { return (unsigned)f2bf(lo) | ((unsigned)f2bf(hi) << 16); }

#define XB_TMO      128
#define XB_XCNT(j)  (256  + 64 * (j))
#define XB_XSUB(j)  (1280 + 64 * (j))
#define XB_XGEN(j)  (2304 + 64 * (j))
#define XB_TOP      3328
#define XB_TOPGEN   3392
#define XCD_BAR_WORDS 3456
#define XB_SPIN_CAP (1u << 18)

__device__ __forceinline__ unsigned xb_ld(unsigned* p)              { return __hip_atomic_load(p, __ATOMIC_RELAXED, __HIP_MEMORY_SCOPE_AGENT); }
__device__ __forceinline__ unsigned xb_add(unsigned* p, unsigned v) { return __hip_atomic_fetch_add(p, v, __ATOMIC_RELAXED, __HIP_MEMORY_SCOPE_AGENT); }
__device__ __forceinline__ unsigned xb_xcc_id() { return (unsigned)__builtin_amdgcn_s_getreg((3 << 11) | 20) & 0xFu; }
#define XB_SPIN(cond, bar) do { unsigned _sp = 0; while (cond) { __builtin_amdgcn_s_sleep(1); \
    if ((++_sp & 255u) == 0u) { if (xb_ld(&(bar)[XB_TMO])) break; if (_sp > XB_SPIN_CAP) { atomicAdd(&(bar)[XB_TMO], 1u); break; } } } } while (0)

struct XcdBarrier {
    unsigned* bar; unsigned x; unsigned w;
    volatile LAS unsigned* st;
};

__device__ __forceinline__ XcdBarrier xcd_barrier_post(unsigned* bar, volatile LAS unsigned* st, unsigned w) {
    XcdBarrier b; b.bar = bar; b.x = xb_xcc_id(); b.st = st; b.w = w;
    if (w == 0u && lane_id() == 0) (void)xb_add(&bar[XB_XCNT(b.x)], 1u);
    return b;
}
__device__ __forceinline__ void xcd_barrier_complete(unsigned* bar, unsigned x, unsigned& nloc, unsigned& nx) {
    const unsigned G = gridDim.x * gridDim.y * gridDim.z;
    unsigned sum, cnt, mine, sp = 0u;
    for (;;) {
        sum = 0u; cnt = 0u; mine = 0u;
#pragma unroll
        for (unsigned j = 0; j < 16; ++j) { const unsigned c = xb_ld(&bar[XB_XCNT(j)]); sum += c; cnt += (c > 0u) ? 1u : 0u; mine = (j == x) ? c : mine; }
        if (sum == G) break;
        __builtin_amdgcn_s_sleep(1);
        if ((++sp & 255u) == 0u) { if (xb_ld(&bar[XB_TMO])) break; if (sp > XB_SPIN_CAP) { atomicAdd(&bar[XB_TMO], 1u); break; } }
    }
    nloc = mine > 0u ? mine : 1u; nx = cnt > 0u ? cnt : 1u;
}

__device__ __forceinline__ void xcd_barrier(const XcdBarrier& b) {
    asm volatile("s_waitcnt vmcnt(0)" ::: "memory");
    __syncthreads();
    if (b.w == 0u && lane_id() == 0) {
        unsigned* bar = b.bar;
        __builtin_amdgcn_s_waitcnt(0);
        unsigned nloc = b.st[0], nx = b.st[1];
        if (nloc == 0u) { xcd_barrier_complete(bar, b.x, nloc, nx); b.st[0] = nloc; b.st[1] = nx; }
        const unsigned old = xb_add(&bar[XB_XSUB(b.x)], 1u);
        const unsigned gen = old / nloc;
        if (old + 1u == (gen + 1u) * nloc) {
            __builtin_amdgcn_fence(__ATOMIC_RELEASE, "agent");
            asm volatile("s_waitcnt vmcnt(0)" ::: "memory");
            const unsigned og = xb_add(&bar[XB_TOP], 1u);
            const unsigned tg = og / nx;
            if (og + 1u == (tg + 1u) * nx) xb_add(&bar[XB_TOPGEN], 1u);
            else XB_SPIN(xb_ld(&bar[XB_TOPGEN]) == tg, bar);
            __builtin_amdgcn_fence(__ATOMIC_ACQUIRE, "agent");
            xb_add(&bar[XB_XGEN(b.x)], 1u);
            asm volatile("s_waitcnt vmcnt(0)" ::: "memory");
        } else {
            XB_SPIN(xb_ld(&bar[XB_XGEN(b.x)]) == gen, bar);
            __builtin_amdgcn_fence(__ATOMIC_ACQUIRE, "agent");
            asm volatile("s_waitcnt vmcnt(0)" ::: "memory");
        }
    }
    __syncthreads();
}

__device__ __forceinline__ void xcd_arrive(const XcdBarrier& b) {
    asm volatile("s_waitcnt vmcnt(0)" ::: "memory");
    __syncthreads();
    if (b.w == 0u && lane_id() == 0) {
        unsigned* bar = b.bar;
        __builtin_amdgcn_s_waitcnt(0);
        unsigned nloc = b.st[0], nx = b.st[1];
        if (nloc == 0u) { xcd_barrier_complete(bar, b.x, nloc, nx); b.st[0] = nloc; b.st[1] = nx; }
        const unsigned old = xb_add(&bar[XB_XSUB(b.x)], 1u);
        const unsigned gen = old / nloc; unsigned role = 0u, tg = 0u;
        if (old + 1u == (gen + 1u) * nloc) {
            __builtin_amdgcn_fence(__ATOMIC_RELEASE, "agent");
            asm volatile("s_waitcnt vmcnt(0)" ::: "memory");
            const unsigned og = xb_add(&bar[XB_TOP], 1u); tg = og / nx;
            if (og + 1u == (tg + 1u) * nx) { xb_add(&bar[XB_TOPGEN], 1u); role = 2u; } else role = 1u;
        }
        b.st[2] = role; b.st[3] = gen; b.st[4] = tg;
    }
}
__device__ __forceinline__ void xcd_wait(const XcdBarrier& b) {
    if (b.w == 0u && lane_id() == 0) {
        unsigned* bar = b.bar; const unsigned role = b.st[2], gen = b.st[3], tg = b.st[4];
        if (role) {
            if (role == 1u) XB_SPIN(xb_ld(&bar[XB_TOPGEN]) == tg, bar);
            __builtin_amdgcn_fence(__ATOMIC_ACQUIRE, "agent");
            xb_add(&bar[XB_XGEN(b.x)], 1u);
            asm volatile("s_waitcnt vmcnt(0)" ::: "memory");
        } else {
            XB_SPIN(xb_ld(&bar[XB_XGEN(b.x)]) == gen, bar);
            __builtin_amdgcn_fence(__ATOMIC_ACQUIRE, "agent");
            asm volatile("s_waitcnt vmcnt(0)" ::: "memory");
        }
    }
    asm volatile("s_waitcnt lgkmcnt(0)" ::: "memory"); __builtin_amdgcn_s_barrier(); asm volatile("" ::: "memory");
}


struct Frame {
    LAS unsigned char* lds;
    int wave, vcu, G;
};
struct MArgs { const float* in[20]; float* out; unsigned char* ws; int ph_lo, ph_hi; };

struct TrItem { const float* W; bf16_t* WT; int K, N, k0, n0, drow0; };
__device__ __forceinline__ void tr_load(const TrItem& t, float (&v)[32], int lane) {
#pragma unroll
    for (int i = 0; i < 32; ++i) v[i] = t.W[(size_t)(t.k0 + 2 * i + (lane >> 5)) * t.N + t.n0 + (lane & 31)];
}
__device__ __forceinline__ void tr_store(const TrItem& t, const float (&v)[32], LAS float* scr, int lane) {
#pragma unroll
    for (int i = 0; i < 32; ++i) scr[(2 * i + (lane >> 5)) * 33 + (lane & 31)] = v[i];
    LDS_WAIT(); asm volatile("" ::: "memory");
    const int c = lane & 7;
#pragma unroll
    for (int j = 0; j < 4; ++j) { const int n = (lane >> 3) + 8 * j; const LAS float* s = scr + (8 * c) * 33 + n;
        v4u o; o.x = pk2(s[0 * 33], s[1 * 33]); o.y = pk2(s[2 * 33], s[3 * 33]); o.z = pk2(s[4 * 33], s[5 * 33]); o.w = pk2(s[6 * 33], s[7 * 33]);
        *(GAS v4u*)(t.WT + (size_t)(t.drow0 + n) * t.K + t.k0 + 8 * c) = o; }
    LDS_WAIT(); asm volatile("" ::: "memory");
}
constexpr int TR_IN = (DM / 64) * (INW / 32), TR_PA = (AOW / 64) * (DM / 32), TR_OUT = (DM / 64) * (DM / 32), TR_G = (DM / 64) * (DEXP / 32), TR_D = (DEXP / 64) * (DM / 32);
constexpr int TR_DENSE = TR_IN + TR_PA + TR_OUT, TR_EXP = NEXP * (2 * TR_G + TR_D);
__device__ __forceinline__ TrItem tr_item(const MArgs& a, int it) {
    unsigned char* ws = a.ws; TrItem t; int r = it;
    if (r < TR_IN) { const int nb = INW / 32; t.W = a.in[1]; t.WT = (bf16_t*)(ws + WT_WIN); t.K = DM; t.N = INW; t.k0 = (r / nb) * 64; t.n0 = (r % nb) * 32;
        t.drow0 = t.n0 < GA_OFF ? t.n0 : (t.n0 < GB_OFF ? GA_OFF + ((t.n0 - GA_OFF) >> 7) * 256 + ((t.n0 - GA_OFF) & 127) : GA_OFF + ((t.n0 - GB_OFF) >> 7) * 256 + 128 + ((t.n0 - GB_OFF) & 127)); return t; } r -= TR_IN;
    if (r < TR_PA) { const int nb = DM / 32; t.W = a.in[6]; t.WT = (bf16_t*)(ws + WT_WPA); t.K = AOW; t.N = DM; t.k0 = (r / nb) * 64; t.n0 = (r % nb) * 32; t.drow0 = t.n0; return t; } r -= TR_PA;
    if (r < TR_OUT) { const int nb = DM / 32; t.W = a.in[8]; t.WT = (bf16_t*)(ws + WT_WOUT); t.K = DM; t.N = DM; t.k0 = (r / nb) * 64; t.n0 = (r % nb) * 32; t.drow0 = t.n0; return t; } r -= TR_OUT;
    const int e = r / (2 * TR_G + TR_D); r -= e * (2 * TR_G + TR_D);
    if (r < 2 * TR_G) { const int up = r >= TR_G; if (up) r -= TR_G; const int nb = DEXP / 32; t.W = (up ? a.in[16] : a.in[15]) + (size_t)e * DM * DEXP; t.WT = (bf16_t*)(ws + WT_WGU); t.K = DM; t.N = DEXP;
        t.k0 = (r / nb) * 64; t.n0 = (r % nb) * 32; t.drow0 = e * 512 + (t.n0 >> 7) * 256 + up * 128 + (t.n0 & 127); return t; }
    r -= 2 * TR_G;
    { const int nb = DM / 32; t.W = a.in[17] + (size_t)e * DEXP * DM; t.WT = (bf16_t*)(ws + WT_WD) + (size_t)e * DM * DEXP; t.K = DEXP; t.N = DM; t.k0 = (r / nb) * 64; t.n0 = (r % nb) * 32; t.drow0 = t.n0; return t; }
}
__device__ __forceinline__ void tr_run(Frame& F, const MArgs& a, int first, int stride, int end) {
    LAS float* scr = (LAS float*)(F.lds + RING_OFF + F.wave * 16384);
    if (first >= end) return;
    float vn[32]; TrItem tn = tr_item(a, first); tr_load(tn, vn, lane_id());
    for (int it = first; it < end; it += stride) {
        float v[32]; TrItem t = tn;
#pragma unroll
        for (int i = 0; i < 32; ++i) v[i] = vn[i];
        if (it + stride < end) { tn = tr_item(a, it + stride); tr_load(tn, vn, lane_id()); }
        tr_store(t, v, scr, lane_id());
    }
}
__device__ __forceinline__ void p0_prologue(Frame& F, const MArgs& a) {
    unsigned char* ws = a.ws;
    const int gw = F.vcu * NWAVES + F.wave, NGW = F.G * NWAVES, lane = lane_id();
    const float* w_pool = a.in[4]; const float* pscale = a.in[5]; const float* w_pp = a.in[7];
    bf16_t* WeffT = (bf16_t*)(ws + WT_WEFF);
    tr_run(F, a, gw, NGW, TR_DENSE);
    for (int it = gw; it < (DM / 32) * (POOLW / 32); it += NGW) {
        const int nb = it >> 4, kb = it & 15, g = kb >> 2, n0 = nb * 32, c0 = (kb & 3) * 32, rr = lane & 31, kk = lane >> 5;
        typedef float f32x16 __attribute__((ext_vector_type(16)));
        f32x16 acc = {0.f, 0.f, 0.f, 0.f, 0.f, 0.f, 0.f, 0.f, 0.f, 0.f, 0.f, 0.f, 0.f, 0.f, 0.f, 0.f};
        const float* ap = w_pp + (size_t)(g * 128 + kk) * DM + n0 + rr;
        const float* sp = pscale + g * 128 + kk;
        const float* bp = w_pool + (size_t)(g * 128 + c0 + rr) * 128 + kk;
#pragma unroll 16
        for (int ks = 0; ks < 64; ++ks) { const float av = ap[(size_t)(2 * ks) * DM] * sp[2 * ks], bv = bp[2 * ks];
            acc = __builtin_amdgcn_mfma_f32_32x32x2f32(av, bv, acc, 0, 0, 0); }
#pragma unroll
        for (int i = 0; i < 16; ++i) { const int n = n0 + (i & 3) + 8 * (i >> 2) + 4 * kk;
            WeffT[(size_t)n * POOLW + g * 128 + c0 + rr] = f2bf(acc[i]); }
    }
    const float* x = a.in[0]; bf16_t* XB = (bf16_t*)(ws + WS_XB);
    for (int it = gw * 8; it < NTOK * DM / 512; it += NGW * 8) {
        f32x4 a0[8], a1[8];
#pragma unroll
        for (int u = 0; u < 8; ++u) { const size_t o = (size_t)(it + u) * 512 + lane * 8; a0[u] = *(const f32x4*)(x + o); a1[u] = *(const f32x4*)(x + o + 4); }
#pragma unroll
        for (int u = 0; u < 8; ++u) { const size_t o = (size_t)(it + u) * 512 + lane * 8;
            v4u w; w.x = pk2(a0[u][0], a0[u][1]); w.y = pk2(a0[u][2], a0[u][3]); w.z = pk2(a1[u][0], a1[u][1]); w.w = pk2(a1[u][2], a1[u][3]);
            *(GAS v4u*)(XB + o) = w; } }
}

__device__ __forceinline__ int moe_tables(Frame& F, const int* cnt) {
    LAS int* tile_e = (LAS int*)(F.lds + TILE_E_OFF); LAS int* first = (LAS int*)(F.lds + FIRST_OFF);
    __syncthreads();
    if ((F.wave * 64 + lane_id()) < 64) {
        const int e = (F.wave * 64 + lane_id()), nt = (e < NEXP) ? ((__hip_atomic_load(cnt + (e & 31) * 64, RLX_AGENT) + 255) >> 8) : 0;
        int incl = nt;
#pragma unroll
        for (int o = 1; o < 32; o <<= 1) { const int t = __shfl_up(incl, o); if ((e & 31) >= o) incl += t; }
        const int f0 = incl - nt;
        if (e < NEXP) { first[e] = f0; for (int i = 0; i < nt; ++i) tile_e[f0 + i] = e; if (e == NEXP - 1) first[NEXP] = incl; }
    }
    __syncthreads();
    return first[NEXP];
}


typedef float f32x16 __attribute__((ext_vector_type(16)));
typedef short s16x4 __attribute__((ext_vector_type(4)));
constexpr float LOG2E = 1.4426950408889634f;
constexpr float QSCALE = 0.125f * LOG2E;
constexpr int VROW = 192;
__device__ __forceinline__ s16x4 vtr(const LAS unsigned char* p) { return __builtin_bit_cast(s16x4, __builtin_amdgcn_ds_read_tr16_b64_v4i16((LAS s16x4*)p)); }
constexpr int AT_K = 0, AT_V0 = 49152, AT_V1 = 98304;
__device__ __forceinline__ void attn_unit_decode(int un, int& b, int& h, int& g, int& dil, int& L, int& c0, int& l0) {
    const int j = un & 7, bh = un >> 3; h = bh % 12; b = bh / 12; g = h >> 2; dil = 1 << (2 * g); L = SEQ >> (2 * g);
    if (g == 0) { c0 = 0; l0 = 256 * j; } else if (g == 1) { c0 = j >> 1; l0 = 256 * (j & 1); } else { c0 = 2 * j; l0 = 0; }
}
__device__ __forceinline__ size_t attn_krow(int b, int g, int L, int c0, int l0, int wr_) {
    if (g == 2) { const int cls = c0 + ((wr_ >> 7) & 1), l = wr_ & 127; return (size_t)b * SEQ + (size_t)cls * L + l; }
    int l = l0 - 128 + wr_; l = l < 0 ? 0 : l; return (size_t)b * SEQ + (size_t)c0 * L + l;
}
__device__ __forceinline__ void attn_wave_q(int g, int c0, int l0, int w, int& cq, int& lq0) { cq = (g == 2) ? c0 + (w >> 2) : c0; lq0 = (g == 2) ? 32 * (w & 3) : l0 + 32 * w; }
__device__ __forceinline__ void phase_attn(Frame& F, const MArgs& a, const bf16_t* proj, bf16_t* aog, float* lse) {
    LAS float* bias2 = (LAS float*)(F.lds + BIAS_OFF);
    const float* rel_bias = a.in[3];
    int tid0 = (F.wave * 64 + lane_id()); asm volatile("" : "+v"(tid0));
    for (int i = tid0; i < 3 * 4 * 192; i += NWAVES * 64) { const int gs = i / 192, j = i - gs * 192 - 32, g = gs >> 2, dil = 1 << (2 * g);
        bias2[i] = (j >= 0 && j <= 128) ? rel_bias[t5_bucket(j * dil) * 12 + gs] * LOG2E : -1.0e30f; }
    asm volatile("s_waitcnt vmcnt(0) lgkmcnt(0)" ::: "memory"); __builtin_amdgcn_s_barrier(); asm volatile("" ::: "memory");
    LAS unsigned char* ring = F.lds;
    const unsigned lds0 = (unsigned)(size_t)F.lds;
    const int lane = lane_id(), w = F.wave, r = lane & 31, hh = lane >> 5;
    const int NU = BATCH * 12 * 8;
    const int drow = lane >> 3, schunk = (lane & 7) ^ (lane >> 3);
    int koff[4];
#pragma unroll
    for (int ks = 0; ks < 4; ++ks) koff[ks] = r * 128 + ((((2 * ks + hh) ^ (r & 7))) << 4);
    const int trow = 4 * hh + ((lane & 15) >> 2);
    int toff[2];
#pragma unroll
    for (int dt = 0; dt < 2; ++dt) toff[dt] = trow * 128 + (((4 * dt + 2 * ((lane >> 4) & 1) + ((lane & 3) >> 1)) ^ (trow & 7)) << 4) + (lane & 1) * 8;
#define AT_DMA(dst_off, col_off) do { _Pragma("unroll") for (int _p = 0; _p < 6; ++_p) { const int _pc = w + 8 * _p; \
        const bf16_t* _src = proj + attn_krow(b_, g_, L_, c0_, l0_, _pc * 8 + drow) * INW + (col_off) + h_ * HD + schunk * 8; \
        unsigned _keep; const unsigned _dst = (unsigned)__builtin_amdgcn_readfirstlane((int)(lds0 + (unsigned)(dst_off) + (unsigned)_pc * 1024u)); \
        asm volatile("s_mov_b32 %0, m0\n\ts_mov_b32 m0, %2\n\ts_nop 0\n\tglobal_load_lds_dwordx4 %1, off\n\ts_mov_b32 m0, %0" : "=&s"(_keep) : "v"(_src), "s"(_dst) : "memory"); } } while (0)
#define AT_QLOAD(dst) do { int cq_, lq_; attn_wave_q(g_, c0_, l0_, w, cq_, lq_); const bf16_t* _qp = proj + ((size_t)b_ * SEQ + (size_t)cq_ * L_ + lq_ + r) * INW + Q_OFF + h_ * HD + 8 * hh; \
        _Pragma("unroll") for (int ks = 0; ks < 4; ++ks) dst[ks] = *(const bf16x8*)(_qp + 16 * ks); } while (0)
    bf16x8 qn[4];
    int un = F.vcu;
    { int b_, h_, g_, dil_, L_, c0_, l0_; attn_unit_decode(un, b_, h_, g_, dil_, L_, c0_, l0_); (void)dil_;
      AT_QLOAD(qn); AT_DMA(AT_K, K_OFF); AT_DMA(AT_V0, V_OFF); }
    bool first = true;
    for (int par = 0; un < NU; un += F.G, par ^= 1) {
        int b, h, g, dil, L, c0, l0; attn_unit_decode(un, b, h, g, dil, L, c0, l0);
        const bool has_next = (un + F.G) < NU;
        int cq, lq0; attn_wave_q(g, c0, l0, w, cq, lq0);
        const int wbase = (g == 2) ? 128 * (w >> 2) + 32 * (w & 3) - 128 : 32 * w;
        bf16x8 qf[4];
#pragma unroll
        for (int ks = 0; ks < 4; ++ks) qf[ks] = qn[ks];
        if (first) asm volatile("s_waitcnt vmcnt(0)" ::: "memory"); else asm volatile("s_waitcnt vmcnt(9)" ::: "memory");
        first = false;
        __builtin_amdgcn_s_barrier(); asm volatile("" ::: "memory");
        if (has_next) { int b_, h_, g_, dil_, L_, c0_, l0_; attn_unit_decode(un + F.G, b_, h_, g_, dil_, L_, c0_, l0_); (void)dil_;
            AT_QLOAD(qn); if (par == 0) AT_DMA(AT_V1, V_OFF); else AT_DMA(AT_V0, V_OFF); }
        f32x16 st[5];
#pragma unroll
        for (int kt = 0; kt < 5; ++kt) {
            int wrow = wbase + 32 * kt; if (g == 2) { const int lo_ = 128 * (w >> 2); wrow = wrow < lo_ ? lo_ : wrow; }
            f32x16 acc = {0.f, 0.f, 0.f, 0.f, 0.f, 0.f, 0.f, 0.f, 0.f, 0.f, 0.f, 0.f, 0.f, 0.f, 0.f, 0.f};
#pragma unroll
            for (int ks = 0; ks < 4; ++ks) { const bf16x8 kf = *(const LAS bf16x8*)(ring + AT_K + wrow * 128 + koff[ks]);
                acc = __builtin_amdgcn_mfma_f32_32x32x16_bf16(kf, qf[ks], acc, 0, 0, 0); }
            st[kt] = acc;
        }
        asm volatile("s_waitcnt lgkmcnt(0)" ::: "memory"); __builtin_amdgcn_s_barrier(); asm volatile("" ::: "memory");
        if (has_next) { int b_, h_, g_, dil_, L_, c0_, l0_; attn_unit_decode(un + F.G, b_, h_, g_, dil_, L_, c0_, l0_); (void)dil_; AT_DMA(AT_K, K_OFF); }
        const LAS float* bt = bias2 + h * 192 + 32 + 128 + (r - 4 * hh);
        float mx = -1.0e30f;
        if (lq0 >= 128) {
#pragma unroll
            for (int kt = 0; kt < 5; ++kt)
#pragma unroll
                for (int hb = 0; hb < 2; ++hb) { float bvv[8];
#pragma unroll
                    for (int i = 0; i < 8; ++i) bvv[i] = bt[-32 * kt - ((i & 3) + 8 * (2 * hb + (i >> 2)))];
                    asm volatile("" : "+v"(bvv[0]), "+v"(bvv[1]), "+v"(bvv[2]), "+v"(bvv[3]), "+v"(bvv[4]), "+v"(bvv[5]), "+v"(bvv[6]), "+v"(bvv[7]));
#pragma unroll
                    for (int i = 0; i < 8; ++i) { const float sv = st[kt][8 * hb + i] + bvv[i]; st[kt][8 * hb + i] = sv; mx = fmaxf(mx, sv); } }
        } else {
            const int jmax = lq0 + r, jl = 128 + r - 4 * hh;
#pragma unroll
            for (int kt = 0; kt < 5; ++kt)
#pragma unroll
                for (int hb = 0; hb < 2; ++hb) { float bvv[8];
#pragma unroll
                    for (int i = 0; i < 8; ++i) bvv[i] = bt[-32 * kt - ((i & 3) + 8 * (2 * hb + (i >> 2)))];
                    asm volatile("" : "+v"(bvv[0]), "+v"(bvv[1]), "+v"(bvv[2]), "+v"(bvv[3]), "+v"(bvv[4]), "+v"(bvv[5]), "+v"(bvv[6]), "+v"(bvv[7]));
#pragma unroll
                    for (int i = 0; i < 8; ++i) { const int jc = -32 * kt - ((i & 3) + 8 * (2 * hb + (i >> 2)));
                        const float sv = (jl + jc <= jmax) ? st[kt][8 * hb + i] + bvv[i] : -1.0e30f; st[kt][8 * hb + i] = sv; mx = fmaxf(mx, sv); } }
        }
        mx = fmaxf(mx, __shfl_xor(mx, 32));
        float lsum = 0.f;
#pragma unroll
        for (int kt = 0; kt < 5; ++kt)
#pragma unroll
            for (int i = 0; i < 16; ++i) { const float pv = __builtin_amdgcn_exp2f(st[kt][i] - mx); st[kt][i] = pv; lsum += pv; }
        lsum += __shfl_xor(lsum, 32);
        f32x16 o0 = {0.f, 0.f, 0.f, 0.f, 0.f, 0.f, 0.f, 0.f, 0.f, 0.f, 0.f, 0.f, 0.f, 0.f, 0.f, 0.f}, o1 = o0;
        const int vbuf = par ? AT_V1 : AT_V0;
#pragma unroll
        for (int kt = 0; kt < 5; ++kt) {
            int wrow = wbase + 32 * kt; if (g == 2) { const int lo_ = 128 * (w >> 2); wrow = wrow < lo_ ? lo_ : wrow; }
            const LAS unsigned char* vb = ring + vbuf + wrow * 128;
#pragma unroll
            for (int s2 = 0; s2 < 2; ++s2) {
                pg8::u32x4 pw; pw.x = pg8::cvt_pk_bf16(st[kt][8 * s2 + 0], st[kt][8 * s2 + 1]); pw.y = pg8::cvt_pk_bf16(st[kt][8 * s2 + 2], st[kt][8 * s2 + 3]);
                pw.z = pg8::cvt_pk_bf16(st[kt][8 * s2 + 4], st[kt][8 * s2 + 5]); pw.w = pg8::cvt_pk_bf16(st[kt][8 * s2 + 6], st[kt][8 * s2 + 7]);
                const bf16x8 pf = __builtin_bit_cast(bf16x8, pw);
#pragma unroll
                for (int dt = 0; dt < 2; ++dt) {
                    const s16x4 lo = vtr(vb + (16 * s2) * 128 + toff[dt]), hi = vtr(vb + (16 * s2 + 8) * 128 + toff[dt]);
                    const bf16x8 vf = {lo[0], lo[1], lo[2], lo[3], hi[0], hi[1], hi[2], hi[3]};
                    if (dt == 0) o0 = __builtin_amdgcn_mfma_f32_32x32x16_bf16(vf, pf, o0, 0, 0, 0); else o1 = __builtin_amdgcn_mfma_f32_32x32x16_bf16(vf, pf, o1, 0, 0, 0);
                }
            }
        }
        const float inv = 1.f / lsum;
        const int tok = b * SEQ + cq + dil * (lq0 + r);
        bf16_t* op = aog + ((size_t)g * NTOK + tok) * AOW + (h & 3) * HD + 4 * hh;
#pragma unroll
        for (int dt = 0; dt < 2; ++dt)
#pragma unroll
            for (int q4 = 0; q4 < 4; ++q4) { const f32x16& o = dt == 0 ? o0 : o1;
                pg8::u32x2 wv; wv.x = pg8::cvt_pk_bf16(o[4 * q4] * inv, o[4 * q4 + 1] * inv); wv.y = pg8::cvt_pk_bf16(o[4 * q4 + 2] * inv, o[4 * q4 + 3] * inv);
                *(pg8::u32x2*)(op + 32 * dt + 8 * q4) = wv; }
        if (hh == 0) lse[((size_t)g * NTOK + tok) * 4 + (h & 3)] = mx + __builtin_amdgcn_logf(lsum);
        asm volatile("s_waitcnt lgkmcnt(0)" ::: "memory");
    }
    asm volatile("s_waitcnt vmcnt(0) lgkmcnt(0)" ::: "memory"); __builtin_amdgcn_s_barrier(); asm volatile("" ::: "memory");
#undef AT_DMA
#undef AT_QLOAD
}
template <int W, int NI> __device__ __forceinline__ void pool_items(const bf16_t* proj, bf16_t* diff, int tok0, int ch) {
    pg8::u32x4 v[NI][W];
#pragma unroll
    for (int u = 0; u < NI; ++u) { const int tok = tok0 + 8 * u, t = tok & (SEQ - 1); const bf16_t* p = proj + (size_t)tok * INW + POOL_OFF + ch * 8;
#pragma unroll
        for (int j = 0; j < W; ++j) v[u][j] = *(const pg8::u32x4*)(p - (size_t)((t >= j) ? j : 0) * INW); }
#pragma unroll
    for (int u = 0; u < NI; ++u) { const int tok = tok0 + 8 * u, t = tok & (SEQ - 1);
        float s[8];
#pragma unroll
        for (int e = 0; e < 8; ++e) s[e] = 0.f;
#pragma unroll
        for (int j = 0; j < W; ++j) { const float m = (t >= j) ? 1.f : 0.f;
            s[0] += m * pg8::bflo(v[u][j].x); s[1] += m * pg8::bfhi(v[u][j].x); s[2] += m * pg8::bflo(v[u][j].y); s[3] += m * pg8::bfhi(v[u][j].y);
            s[4] += m * pg8::bflo(v[u][j].z); s[5] += m * pg8::bfhi(v[u][j].z); s[6] += m * pg8::bflo(v[u][j].w); s[7] += m * pg8::bfhi(v[u][j].w); }
        const float ic = 1.f / (float)((t + 1 < W) ? t + 1 : W);
        pg8::u32x4 o;
        o.x = pg8::cvt_pk_bf16(s[0] * ic - pg8::bflo(v[u][0].x), s[1] * ic - pg8::bfhi(v[u][0].x)); o.y = pg8::cvt_pk_bf16(s[2] * ic - pg8::bflo(v[u][0].y), s[3] * ic - pg8::bfhi(v[u][0].y));
        o.z = pg8::cvt_pk_bf16(s[4] * ic - pg8::bflo(v[u][0].z), s[5] * ic - pg8::bfhi(v[u][0].z)); o.w = pg8::cvt_pk_bf16(s[6] * ic - pg8::bflo(v[u][0].w), s[7] * ic - pg8::bfhi(v[u][0].w));
        *(pg8::u32x4*)(diff + (size_t)tok * POOLW + ch * 8) = o; }
}
__device__ __forceinline__ void phase_pool(Frame& F, const bf16_t* proj, bf16_t* diff) {
    const int gw = F.vcu * NWAVES + F.wave, NGW = F.G * NWAVES, lane = lane_id();
    for (int it = gw; it < NTOK / 4; it += NGW) {
        const int tg = it >> 3, cg = ((it & 7) + 2 * (it / NGW)) & 7, tok0 = tg * 32 + (lane >> 3), ch = cg * 8 + (lane & 7), gi = cg >> 1;
        if (gi == 0) pool_items<2, 4>(proj, diff, tok0, ch); else if (gi == 1) pool_items<4, 4>(proj, diff, tok0, ch);
        else if (gi == 2) { pool_items<8, 2>(proj, diff, tok0, ch); pool_items<8, 2>(proj, diff, tok0 + 16, ch); }
        else { pool_items<16, 1>(proj, diff, tok0, ch); pool_items<16, 1>(proj, diff, tok0 + 8, ch); pool_items<16, 1>(proj, diff, tok0 + 16, ch); pool_items<16, 1>(proj, diff, tok0 + 24, ch); }
    }
}
__device__ __forceinline__ void phase_combine(Frame& F, const bf16_t* aog, const float* lse, bf16_t* ao) {
    const int gt = (F.vcu * NWAVES + F.wave) * 64 + lane_id(), NGT = F.G * NWAVES * 64;
    for (int it = gt; it < NTOK * 32; it += NGT) {
        const int tok = it >> 5, ch = it & 31, slot = ch >> 3;
        const float l0 = lse[((size_t)0 * NTOK + tok) * 4 + slot], l1 = lse[((size_t)1 * NTOK + tok) * 4 + slot], l2 = lse[((size_t)2 * NTOK + tok) * 4 + slot];
        const float M = fmaxf(l0, fmaxf(l1, l2));
        float w0 = __builtin_amdgcn_exp2f(l0 - M), w1 = __builtin_amdgcn_exp2f(l1 - M), w2 = __builtin_amdgcn_exp2f(l2 - M);
        const float iw = 1.f / (w0 + w1 + w2); w0 *= iw; w1 *= iw; w2 *= iw;
        const pg8::u32x4 a0 = *(const pg8::u32x4*)(aog + ((size_t)0 * NTOK + tok) * AOW + ch * 8), a1 = *(const pg8::u32x4*)(aog + ((size_t)1 * NTOK + tok) * AOW + ch * 8),
                         a2 = *(const pg8::u32x4*)(aog + ((size_t)2 * NTOK + tok) * AOW + ch * 8);
        pg8::u32x4 o;
#define CMB(f) pg8::cvt_pk_bf16(w0 * pg8::bflo(a0.f) + w1 * pg8::bflo(a1.f) + w2 * pg8::bflo(a2.f), w0 * pg8::bfhi(a0.f) + w1 * pg8::bfhi(a1.f) + w2 * pg8::bfhi(a2.f))
        o.x = CMB(x); o.y = CMB(y); o.z = CMB(z); o.w = CMB(w);
#undef CMB
        *(pg8::u32x4*)(ao + (size_t)tok * AOW + ch * 8) = o;
    }
}

constexpr int XS = 1028;
__device__ __forceinline__ void phase_ln_router(Frame& F, const MArgs& a, const bf16_t* y, bf16_t* x1b, int* cnt, int* list, float* listw) {
    const float* x = a.in[0];
    LAS float* xs = (LAS float*)(F.lds + RING_OFF);
    LAS float* part = xs + 16 * XS;
    LAS float* lgs = part + 8 * 16 * 48;
    LAS unsigned* lcnt = (LAS unsigned*)(lgs + 8 * 16 * 40);
    LAS int* rtab = (LAS int*)(lcnt + 32);
    if ((F.wave * 64 + lane_id()) < 32) lcnt[(F.wave * 64 + lane_id())] = 0u;
    const float* g1 = a.in[9]; const float* b1 = a.in[10]; const float* wrg = a.in[11]; const float* brg = a.in[12]; const float* wre = a.in[13]; const float* bre = a.in[14];
    LAS float* gb1 = (LAS float*)(F.lds + RING_OFF + 122880);
    { int tid0 = (F.wave * 64 + lane_id()); asm volatile("" : "+v"(tid0)); for (int i = tid0; i < 2 * DM; i += NWAVES * 64) gb1[i] = (i < DM) ? g1[i] : b1[i - DM]; }
    __syncthreads();
    const int lane = lane_id(), w = F.wave, t16 = lane & 15, q = lane >> 4, tid = (F.wave * 64 + lane_id());
    bf16x8 wBh[4][3], wBl[4][3];
#pragma unroll
    for (int ks = 0; ks < 4; ++ks)
#pragma unroll
        for (int ct = 0; ct < 3; ++ct) { const int o = 16 * ct + t16; float wv[8];
#pragma unroll
            for (int j = 0; j < 8; ++j) { const int k = 128 * w + 32 * ks + 8 * q + j; wv[j] = (o < 4) ? wrg[k * 4 + o] : ((o < 36) ? wre[k * 32 + o - 4] : 0.f); }
            pg8::u32x4 hw, lw;
#pragma unroll
            for (int j2 = 0; j2 < 4; ++j2) { const unsigned hp = pg8::cvt_pk_bf16(wv[2 * j2], wv[2 * j2 + 1]);
                const unsigned lp = pg8::cvt_pk_bf16(wv[2 * j2] - pg8::bflo(hp), wv[2 * j2 + 1] - pg8::bfhi(hp)); hw[j2] = hp; lw[j2] = lp; }
            wBh[ks][ct] = __builtin_bit_cast(bf16x8, hw); wBl[ks][ct] = __builtin_bit_cast(bf16x8, lw); }
    const int ntile = NTOK / 16;
    f32x4 vn[2][4]; pg8::u32x2 yn[2][4];
#define LNR_LOAD(T_) do { _Pragma("unroll") for (int rr = 0; rr < 2; ++rr) _Pragma("unroll") for (int j = 0; j < 4; ++j) { const size_t o_ = (size_t)(16 * (T_) + 2 * w + rr) * DM + lane * 4 + 256 * j; \
        vn[rr][j] = *(const f32x4*)(x + o_); yn[rr][j] = *(const pg8::u32x2*)(y + o_); } } while (0)
    LNR_LOAD(F.vcu);
    const float rb0 = ((tid % 36) < 4) ? brg[tid % 36] : bre[(tid % 36) - 4], rb1 = (((tid + NWAVES * 64) % 36) < 4) ? brg[(tid + NWAVES * 64) % 36] : bre[((tid + NWAVES * 64) % 36) - 4];
    int ti = 0;
    for (int T = F.vcu; T < ntile; T += F.G, ++ti) {
        f32x4 v[2][4];
#pragma unroll
        for (int rr = 0; rr < 2; ++rr)
#pragma unroll
            for (int j = 0; j < 4; ++j) { f32x4 z = vn[rr][j] * ALPHA; z[0] += pg8::bflo(yn[rr][j].x); z[1] += pg8::bfhi(yn[rr][j].x); z[2] += pg8::bflo(yn[rr][j].y); z[3] += pg8::bfhi(yn[rr][j].y); v[rr][j] = z; }
        if (T + F.G < ntile) LNR_LOAD(T + F.G);
#pragma unroll
        for (int rr = 0; rr < 2; ++rr) {
            const int tok = 16 * T + 2 * w + rr;
            float s = 0.f;
#pragma unroll
            for (int j = 0; j < 4; ++j) s += (v[rr][j][0] + v[rr][j][1]) + (v[rr][j][2] + v[rr][j][3]);
            const float mean = wave_sum(s) * (1.f / DM); float s2 = 0.f;
#pragma unroll
            for (int j = 0; j < 4; ++j) { const f32x4 d = v[rr][j] - mean; s2 += (d[0] * d[0] + d[1] * d[1]) + (d[2] * d[2] + d[3] * d[3]); }
            const float rstd = 1.f / sqrtf(wave_sum(s2) * (1.f / DM) + LN_EPS);
#pragma unroll
            for (int j = 0; j < 4; ++j) { const int k0 = lane * 4 + 256 * j;
                const f32x4 x1 = (v[rr][j] - mean) * rstd * *(const LAS f32x4*)(gb1 + k0) + *(const LAS f32x4*)(gb1 + DM + k0);
                *(LAS f32x4*)(xs + (2 * w + rr) * XS + k0) = x1;
                pg8::u32x2 pk; pk.x = pg8::cvt_pk_bf16(x1[0], x1[1]); pk.y = pg8::cvt_pk_bf16(x1[2], x1[3]);
                *(pg8::u32x2*)(x1b + (size_t)tok * DM + k0) = pk; }
        }
        __syncthreads();
        f32x4 acc[3];
#pragma unroll
        for (int ct = 0; ct < 3; ++ct) acc[ct] = (f32x4){0.f, 0.f, 0.f, 0.f};
        const LAS float* xr = xs + t16 * XS + 128 * w + 8 * q;
#pragma unroll
        for (int ks = 0; ks < 4; ++ks) { const f32x4 xa = *(const LAS f32x4*)(xr + 32 * ks), xb = *(const LAS f32x4*)(xr + 32 * ks + 4);
            pg8::u32x4 hw, lw;
            hw.x = pg8::cvt_pk_bf16(xa[0], xa[1]); hw.y = pg8::cvt_pk_bf16(xa[2], xa[3]); hw.z = pg8::cvt_pk_bf16(xb[0], xb[1]); hw.w = pg8::cvt_pk_bf16(xb[2], xb[3]);
            lw.x = pg8::cvt_pk_bf16(xa[0] - pg8::bflo(hw.x), xa[1] - pg8::bfhi(hw.x)); lw.y = pg8::cvt_pk_bf16(xa[2] - pg8::bflo(hw.y), xa[3] - pg8::bfhi(hw.y));
            lw.z = pg8::cvt_pk_bf16(xb[0] - pg8::bflo(hw.z), xb[1] - pg8::bfhi(hw.z)); lw.w = pg8::cvt_pk_bf16(xb[2] - pg8::bflo(hw.w), xb[3] - pg8::bfhi(hw.w));
            const bf16x8 ah = __builtin_bit_cast(bf16x8, hw), al = __builtin_bit_cast(bf16x8, lw);
#pragma unroll
            for (int ct = 0; ct < 3; ++ct) {
                acc[ct] = __builtin_amdgcn_mfma_f32_16x16x32_bf16(ah, wBh[ks][ct], acc[ct], 0, 0, 0);
                acc[ct] = __builtin_amdgcn_mfma_f32_16x16x32_bf16(al, wBh[ks][ct], acc[ct], 0, 0, 0);
                acc[ct] = __builtin_amdgcn_mfma_f32_16x16x32_bf16(ah, wBl[ks][ct], acc[ct], 0, 0, 0); } }
#pragma unroll
        for (int ct = 0; ct < 3; ++ct)
#pragma unroll
            for (int rg = 0; rg < 4; ++rg) part[(w * 16 + 4 * q + rg) * 48 + 16 * ct + t16] = acc[ct][rg];
        __syncthreads();
        for (int i = tid; i < 16 * 36; i += NWAVES * 64) { const int tk = i / 36, o = i - tk * 36; float sum = (i < NWAVES * 64) ? rb0 : rb1;
#pragma unroll
            for (int ww = 0; ww < 8; ++ww) sum += part[(ww * 16 + tk) * 48 + o];
            lgs[(ti * 16 + tk) * 40 + o] = sum; }
    }
#undef LNR_LOAD
    __syncthreads();
    for (int sl_ = tid; sl_ < ti * 16; sl_ += NWAVES * 64) {
        const LAS float* sl = lgs + sl_ * 40;
        int gi = 0; float gm = sl[0];
        for (int o = 1; o < 4; ++o) if (sl[o] > gm) { gm = sl[o]; gi = o; }
        float gs = 0.f; for (int o = 0; o < 4; ++o) gs += __expf(sl[o] - gm);
        const float gprob = 1.f / gs;
        const LAS float* el = sl + 4 + gi * 8;
        int i0 = 0; float l0 = el[0];
        for (int o = 1; o < 8; ++o) if (el[o] > l0) { l0 = el[o]; i0 = o; }
        int i1 = -1; float l1 = -3.0e38f;
        for (int o = 0; o < 8; ++o) if (o != i0 && el[o] > l1) { l1 = el[o]; i1 = o; }
        const float e1 = __expf(l1 - l0), w0 = gprob / (1.f + e1), w1 = gprob * e1 / (1.f + e1);
        const int ex0 = gi * 8 + i0, ex1 = gi * 8 + i1;
        const int r0 = (int)__hip_atomic_fetch_add(lcnt + ex0, 1u, __ATOMIC_RELAXED, __HIP_MEMORY_SCOPE_WORKGROUP), r1 = (int)__hip_atomic_fetch_add(lcnt + ex1, 1u, __ATOMIC_RELAXED, __HIP_MEMORY_SCOPE_WORKGROUP);
        rtab[sl_ * 4 + 0] = (ex0 << 16) | r0; rtab[sl_ * 4 + 1] = (ex1 << 16) | r1; ((LAS float*)rtab)[sl_ * 4 + 2] = w0; ((LAS float*)rtab)[sl_ * 4 + 3] = w1;
    }
    __syncthreads();
    if (tid < 32) { const unsigned n = lcnt[tid]; lcnt[tid] = n ? (unsigned)atomicAdd(&cnt[tid * 64], (int)n) : 0u; }
    __syncthreads();
    for (int sl_ = tid; sl_ < ti * 16; sl_ += NWAVES * 64) {
        const int tok = 16 * (F.vcu + (sl_ >> 4) * F.G) + (sl_ & 15);
        const int a0 = rtab[sl_ * 4 + 0], a1 = rtab[sl_ * 4 + 1]; const float w0 = ((LAS float*)rtab)[sl_ * 4 + 2], w1 = ((LAS float*)rtab)[sl_ * 4 + 3];
        const int ex0 = a0 >> 16, ex1 = a1 >> 16, r0 = (a0 & 0xffff) + (int)lcnt[ex0], r1 = (a1 & 0xffff) + (int)lcnt[ex1];
        list[ex0 * NTOK + r0] = tok * 2; listw[ex0 * NTOK + r0] = w0;
        list[ex1 * NTOK + r1] = tok * 2 + 1; listw[ex1 * NTOK + r1] = w1;
    }
}

__device__ __forceinline__ void phase_final(Frame& F, const MArgs& a, const bf16_t* x1b, const bf16_t* po) {
    const float* g2 = a.in[18]; const float* b2 = a.in[19];
    const int gw = F.vcu * NWAVES + F.wave, NGW = F.G * NWAVES, lane = lane_id();
    f32x4 gg2[4], bb2[4];
#pragma unroll
    for (int j = 0; j < 4; ++j) { gg2[j] = *(const f32x4*)(g2 + lane * 4 + 256 * j); bb2[j] = *(const f32x4*)(b2 + lane * 4 + 256 * j); }
    pg8::u32x2 xn[2][4], pan[2][4], pbn[2][4];
#define FIN_LOAD(base_) do { _Pragma("unroll") for (int u = 0; u < 2; ++u) { const int tk = (base_) + u; \
        _Pragma("unroll") for (int j = 0; j < 4; ++j) { const int k0 = lane * 4 + 256 * j; xn[u][j] = *(const pg8::u32x2*)(x1b + (size_t)tk * DM + k0); \
            pan[u][j] = *(const pg8::u32x2*)(po + (size_t)tk * 2 * DM + k0); pbn[u][j] = *(const pg8::u32x2*)(po + (size_t)tk * 2 * DM + DM + k0); } } } while (0)
    FIN_LOAD(gw * 2);
    for (int base = gw * 2; base < NTOK; base += NGW * 2) {
        f32x4 v[2][4]; float s[2] = {0.f, 0.f};
#pragma unroll
        for (int u = 0; u < 2; ++u)
#pragma unroll
            for (int j = 0; j < 4; ++j) { f32x4 t;
                t[0] = ALPHA * pg8::bflo(xn[u][j].x) + (pg8::bflo(pan[u][j].x) + pg8::bflo(pbn[u][j].x)); t[1] = ALPHA * pg8::bfhi(xn[u][j].x) + (pg8::bfhi(pan[u][j].x) + pg8::bfhi(pbn[u][j].x));
                t[2] = ALPHA * pg8::bflo(xn[u][j].y) + (pg8::bflo(pan[u][j].y) + pg8::bflo(pbn[u][j].y)); t[3] = ALPHA * pg8::bfhi(xn[u][j].y) + (pg8::bfhi(pan[u][j].y) + pg8::bfhi(pbn[u][j].y));
                v[u][j] = t; s[u] += (t[0] + t[1]) + (t[2] + t[3]); }
        if (base + NGW * 2 < NTOK) FIN_LOAD(base + NGW * 2);
#pragma unroll
        for (int u = 0; u < 2; ++u) {
            const float mean = wave_sum(s[u]) * (1.f / DM); float s2 = 0.f;
#pragma unroll
            for (int j = 0; j < 4; ++j) { v[u][j] = v[u][j] - mean; s2 += (v[u][j][0] * v[u][j][0] + v[u][j][1] * v[u][j][1]) + (v[u][j][2] * v[u][j][2] + v[u][j][3] * v[u][j][3]); }
            const float rstd = 1.f / sqrtf(wave_sum(s2) * (1.f / DM) + LN_EPS);
            float* row = a.out + (size_t)(base + u) * DM;
#pragma unroll
            for (int j = 0; j < 4; ++j) { const int k0 = lane * 4 + 256 * j; *(f32x4*)(row + k0) = v[u][j] * rstd * gg2[j] + bb2[j]; }
        }
    }
#undef FIN_LOAD
}


struct PreWait { XcdBarrier b; bool on; __device__ __forceinline__ void operator()() const { if (on) xcd_wait(b); } };
__global__ void __launch_bounds__(NWAVES * 64, 2) mega(MArgs args) {
    extern __shared__ __attribute__((aligned(16))) unsigned char lds[];
    Frame F;
    F.lds = (LAS unsigned char*)lds;
    F.wave = __builtin_amdgcn_readfirstlane((int)(threadIdx.x >> 6));
    F.G = gridDim.x; { const int bx = blockIdx.x; F.vcu = (F.G % 8 == 0) ? (bx % 8) * (F.G / 8) + bx / 8 : bx; }
    unsigned char* ws = args.ws;
    gu32* ctl = (gu32*)(ws + WS_CTL);
    { int tid0 = (F.wave * 64 + lane_id()); asm volatile("" : "+v"(tid0)); for (int u = tid0; u < (LDS_BYTES - LDSCTL_OFF) / 4; u += NWAVES * 64) ((LAS unsigned*)(F.lds + LDSCTL_OFF))[u] = 0u; }
    __syncthreads();
    const int lo = args.ph_lo, hi = args.ph_hi;
    const bool multi = (hi - lo) > 1;
    XcdBarrier bar; bar.bar = (unsigned*)(ctl + CW_BAR); bar.x = 0; bar.st = nullptr; bar.w = (unsigned)F.wave;
    if (multi) bar = xcd_barrier_post((unsigned*)(ctl + CW_BAR), (volatile LAS unsigned*)(F.lds + MISC_OFF) + 8, (unsigned)F.wave);
    bf16_t* PROJ = (bf16_t*)(ws + WS_PROJ); bf16_t* MIXED = (bf16_t*)(ws + WS_MIXED); bf16_t* X1B = (bf16_t*)(ws + WS_X1B); bf16_t* XB = (bf16_t*)(ws + WS_XB);
    bf16_t* HID = (bf16_t*)(ws + WS_HID); bf16_t* PO = (bf16_t*)(ws + WS_PO); bf16_t* Y = (bf16_t*)(ws + WS_Z);
    bf16_t* AO = (bf16_t*)((unsigned char*)args.out + DO_AO); bf16_t* DIFF = (bf16_t*)((unsigned char*)args.out + DO_DIFF);
    bf16_t* AOG = (bf16_t*)((unsigned char*)args.out + DO_AOG); float* LSE = (float*)((unsigned char*)args.out + DO_LSE);
    int* cnt = (int*)(ws + WS_CTL) + CW_CNT; int* list = (int*)(ws + WS_LIST); float* listw = (float*)(ws + WS_LISTW);
#define PHASE_0 p0_prologue(F, args);
#define PHASE_1 { pg8::Gemm g{XB, (const bf16_t*)(ws + WT_WIN), DM, F.wave}; pg8::StaticOrder S; S.init(NTOK, GA_OFF, F.G, (int)blockIdx.x);     \
        pg8::EpiProj E{PROJ, args.in[2], QSCALE}; pg8::gemm_phase<pg8::EpiProj, pg8::StaticOrder, true>(F.lds + RING_OFF, g, S, E); \
        if (multi) xcd_arrive(bar);                                     \
          \
        { const int bx = (int)blockIdx.x; if (F.G == 256) { if (bx >= 128) tr_run(F, args, TR_DENSE + ((bx - 128) * NWAVES + F.wave), 1024, TR_DENSE + 10240); \
              else tr_run(F, args, TR_DENSE + 10240 + (bx * NWAVES + F.wave), 1024, TR_DENSE + TR_EXP); } \
          else tr_run(F, args, TR_DENSE + F.vcu * NWAVES + F.wave, F.G * NWAVES, TR_DENSE + TR_EXP); } \
        if (multi) xcd_wait(bar); }
#define PHASE_2 { phase_attn(F, args, PROJ, AOG, LSE); if (multi) xcd_arrive(bar); }
#define PHASE_3 { phase_pool(F, PROJ, DIFF); if (multi) xcd_wait(bar); phase_combine(F, AOG, LSE, AO); if (multi) xcd_arrive(bar); }
#define PHASE_4 { pg8::GemmGM g{XB, (const bf16_t*)(ws + WT_WIN), AO, (const bf16_t*)(ws + WT_WPA), DIFF, (const bf16_t*)(ws + WT_WEFF), args.in[2], MIXED, F.wave}; \
        pg8::StaticOrder S; S.init(NTOK, 2 * DM, F.G, (int)blockIdx.x);     \
        PreWait pre{bar, multi}; pg8::gemm_phase_gm<pg8::StaticOrder>(F.lds + RING_OFF, g, S, pre); }
#define PHASE_5 { }
#define PHASE_6 { pg8::Gemm g{MIXED, (const bf16_t*)(ws + WT_WOUT), DM, F.wave}; pg8::StaticOrder S; S.init(NTOK, DM, F.G, (int)blockIdx.x); \
        pg8::EpiY E{Y}; pg8::gemm_phase<pg8::EpiY, pg8::StaticOrder, true>(F.lds + RING_OFF, g, S, E); }
#define PHASE_7 phase_ln_router(F, args, Y, X1B, cnt, list, listw);
#define PHASE_8 { const int ntiles = moe_tables(F, cnt); { pg8::Gemm g{X1B, (const bf16_t*)(ws + WT_WGU), DM, F.wave}; \
        pg8::MoeOrder S{(const LAS int*)(F.lds + TILE_E_OFF), (const LAS int*)(F.lds + FIRST_OFF), cnt, list, 2, F.G, F.vcu, ntiles, true, (unsigned*)(ctl + CW_READY)}; \
        pg8::EpiMoe1 E{HID, cnt, listw}; pg8::gemm_phase<pg8::EpiMoe1, pg8::MoeOrder, true>(F.lds + RING_OFF, g, S, E); } \
          \
        { pg8::Gemm g{HID, (const bf16_t*)(ws + WT_WD), DEXP, F.wave}; \
        pg8::DynMoeOrder S{(const LAS int*)(F.lds + TILE_E_OFF), (const LAS int*)(F.lds + FIRST_OFF), 4, ntiles, (unsigned*)(ctl + CW_Q9), (const unsigned*)(ctl + CW_READY), 16u, (unsigned*)(ctl + CW_TMO), (volatile LAS int*)(F.lds + MISC_OFF + 64), F.wave}; \
        pg8::EpiMoe2 E{PO, cnt, list}; pg8::gemm_phase<pg8::EpiMoe2, pg8::DynMoeOrder, true>(F.lds + RING_OFF, g, S, E); } }
#define PHASE_9 { }
#define PHASE_10 phase_final(F, args, X1B, PO);
#define IN(k) (lo <= (k) && (k) < hi)
#define SEAM(k) do { if (IN(k) && (k) + 1 < hi) xcd_barrier(bar); } while (0)
#define RUN(k, BODY) do { if (IN(k)) { BODY SEAM(k); } } while (0)
    RUN(0, PHASE_0);
    if (IN(1)) PHASE_1
    if (IN(2)) PHASE_2
    if (IN(3)) PHASE_3
    RUN(4, PHASE_4);
    RUN(6, PHASE_6);
    RUN(7, PHASE_7);
    RUN(8, PHASE_8);
    RUN(10, PHASE_10);
#undef IN
#undef SEAM
#undef RUN
}

#ifndef SINGLE_LAUNCH
#define SINGLE_LAUNCH 1
#endif
constexpr int NPHASES = 11;
#ifndef DUP_MASK
#define DUP_MASK 0
#endif
extern "C" void kernel_launch(void* const* d_in, const int* in_sizes, int n_in, void* d_out, int out_size, void* d_ws, size_t ws_size, hipStream_t stream) {
    static int grid = 0;
    if (grid == 0) {
        if (n_in != 20 || in_sizes[0] != NTOK * DM || out_size != NTOK * DM || ws_size < WS_END) {
            fprintf(stderr, "kernel_launch: unexpected shapes (n_in %d, in0 %d, out %d, ws %zu)\n", n_in, n_in > 0 ? in_sizes[0] : -1, out_size, ws_size); grid = -1; return; }
        int dev = 0, cus = 0, per_cu = 0;
        if (hipGetDevice(&dev) != hipSuccess || hipDeviceGetAttribute(&cus, hipDeviceAttributeMultiprocessorCount, dev) != hipSuccess) { grid = -1; return; }
        if (hipFuncSetAttribute((const void*)mega, hipFuncAttributeMaxDynamicSharedMemorySize, LDS_BYTES) != hipSuccess) { fprintf(stderr, "kernel_launch: hipFuncSetAttribute failed\n"); grid = -1; return; }
        if (hipOccupancyMaxActiveBlocksPerMultiprocessor(&per_cu, (const void*)mega, NWAVES * 64, LDS_BYTES) != hipSuccess || per_cu < 1) {
            fprintf(stderr, "kernel_launch: occupancy query reports %d workgroups per CU\n", per_cu); (void)hipGetLastError(); grid = -1; return; }
        if (cus != 256) { fprintf(stderr, "kernel_launch: built for a 256-CU device (LDS tables of the LN/router phase are sized for 8 token tiles per workgroup); found %d CUs\n", cus); grid = -1; return; }
        grid = cus;
    }
    if (grid < 0) return;
    (void)hipMemsetAsync((unsigned char*)d_ws + WS_CTL, 0, CTL_ZERO_BYTES, stream);
    MArgs a{};
    for (int i = 0; i < 20; ++i) a.in[i] = (const float*)d_in[i];
    a.out = (float*)d_out; a.ws = (unsigned char*)d_ws;
    if (SINGLE_LAUNCH) { a.ph_lo = 0; a.ph_hi = NPHASES; hipLaunchKernelGGL(mega, dim3(grid), dim3(NWAVES * 64), LDS_BYTES, stream, a); return; }
    for (int p = 0; p < NPHASES; ++p) { a.ph_lo = p; a.ph_hi = p + 1;
        for (int rep = 0; rep < 1 + ((DUP_MASK >> p) & 1); ++rep) { if (rep && p == 7) (void)hipMemsetAsync((unsigned char*)d_ws + WS_CTL, 0, 8192, stream); hipLaunchKernelGGL(mega, dim3(grid), dim3(NWAVES * 64), LDS_BYTES, stream, a); } }
}
```

```cpp
#define SINGLE_LAUNCH 1
#include <hip/hip_runtime.h>
#include <cstdint>
#include <cstdio>

typedef unsigned short bf16_t;
typedef short bf16x8 __attribute__((ext_vector_type(8)));
typedef float f32x4 __attribute__((ext_vector_type(4)));

constexpr int BATCH = 16, SEQ = 2048, DM = 1024, NTOK = BATCH * SEQ;
constexpr int HD = 64, ATTW = 768, AOW = 256, POOLW = 512, INW = 4864;
constexpr int Q_OFF = 0, K_OFF = 768, V_OFF = 1536, POOL_OFF = 2304, GA_OFF = 2816, GB_OFF = 3840;
constexpr int NEXP = 32, DEXP = 256, NGRP = 4, EPG = 8;
constexpr float LN_EPS = 1e-5f;
constexpr float ALPHA = 1.189207115002721f;
constexpr int MAXROWS = 65536 + NEXP * 256;

constexpr size_t MiB = 1u << 20;
constexpr size_t WS_PROJ = 0;
constexpr size_t WS_PO = 0;
constexpr size_t WS_HID = 130 * MiB;
constexpr size_t WS_Z = 166 * MiB;
constexpr size_t WS_MIXED = 304 * MiB;
constexpr size_t WS_X1B = 368 * MiB;
constexpr size_t WS_WT = 432 * MiB;
constexpr size_t WS_CTL = 500 * MiB;
constexpr size_t WS_LIST = 501 * MiB;
constexpr size_t WS_LISTW = 505 * MiB;
constexpr size_t WS_TINFO = 509 * MiB;
constexpr size_t WS_END = 512 * MiB;
constexpr size_t DO_AO = 0, DO_DIFF = 16 * MiB, DO_AOG = 48 * MiB, DO_LSE = 96 * MiB;

__device__ __forceinline__ int lane_id() { int l; asm volatile("v_mbcnt_lo_u32_b32 %0, -1, 0\n\tv_mbcnt_hi_u32_b32 %0, -1, %0" : "=v"(l)); return l; }
__device__ __forceinline__ bf16_t f2bf(float f) { unsigned u = __float_as_uint(f); return (bf16_t)((u + 0x7fffu + ((u >> 16) & 1u)) >> 16); }
__device__ __forceinline__ float bf2f(bf16_t h) { return __uint_as_float(((unsigned)h) << 16); }
__device__ __forceinline__ bf16_t cvt_in(float v) { return f2bf(v); }
__device__ __forceinline__ bf16_t cvt_in(bf16_t v) { return v; }
__device__ __forceinline__ float sigmoidf_(float v) { return 1.f / (1.f + __expf(-v)); }
#define DPP_ADD(v, CTRL) ((v) + __builtin_bit_cast(float, __builtin_amdgcn_update_dpp(0, __builtin_bit_cast(int, (v)), (CTRL), 0xf, 0xf, true)))
__device__ __forceinline__ float wave_sum(float v) {
    v = DPP_ADD(v, 0xB1);
    v = DPP_ADD(v, 0x4E);
    v = DPP_ADD(v, 0x141);
    v = DPP_ADD(v, 0x140);
    const int iv = __builtin_bit_cast(int, v);
    return (__builtin_bit_cast(float, __builtin_amdgcn_readlane(iv, 0)) + __builtin_bit_cast(float, __builtin_amdgcn_readlane(iv, 16)))
         + (__builtin_bit_cast(float, __builtin_amdgcn_readlane(iv, 32)) + __builtin_bit_cast(float, __builtin_amdgcn_readlane(iv, 48)));
}
__device__ __forceinline__ float wave_max(float v) {
#pragma unroll
    for (int o = 1; o < 64; o <<= 1) v = fmaxf(v, __shfl_xor(v, o));
    return v;
}

__device__ __forceinline__ int t5_bucket(int dist) {
    if (dist < 16) return dist;
    const float d = (float)dist;
    int large = 16 + (int)(logf(d / 16.0f) / logf(128.0f) * 16.0f);
    return large < 31 ? large : 31;
}


namespace pg8 {
#define PG8_LAS __attribute__((address_space(3)))
typedef unsigned u32x4 __attribute__((ext_vector_type(4)));
typedef unsigned u32x2 __attribute__((ext_vector_type(2)));
constexpr int BM = 256, BK = 64, HALF = 128, HTB = HALF * BK * 2  , STAGE_BYTES = 8 * HTB, NXCD = 8, WGM = 8;

__host__ __device__ __forceinline__ int lds_byte(int r, int c) { const int st = (r >> 4) * 2 + (c >> 5), rr = r & 15, cc = c & 31, ob = rr * 64 + cc * 2; return st * 1024 + (ob ^ (((ob >> 9) & 1) << 5)); }
__host__ __device__ __forceinline__ void stage_rc(int b, int& R, int& C) { const int st = b / 1024, sb = b % 1024, swz = sb ^ (((sb >> 9) & 1) << 5); R = (st >> 1) * 16 + swz / 64; C = (st & 1) * 32 + (swz % 64) / 2; }
__host__ __device__ __forceinline__ int perm32(int rho) { const int n = rho >> 4, i = rho & 15; return 8 * (i >> 2) + 4 * n + (i & 3); }

struct Unit { int pm, pn, e, rt; };
struct Gemm { const bf16_t* A; const bf16_t* Bt; int K; int wave; };

struct StaticOrder {
    int nM, nN, nwg, G, c;
    __device__ void init(int M, int N, int G_, int c_) { nM = M / BM; nN = N / BM; nwg = nM * nN; G = G_; c = c_; }
    __device__ bool next(int i, Unit& u) const {
        const long L = (long)i * G + c; if (L >= nwg) return false;
        int wgid = (int)L; { const int q = nwg / NXCD, r = nwg % NXCD, xcd = wgid % NXCD, off = wgid / NXCD; wgid = (xcd < r ? xcd * (q + 1) : r * (q + 1) + (xcd - r) * q) + off; }
        const int nig = WGM * nN, gid = wgid / nig, fm = gid * WGM, gsz = (nM - fm) < WGM ? (nM - fm) : WGM;
        u.pm = fm + ((wgid % nig) % gsz); u.pn = (wgid % nig) / gsz; u.e = 0; u.rt = 0; return true;
    }
    __device__ __forceinline__ int arow(const Unit& u, int r) const { return u.pm * BM + r; }
    __device__ __forceinline__ void done(const Unit&) const {}
};

struct MoeOrder {
    const PG8_LAS int* tile_e; const PG8_LAS int* first; const int* cnt; const int* list; int nN, G, c, ntiles; bool gather; unsigned* ready;
    __device__ bool next(int i, Unit& u) const {
        const int L = i * G + c; if (L >= ntiles * nN) return false;
        const int rt = L / nN, pn = L - rt * nN, e = tile_e[rt];
        u.pm = rt; u.pn = e * nN + pn; u.e = e; u.rt = rt - first[e]; return true;
    }
    __device__ __forceinline__ int arow(const Unit& u, int r) const {
        if (!gather) return u.pm * BM + r;
        const int idx = u.rt * BM + r; return idx < cnt[u.e * 64] ? (list[u.e * NTOK + idx] >> 1) : 0;
    }
    __device__ __forceinline__ void done(const Unit& u) const {
        asm volatile("s_waitcnt vmcnt(0)" ::: "memory");
        if (lane_id() == 0) __hip_atomic_fetch_add(ready + 64 * u.pm, 1u, __ATOMIC_RELAXED, __HIP_MEMORY_SCOPE_AGENT);
    }
};
struct DynMoeOrder {
    const PG8_LAS int* tile_e; const PG8_LAS int* first; int nN, ntiles; unsigned* queue; const unsigned* ready; unsigned need; unsigned* tmo; volatile PG8_LAS int* slot; int wave;
    __device__ bool next(int i, Unit& u) const {
        if (wave == 0) {
            int L = 0; if (lane_id() == 0) L = (int)__hip_atomic_fetch_add(queue, 1u, __ATOMIC_RELAXED, __HIP_MEMORY_SCOPE_AGENT);
            L = __builtin_amdgcn_readfirstlane(L);
            if (L < ntiles * nN) {
                const int rt = L / nN; unsigned spins = 0;
                while ((unsigned)__builtin_amdgcn_readfirstlane(__hip_atomic_load(ready + 64 * rt, __ATOMIC_RELAXED, __HIP_MEMORY_SCOPE_AGENT)) < need) {
                    __builtin_amdgcn_s_sleep(2);
                    if (++spins > (1u << 20)) { if (lane_id() == 0) __hip_atomic_store(tmo, 1u, __ATOMIC_RELAXED, __HIP_MEMORY_SCOPE_AGENT); break; } }
                __builtin_amdgcn_fence(__ATOMIC_ACQUIRE, "agent");
                asm volatile("s_waitcnt vmcnt(0)" ::: "memory");
            } else L = -1;
            if (lane_id() == 0) slot[i & 1] = L;
            asm volatile("s_waitcnt lgkmcnt(0)" ::: "memory");
        }
        __builtin_amdgcn_s_barrier(); asm volatile("" ::: "memory");
        const int L = slot[i & 1]; if (L < 0) return false;
        const int rt = L / nN, pn = L - rt * nN, e = tile_e[rt];
        u.pm = rt; u.pn = e * nN + pn; u.e = e; u.rt = rt - first[e]; return true;
    }
    __device__ __forceinline__ int arow(const Unit& u, int r) const { return u.pm * BM + r; }
    __device__ __forceinline__ void done(const Unit&) const {}
};

__device__ __forceinline__ unsigned cvt_pk_bf16(float lo, float hi) { unsigned r; asm volatile("v_cvt_pk_bf16_f32 %0, %1, %2" : "=v"(r) : "v"(lo), "v"(hi)); return r; }
__device__ __forceinline__ float bflo(unsigned w) { return __uint_as_float(w << 16); }
__device__ __forceinline__ float bfhi(unsigned w) { return __uint_as_float(w & 0xffff0000u); }
__device__ __forceinline__ float fsig(float v) { return __builtin_amdgcn_rcpf(1.f + __builtin_amdgcn_exp2f(-1.4426950408889634f * v)); }
__device__ __forceinline__ float fsig_gate(float v) { return fmaxf(fsig(v), 1.0e-7f); }

struct EpiProj {
    static constexpr bool PERM = true;
    bf16_t* O; const float* bias; float qscale;
    __device__ __forceinline__ void operator()(const f32x4 (&acc)[2][2][4][2], const Unit& u, int wr, int wc, int fr, int fq) const {
        const int row0 = u.pm * BM + wr * 64 + fr, lc0 = wc * 32 + 8 * fq;
        const bool gate = u.pn >= 11;
        const int lg = (u.pn < 9) ? 2 * (u.pn % 3) : 0;
        const int cb0 = gate ? GA_OFF + (u.pn - 11) * HALF + lc0 : u.pn * BM + lc0, cb1 = gate ? GB_OFF + (u.pn - 11) * HALF + lc0 : u.pn * BM + HALF + lc0;
        f32x4 bv[2][2];
#pragma unroll
        for (int n = 0; n < 2; ++n) { bv[0][n] = *(const f32x4*)(bias + cb0 + 4 * n); bv[1][n] = *(const f32x4*)(bias + cb1 + 4 * n); }
#pragma unroll
        for (int ai = 0; ai < 2; ++ai)
#pragma unroll
            for (int m = 0; m < 4; ++m) { const int rg = row0 + ai * HALF + m * 16, t = rg & (SEQ - 1), prow = (rg & ~(SEQ - 1)) + ((t & ((1 << lg) - 1)) << (11 - lg)) + (t >> lg);
                bf16_t* rowp = O + (size_t)prow * INW;
                f32x4 a0 = acc[ai][0][m][0] + bv[0][0], a1 = acc[ai][0][m][1] + bv[0][1], b0 = acc[ai][1][m][0] + bv[1][0], b1 = acc[ai][1][m][1] + bv[1][1];
                if (u.pn < 3) { a0 = a0 * qscale; a1 = a1 * qscale; b0 = b0 * qscale; b1 = b1 * qscale; }
                if (gate) {
#pragma unroll
                    for (int i = 0; i < 4; ++i) { const float s0 = fsig_gate(b0[i]), s1 = fsig_gate(b1[i]); a0[i] = fsig(a0[i]) * __builtin_amdgcn_rcpf(s0); a1[i] = fsig(a1[i]) * __builtin_amdgcn_rcpf(s1); b0[i] = s0; b1[i] = s1; } }
                u32x4 w; w.x = cvt_pk_bf16(a0[0], a0[1]); w.y = cvt_pk_bf16(a0[2], a0[3]); w.z = cvt_pk_bf16(a1[0], a1[1]); w.w = cvt_pk_bf16(a1[2], a1[3]);
                *(u32x4*)(rowp + cb0) = w;
                w.x = cvt_pk_bf16(b0[0], b0[1]); w.y = cvt_pk_bf16(b0[2], b0[3]); w.z = cvt_pk_bf16(b1[0], b1[1]); w.w = cvt_pk_bf16(b1[2], b1[3]);
                *(u32x4*)(rowp + cb1) = w; }
    }
};
template <bool ACCUM> struct EpiGate {
    static constexpr bool PERM = true;
    bf16_t* O; const bf16_t* gate;
    __device__ __forceinline__ void operator()(const f32x4 (&acc)[2][2][4][2], const Unit& u, int wr, int wc, int fr, int fq) const {
        const int row0 = u.pm * BM + wr * 64 + fr, col0 = u.pn * BM + wc * 32 + 8 * fq;
#pragma unroll
        for (int ai = 0; ai < 2; ++ai)
#pragma unroll
            for (int m = 0; m < 4; ++m) { const size_t r = (size_t)(row0 + ai * HALF + m * 16);
#pragma unroll
                for (int bj = 0; bj < 2; ++bj) {
                    const u32x4 gw = *(const u32x4*)(gate + r * INW + col0 + bj * HALF);
                    bf16_t* op = O + r * DM + col0 + bj * HALF;
                    f32x4 v0 = acc[ai][bj][m][0], v1 = acc[ai][bj][m][1];
                    v0[0] *= bflo(gw.x); v0[1] *= bfhi(gw.x); v0[2] *= bflo(gw.y); v0[3] *= bfhi(gw.y);
                    v1[0] *= bflo(gw.z); v1[1] *= bfhi(gw.z); v1[2] *= bflo(gw.w); v1[3] *= bfhi(gw.w);
                    if (ACCUM) { const u32x4 ow = *(const u32x4*)op;
                        v0[0] += bflo(ow.x); v0[1] += bfhi(ow.x); v0[2] += bflo(ow.y); v0[3] += bfhi(ow.y);
                        v1[0] += bflo(ow.z); v1[1] += bfhi(ow.z); v1[2] += bflo(ow.w); v1[3] += bfhi(ow.w); }
                    u32x4 w; w.x = cvt_pk_bf16(v0[0], v0[1]); w.y = cvt_pk_bf16(v0[2], v0[3]); w.z = cvt_pk_bf16(v1[0], v1[1]); w.w = cvt_pk_bf16(v1[2], v1[3]);
                    *(u32x4*)op = w; } }
    }
};
struct EpiMix {
    static constexpr bool PERM = true;
    bf16_t* O; const bf16_t* ga; const bf16_t* gb;
    __device__ __forceinline__ void mid(f32x4 (&acc)[2][2][4][2], const Unit& u, int wr, int wc, int fr, int fq) const {
        int row0 = u.pm * BM + wr * 64 + fr, col0 = u.pn * BM + wc * 32 + 8 * fq;
        asm volatile("" : "+v"(row0), "+v"(col0));
#pragma unroll
        for (int ai = 0; ai < 2; ++ai)
#pragma unroll
            for (int m = 0; m < 4; ++m) { const size_t r = (size_t)(row0 + ai * HALF + m * 16);
#pragma unroll
                for (int bj = 0; bj < 2; ++bj) {
                    const u32x4 a = *(const u32x4*)(ga + r * INW + col0 + bj * HALF);
                    f32x4& v0 = acc[ai][bj][m][0]; f32x4& v1 = acc[ai][bj][m][1];
                    v0[0] *= bflo(a.x); v0[1] *= bfhi(a.x); v0[2] *= bflo(a.y); v0[3] *= bfhi(a.y);
                    v1[0] *= bflo(a.z); v1[1] *= bfhi(a.z); v1[2] *= bflo(a.w); v1[3] *= bfhi(a.w); }
                if (m == 3) asm volatile("" ::: "memory"); }
    }
    __device__ __forceinline__ void operator()(const f32x4 (&acc)[2][2][4][2], const Unit& u, int wr, int wc, int fr, int fq) const {
        const int row0 = u.pm * BM + wr * 64 + fr, col0 = u.pn * BM + wc * 32 + 8 * fq;
#pragma unroll
        for (int ai = 0; ai < 2; ++ai)
#pragma unroll
            for (int m = 0; m < 4; ++m) { const size_t r = (size_t)(row0 + ai * HALF + m * 16);
#pragma unroll
                for (int bj = 0; bj < 2; ++bj) {
                    const u32x4 b = *(const u32x4*)(gb + r * INW + col0 + bj * HALF);
                    const f32x4 v0 = acc[ai][bj][m][0], v1 = acc[ai][bj][m][1];
                    u32x4 w; w.x = cvt_pk_bf16(v0[0] * bflo(b.x), v0[1] * bfhi(b.x)); w.y = cvt_pk_bf16(v0[2] * bflo(b.y), v0[3] * bfhi(b.y));
                    w.z = cvt_pk_bf16(v1[0] * bflo(b.z), v1[1] * bfhi(b.z)); w.w = cvt_pk_bf16(v1[2] * bflo(b.w), v1[3] * bfhi(b.w));
                    *(u32x4*)(O + r * DM + col0 + bj * HALF) = w; }
                if (m == 3) asm volatile("" ::: "memory"); }
    }
};
struct EpiY {
    static constexpr bool PERM = true;
    bf16_t* Y;
    __device__ __forceinline__ void operator()(const f32x4 (&acc)[2][2][4][2], const Unit& u, int wr, int wc, int fr, int fq) const {
        const int col0 = u.pn * BM + wc * 32 + 8 * fq;
#pragma unroll
        for (int ai = 0; ai < 2; ++ai)
#pragma unroll
            for (int m = 0; m < 4; ++m) { bf16_t* rowp = Y + (size_t)(u.pm * BM + ai * HALF + wr * 64 + m * 16 + fr) * DM + col0;
#pragma unroll
                for (int bj = 0; bj < 2; ++bj) { const f32x4 v0 = acc[ai][bj][m][0], v1 = acc[ai][bj][m][1];
                    u32x4 w; w.x = cvt_pk_bf16(v0[0], v0[1]); w.y = cvt_pk_bf16(v0[2], v0[3]); w.z = cvt_pk_bf16(v1[0], v1[1]); w.w = cvt_pk_bf16(v1[2], v1[3]);
                    *(u32x4*)(rowp + bj * HALF) = w; } }
    }
};
struct EpiMoe1 {
    static constexpr bool PERM = true;
    bf16_t* hid; const int* cnt; const float* listw;
    __device__ __forceinline__ void operator()(const f32x4 (&acc)[2][2][4][2], const Unit& u, int wr, int wc, int fr, int fq) const {
        const int n_e = cnt[u.e * 64], pnl = u.pn & 1, hc0 = pnl * 128 + wc * 32 + 8 * fq;
        const __amdgpu_buffer_rsrc_t rs = __builtin_amdgcn_make_buffer_rsrc(hid, 0, MAXROWS * DEXP * 2, 0x00020000);
#pragma unroll
        for (int ai = 0; ai < 2; ++ai)
#pragma unroll
            for (int m = 0; m < 4; ++m) { const int r = ai * HALF + wr * 64 + m * 16 + fr, idx = u.rt * BM + r;
                const float w = idx < n_e ? listw[u.e * NTOK + idx] : 0.f;
                float h[8];
#pragma unroll
                for (int n = 0; n < 2; ++n)
#pragma unroll
                    for (int i = 0; i < 4; ++i) { const float g = acc[ai][0][m][n][i], uu = acc[ai][1][m][n][i]; h[n * 4 + i] = w * g * fsig(g) * uu; }
                u32x4 o; o.x = cvt_pk_bf16(h[0], h[1]); o.y = cvt_pk_bf16(h[2], h[3]); o.z = cvt_pk_bf16(h[4], h[5]); o.w = cvt_pk_bf16(h[6], h[7]);
                __builtin_amdgcn_raw_buffer_store_b128(o, rs, (unsigned)(((u.pm * BM + r) * DEXP + hc0) * 2), 0,   16); }
    }
};
struct EpiMoe2 {
    static constexpr bool PERM = true;
    bf16_t* po; const int* cnt; const int* list;
    __device__ __forceinline__ void operator()(const f32x4 (&acc)[2][2][4][2], const Unit& u, int wr, int wc, int fr, int fq) const {
        const int col0 = (u.pn & 3) * BM + wc * 32 + 8 * fq, n_e = cnt[u.e * 64];
#pragma unroll
        for (int ai = 0; ai < 2; ++ai)
#pragma unroll
            for (int m = 0; m < 4; ++m) { const int r = ai * HALF + wr * 64 + m * 16 + fr, idx = u.rt * BM + r;
                const int drow = idx < n_e ? list[u.e * NTOK + idx] : 2 * NTOK + r;
                bf16_t* rowp = po + (size_t)drow * DM + col0;
#pragma unroll
                for (int bj = 0; bj < 2; ++bj) { const f32x4 v0 = acc[ai][bj][m][0], v1 = acc[ai][bj][m][1];
                    u32x4 w; w.x = cvt_pk_bf16(v0[0], v0[1]); w.y = cvt_pk_bf16(v0[2], v0[3]); w.z = cvt_pk_bf16(v1[0], v1[1]); w.w = cvt_pk_bf16(v1[2], v1[3]);
                    *(u32x4*)(rowp + bj * HALF) = w; } }
    }
};

template <class Epi, class Sched, bool ALIGN_EPI>
__device__ __forceinline__ void gemm_phase(PG8_LAS unsigned char* lds, const Gemm g, const Sched& S, const Epi& E) {
    const int wid = g.wave, lane = lane_id(), tid = wid * 64 + lane, wr = wid >> 2, wc = wid & 3, fr = lane & 15, fq = lane >> 4;
    const int K = g.K, nt = K / BK;
    int RA[2]; unsigned CA[2], voffB[2];
#pragma unroll
    for (int i = 0; i < 2; ++i) { int R, C; stage_rc(tid * 16 + i * 8192, R, C); const int Rb = Epi::PERM ? ((R & ~31) + perm32(R & 31)) : R;
        RA[i] = R; CA[i] = (unsigned)C * 2u; voffB[i] = (unsigned)(Rb * K + C) * 2u; }
    const size_t kstep = (size_t)(BK * 2);
    const size_t hstep = (size_t)HALF * K * 2;
    const size_t tstep = 2 * hstep;
    const unsigned ldsw = (unsigned)wid * 1024u;
    const int aoff = lds_byte(wr * 64 + fr, fq * 8), boff = lds_byte(wc * 32 + fr, fq * 8);
#define PG8_SA(b, h) (((b) * 2 + (h)) * HTB)
#define PG8_SB(b, h) ((4 + (b) * 2 + (h)) * HTB)
#define PG8_STAGE(bufoff, gbase, voff) do { _Pragma("unroll") for (int _i = 0; _i < 2; ++_i) \
        __builtin_amdgcn_global_load_lds((const unsigned*)((const char*)(gbase) + (voff)[_i]), (PG8_LAS unsigned*)(lds + (bufoff) + ldsw + _i * 8192), 16, 0, 0); } while (0)
#define PG8_LDA(dst, b, h) do { _Pragma("unroll") for (int m = 0; m < 4; ++m) _Pragma("unroll") for (int k = 0; k < 2; ++k) dst[m][k] = *(const PG8_LAS bf16x8*)(lds + PG8_SA(b, h) + aoff + m * 2048 + k * 1024); } while (0)
#define PG8_LDB(dst, b, h) do { _Pragma("unroll") for (int n = 0; n < 2; ++n) _Pragma("unroll") for (int k = 0; k < 2; ++k) dst[n][k] = *(const PG8_LAS bf16x8*)(lds + PG8_SB(b, h) + boff + n * 2048 + k * 1024); } while (0)
#define PG8_MMA(ai, bj, At, Bt) do { __builtin_amdgcn_s_setprio(1); _Pragma("unroll") for (int m = 0; m < 4; ++m) _Pragma("unroll") for (int n = 0; n < 2; ++n) _Pragma("unroll") for (int k = 0; k < 2; ++k) \
        acc[ai][bj][m][n] = __builtin_amdgcn_mfma_f32_16x16x32_bf16(Bt[n][k], At[m][k], acc[ai][bj][m][n], 0, 0, 0); __builtin_amdgcn_s_setprio(0); } while (0)
#define PG8_WAIT_V(n) asm volatile("s_waitcnt vmcnt(" #n ")" ::: "memory")
#define PG8_WAIT_L(n) asm volatile("s_waitcnt lgkmcnt(" #n ")" ::: "memory")
#define PG8_BAR __builtin_amdgcn_s_barrier()
#define PG8_SCHED __builtin_amdgcn_sched_barrier(0)
#define PG8_AOFF(dst, U) do { _Pragma("unroll") for (int _h = 0; _h < 2; ++_h) _Pragma("unroll") for (int _i = 0; _i < 2; ++_i) \
        dst[_h][_i] = (unsigned)S.arow(U, _h * HALF + RA[_i]) * (unsigned)(K * 2) + CA[_i]; } while (0)
    Unit cur, nxt; int ui = 0;
    if (!S.next(0, cur)) return;
    f32x4 acc[2][2][4][2];
#pragma unroll
    for (int a = 0; a < 2; ++a)
#pragma unroll
        for (int b = 0; b < 2; ++b)
#pragma unroll
            for (int m = 0; m < 4; ++m)
#pragma unroll
                for (int n = 0; n < 2; ++n) acc[a][b][m][n] = (f32x4){0.f, 0.f, 0.f, 0.f};
    bf16x8 At[4][2], B0[2][2], B1[2][2];
    unsigned offC[2][2], offN[2][2];
    PG8_AOFF(offC, cur);
    const char* A0 = (const char*)g.A;
    const char* cB = (const char*)g.Bt + (size_t)cur.pn * tstep;
    PG8_STAGE(PG8_SB(0, 0), cB, voffB); PG8_STAGE(PG8_SB(0, 1), cB + hstep, voffB); PG8_STAGE(PG8_SA(0, 0), A0, offC[0]); PG8_STAGE(PG8_SA(0, 1), A0, offC[1]);
    if (wr == 1) PG8_BAR;
    PG8_WAIT_V(2); PG8_BAR;
    PG8_STAGE(PG8_SB(1, 0), cB + kstep, voffB); PG8_STAGE(PG8_SA(1, 0), A0 + kstep, offC[0]); PG8_STAGE(PG8_SB(1, 1), cB + hstep + kstep, voffB);
    PG8_WAIT_V(6); PG8_BAR;
    for (;;) {
        const bool has_next = S.next(ui + 1, nxt);
        if (has_next) PG8_AOFF(offN, nxt);
        const char* nB = has_next ? (const char*)g.Bt + (size_t)nxt.pn * tstep : cB;
#pragma unroll 1
        for (int t = 0; t < nt; t += 2) {
            const bool last = (t == nt - 2);
            const char* a1 = A0 + (size_t)(t + 1) * kstep;
            const char* a2 = last ? A0 : A0 + (size_t)(t + 2) * kstep; const char* b2 = last ? nB : cB + (size_t)(t + 2) * kstep;
            const char* a3 = a2 + kstep; const char* b3 = b2 + kstep;
            PG8_LDB(B0, 0, 0); PG8_LDB(B1, 0, 1); PG8_SCHED; PG8_LDA(At, 0, 0); PG8_STAGE(PG8_SA(1, 1), a1, offC[1]);
            if (last && has_next) {
#pragma unroll
                for (int _h = 0; _h < 2; ++_h)
#pragma unroll
                    for (int _i = 0; _i < 2; ++_i) offC[_h][_i] = offN[_h][_i];
            }
            PG8_WAIT_V(8); PG8_WAIT_L(0); PG8_BAR; PG8_MMA(0, 0, At, B0); PG8_MMA(0, 1, At, B1); PG8_BAR; PG8_SCHED;
            PG8_LDA(At, 0, 1); PG8_STAGE(PG8_SB(0, 0), b2, voffB); PG8_STAGE(PG8_SB(0, 1), b2 + hstep, voffB); PG8_STAGE(PG8_SA(0, 0), a2, offC[0]);
            PG8_WAIT_V(8); PG8_WAIT_L(0); PG8_BAR; PG8_MMA(1, 0, At, B0); PG8_MMA(1, 1, At, B1); PG8_BAR; PG8_SCHED;
            PG8_LDB(B0, 1, 0); PG8_LDB(B1, 1, 1); PG8_SCHED; PG8_LDA(At, 1, 0); PG8_STAGE(PG8_SA(0, 1), a2, offC[1]);
            PG8_WAIT_V(8); PG8_WAIT_L(0); PG8_BAR; PG8_MMA(0, 0, At, B0); PG8_MMA(0, 1, At, B1); PG8_BAR; PG8_SCHED;
            PG8_LDA(At, 1, 1); PG8_STAGE(PG8_SB(1, 0), b3, voffB); PG8_STAGE(PG8_SB(1, 1), b3 + hstep, voffB); PG8_STAGE(PG8_SA(1, 0), a3, offC[0]);
            PG8_WAIT_V(8); PG8_WAIT_L(0); PG8_BAR; PG8_MMA(1, 0, At, B0); PG8_MMA(1, 1, At, B1); PG8_BAR; PG8_SCHED;
        }
        if constexpr (ALIGN_EPI) { if (wr == 0) PG8_BAR; }
        E(acc, cur, wr, wc, fr, fq); S.done(cur);
        if (!has_next) break;
#pragma unroll
        for (int a = 0; a < 2; ++a)
#pragma unroll
            for (int b = 0; b < 2; ++b)
#pragma unroll
                for (int m = 0; m < 4; ++m)
#pragma unroll
                    for (int n = 0; n < 2; ++n) acc[a][b][m][n] = (f32x4){0.f, 0.f, 0.f, 0.f};
        cur = nxt; cB = nB; ++ui;
        if constexpr (ALIGN_EPI) { if (wr == 1) PG8_BAR; }
    }
    PG8_WAIT_V(0);
    if constexpr (!ALIGN_EPI) { if (wr == 0) PG8_BAR; }
    PG8_BAR;
#undef PG8_SA
#undef PG8_SB
#undef PG8_STAGE
#undef PG8_LDA
#undef PG8_LDB
#undef PG8_MMA
#undef PG8_WAIT_V
#undef PG8_WAIT_L
#undef PG8_BAR
#undef PG8_SCHED
#undef PG8_AOFF
}

struct Gemm2 { const bf16_t* A0; const bf16_t* B0; int K0; const bf16_t* A1; const bf16_t* B1; int K1; int wave; };
template <class Epi, class Sched, bool ALIGN_EPI>
__device__ __forceinline__ void gemm_phase2(PG8_LAS unsigned char* lds, const Gemm2 g, const Sched& S, const Epi& E) {
    const int wid = g.wave, lane = lane_id(), tid = wid * 64 + lane, wr = wid >> 2, wc = wid & 3, fr = lane & 15, fq = lane >> 4;
    const int nt0 = g.K0 / BK, nt = nt0 + g.K1 / BK;
    unsigned RA2[2], RB2[2], C2[2];
#pragma unroll
    for (int i = 0; i < 2; ++i) { int R, C; stage_rc(tid * 16 + i * 8192, R, C); const int Rb = Epi::PERM ? ((R & ~31) + perm32(R & 31)) : R;
        RA2[i] = (unsigned)R * 2u; RB2[i] = (unsigned)Rb * 2u; C2[i] = (unsigned)C * 2u; }
    const size_t kstep = (size_t)(BK * 2);
    const unsigned ldsw = (unsigned)wid * 1024u;
    const int aoff = lds_byte(wr * 64 + fr, fq * 8), boff = lds_byte(wc * 32 + fr, fq * 8);
#define PG8_SA(b, h) (((b) * 2 + (h)) * HTB)
#define PG8_SB(b, h) ((4 + (b) * 2 + (h)) * HTB)
#define PG8_STAGE(bufoff, gbase, R2, Kb) do { _Pragma("unroll") for (int _i = 0; _i < 2; ++_i) \
        __builtin_amdgcn_global_load_lds((const unsigned*)((const char*)(gbase) + ((R2)[_i] * (unsigned)(Kb) + C2[_i])), (PG8_LAS unsigned*)(lds + (bufoff) + ldsw + _i * 8192), 16, 0, 0); } while (0)
#define PG8_LDA(dst, b, h) do { _Pragma("unroll") for (int m = 0; m < 4; ++m) _Pragma("unroll") for (int k = 0; k < 2; ++k) dst[m][k] = *(const PG8_LAS bf16x8*)(lds + PG8_SA(b, h) + aoff + m * 2048 + k * 1024); } while (0)
#define PG8_LDB(dst, b, h) do { _Pragma("unroll") for (int n = 0; n < 2; ++n) _Pragma("unroll") for (int k = 0; k < 2; ++k) dst[n][k] = *(const PG8_LAS bf16x8*)(lds + PG8_SB(b, h) + boff + n * 2048 + k * 1024); } while (0)
#define PG8_MMA(ai, bj, At, Bt) do { __builtin_amdgcn_s_setprio(1); _Pragma("unroll") for (int m = 0; m < 4; ++m) _Pragma("unroll") for (int n = 0; n < 2; ++n) _Pragma("unroll") for (int k = 0; k < 2; ++k) \
        acc[ai][bj][m][n] = __builtin_amdgcn_mfma_f32_16x16x32_bf16(Bt[n][k], At[m][k], acc[ai][bj][m][n], 0, 0, 0); __builtin_amdgcn_s_setprio(0); } while (0)
#define PG8_WAIT_V(n) asm volatile("s_waitcnt vmcnt(" #n ")" ::: "memory")
#define PG8_WAIT_L(n) asm volatile("s_waitcnt lgkmcnt(" #n ")" ::: "memory")
#define PG8_BAR __builtin_amdgcn_s_barrier()
#define PG8_SCHED __builtin_amdgcn_sched_barrier(0)
#define PG8_APTR(pm_, h, tt) ((tt) < nt0 ? (const char*)g.A0 + ((size_t)((pm_) * BM + (h) * HALF) * g.K0 + (size_t)(tt) * BK) * 2 : (const char*)g.A1 + ((size_t)((pm_) * BM + (h) * HALF) * g.K1 + (size_t)((tt) - nt0) * BK) * 2)
#define PG8_BPTR(pn_, h, tt) ((tt) < nt0 ? (const char*)g.B0 + ((size_t)((pn_) * BM + (h) * HALF) * g.K0 + (size_t)(tt) * BK) * 2 : (const char*)g.B1 + ((size_t)((pn_) * BM + (h) * HALF) * g.K1 + (size_t)((tt) - nt0) * BK) * 2)
    Unit cur, nxt; int ui = 0;
    if (!S.next(0, cur)) return;
    f32x4 acc[2][2][4][2];
#pragma unroll
    for (int a = 0; a < 2; ++a)
#pragma unroll
        for (int b = 0; b < 2; ++b)
#pragma unroll
            for (int m = 0; m < 4; ++m)
#pragma unroll
                for (int n = 0; n < 2; ++n) acc[a][b][m][n] = (f32x4){0.f, 0.f, 0.f, 0.f};
    bf16x8 At[4][2], B0[2][2], B1[2][2];
    PG8_STAGE(PG8_SB(0, 0), PG8_BPTR(cur.pn, 0, 0), RB2, g.K0); PG8_STAGE(PG8_SB(0, 1), PG8_BPTR(cur.pn, 1, 0), RB2, g.K0); PG8_STAGE(PG8_SA(0, 0), PG8_APTR(cur.pm, 0, 0), RA2, g.K0); PG8_STAGE(PG8_SA(0, 1), PG8_APTR(cur.pm, 1, 0), RA2, g.K0);
    if (wr == 1) PG8_BAR;
    PG8_WAIT_V(2); PG8_BAR;
    PG8_STAGE(PG8_SB(1, 0), PG8_BPTR(cur.pn, 0, 1), RB2, g.K0); PG8_STAGE(PG8_SA(1, 0), PG8_APTR(cur.pm, 0, 1), RA2, g.K0); PG8_STAGE(PG8_SB(1, 1), PG8_BPTR(cur.pn, 1, 1), RB2, g.K0);
    PG8_WAIT_V(6); PG8_BAR;
    for (;;) {
        const bool has_next = S.next(ui + 1, nxt);
#pragma unroll 1
        for (int t = 0; t < nt; t += 2) {
            const bool last = (t == nt - 2);
            if (t == nt0) E.mid(acc, cur, wr, wc, fr, fq);
            const bool s1 = t >= nt0;
            const int t2 = last ? 0 : t + 2; const bool s2 = t2 >= nt0;
            const int pm2 = (last && has_next) ? nxt.pm : cur.pm, pn2 = (last && has_next) ? nxt.pn : cur.pn;
            const int Ks1 = s1 ? g.K1 : g.K0, Ks2 = s2 ? g.K1 : g.K0;
            const char* a1h1 = PG8_APTR(cur.pm, 1, t + 1);
            const char* a2h0 = PG8_APTR(pm2, 0, t2); const char* a2h1 = PG8_APTR(pm2, 1, t2);
            const char* b2h0 = PG8_BPTR(pn2, 0, t2); const char* b2h1 = PG8_BPTR(pn2, 1, t2);
            PG8_LDB(B0, 0, 0); PG8_LDB(B1, 0, 1); PG8_SCHED; PG8_LDA(At, 0, 0); PG8_STAGE(PG8_SA(1, 1), a1h1, RA2, Ks1);
            PG8_WAIT_V(8); PG8_WAIT_L(0); PG8_BAR; PG8_MMA(0, 0, At, B0); PG8_MMA(0, 1, At, B1); PG8_BAR; PG8_SCHED;
            PG8_LDA(At, 0, 1); PG8_STAGE(PG8_SB(0, 0), b2h0, RB2, Ks2); PG8_STAGE(PG8_SB(0, 1), b2h1, RB2, Ks2); PG8_STAGE(PG8_SA(0, 0), a2h0, RA2, Ks2);
            PG8_WAIT_V(8); PG8_WAIT_L(0); PG8_BAR; PG8_MMA(1, 0, At, B0); PG8_MMA(1, 1, At, B1); PG8_BAR; PG8_SCHED;
            PG8_LDB(B0, 1, 0); PG8_LDB(B1, 1, 1); PG8_SCHED; PG8_LDA(At, 1, 0); PG8_STAGE(PG8_SA(0, 1), a2h1, RA2, Ks2);
            PG8_WAIT_V(8); PG8_WAIT_L(0); PG8_BAR; PG8_MMA(0, 0, At, B0); PG8_MMA(0, 1, At, B1); PG8_BAR; PG8_SCHED;
            PG8_LDA(At, 1, 1); PG8_STAGE(PG8_SB(1, 0), b2h0 + kstep, RB2, Ks2); PG8_STAGE(PG8_SB(1, 1), b2h1 + kstep, RB2, Ks2); PG8_STAGE(PG8_SA(1, 0), a2h0 + kstep, RA2, Ks2);
            PG8_WAIT_V(8); PG8_WAIT_L(0); PG8_BAR; PG8_MMA(1, 0, At, B0); PG8_MMA(1, 1, At, B1); PG8_BAR; PG8_SCHED;
        }
        if constexpr (ALIGN_EPI) { if (wr == 0) PG8_BAR; }
        E(acc, cur, wr, wc, fr, fq);
        if (!has_next) break;
#pragma unroll
        for (int a = 0; a < 2; ++a)
#pragma unroll
            for (int b = 0; b < 2; ++b)
#pragma unroll
                for (int m = 0; m < 4; ++m)
#pragma unroll
                    for (int n = 0; n < 2; ++n) acc[a][b][m][n] = (f32x4){0.f, 0.f, 0.f, 0.f};
        cur = nxt; ++ui;
        if constexpr (ALIGN_EPI) { if (wr == 1) PG8_BAR; }
    }
    PG8_WAIT_V(0);
    if constexpr (!ALIGN_EPI) { if (wr == 0) PG8_BAR; }
    PG8_BAR;
#undef PG8_SA
#undef PG8_SB
#undef PG8_STAGE
#undef PG8_LDA
#undef PG8_LDB
#undef PG8_MMA
#undef PG8_WAIT_V
#undef PG8_WAIT_L
#undef PG8_BAR
#undef PG8_SCHED
#undef PG8_APTR
#undef PG8_BPTR
}
struct GemmGM { const bf16_t* XB; const bf16_t* WinT; const bf16_t* AO; const bf16_t* WpaT; const bf16_t* DIFF; const bf16_t* WeffT; const float* bias; bf16_t* MIXED; int wave; };
template <class Sched, class Pre>
__device__ __forceinline__ void gemm_phase_gm(PG8_LAS unsigned char* lds, const GemmGM g, const Sched& S, const Pre& pre) {
    const int wid = g.wave, lane = lane_id(), tid = wid * 64 + lane, wr = wid >> 2, wc = wid & 3, fr = lane & 15, fq = lane >> 4;
    constexpr int NTG = DM / BK, NTA = AOW / BK, NTP = POOLW / BK, NT = NTG + NTA + NTP;
    static_assert(NTG % 2 == 0 && NTA % 2 == 0 && NTP % 2 == 0, "segment boundaries on even K-tiles");
    unsigned RCB[2];
#pragma unroll
    for (int i = 0; i < 2; ++i) { int R, C; stage_rc(tid * 16 + i * 8192, R, C); const int Rb = (R & ~31) + perm32(R & 31);
        RCB[i] = ((unsigned)Rb << 16) | ((unsigned)R << 8) | (unsigned)C; }
    const size_t kstep = (size_t)(BK * 2);
    const unsigned ldsw = (unsigned)wid * 1024u;
    const int aoff = lds_byte(wr * 64 + fr, fq * 8), boff = lds_byte(wc * 32 + fr, fq * 8);
#define PG8_SA(b, h) (((b) * 2 + (h)) * HTB)
#define PG8_SB(b, h) ((4 + (b) * 2 + (h)) * HTB)
#define RA2 8
#define RB2 16
#define PG8_STAGE(bufoff, gbase, SH, Kb) do { _Pragma("unroll") for (int _i = 0; _i < 2; ++_i) \
        __builtin_amdgcn_global_load_lds((const unsigned*)((const char*)(gbase) + ((((RCB[_i] >> (SH)) & 0xffu) * (unsigned)(Kb) + (RCB[_i] & 0xffu)) * 2u)), (PG8_LAS unsigned*)(lds + (bufoff) + ldsw + _i * 8192), 16, 0, 0); } while (0)
#define PG8_LDA(dst, b, h) do { _Pragma("unroll") for (int m = 0; m < 4; ++m) _Pragma("unroll") for (int k = 0; k < 2; ++k) dst[m][k] = *(const PG8_LAS bf16x8*)(lds + PG8_SA(b, h) + aoff + m * 2048 + k * 1024); } while (0)
#define PG8_LDB(dst, b, h) do { _Pragma("unroll") for (int n = 0; n < 2; ++n) _Pragma("unroll") for (int k = 0; k < 2; ++k) dst[n][k] = *(const PG8_LAS bf16x8*)(lds + PG8_SB(b, h) + boff + n * 2048 + k * 1024); } while (0)
#define PG8_MMA(ai, bj, At, Bt) do { __builtin_amdgcn_s_setprio(1); _Pragma("unroll") for (int m = 0; m < 4; ++m) _Pragma("unroll") for (int n = 0; n < 2; ++n) _Pragma("unroll") for (int k = 0; k < 2; ++k) \
        acc[ai][bj][m][n] = __builtin_amdgcn_mfma_f32_16x16x32_bf16(Bt[n][k], At[m][k], acc[ai][bj][m][n], 0, 0, 0); __builtin_amdgcn_s_setprio(0); } while (0)
#define PG8_WAIT_V(n) asm volatile("s_waitcnt vmcnt(" #n ")" ::: "memory")
#define PG8_WAIT_L(n) asm volatile("s_waitcnt lgkmcnt(" #n ")" ::: "memory")
#define PG8_BAR __builtin_amdgcn_s_barrier()
#define PG8_SCHED __builtin_amdgcn_sched_barrier(0)
    int kG = DM, kA = AOW, kP = POOLW; asm volatile("" : "+s"(kG), "+s"(kA), "+s"(kP));
#define GM_K(tt) ((tt) < NTG ? kG : ((tt) < NTG + NTA ? kA : kP))
#define GM_APTR(pm_, h, tt) ((tt) < NTG ? (const char*)g.XB + ((size_t)((pm_) * BM + (h) * HALF) * DM + (size_t)(tt) * BK) * 2 : \
        ((tt) < NTG + NTA ? (const char*)g.AO + ((size_t)((pm_) * BM + (h) * HALF) * AOW + (size_t)((tt) - NTG) * BK) * 2 : (const char*)g.DIFF + ((size_t)((pm_) * BM + (h) * HALF) * POOLW + (size_t)((tt) - NTG - NTA) * BK) * 2))
#define GM_BPTR(tc_, h, tt) ((tt) < NTG ? (const char*)g.WinT + ((size_t)((11 + (tc_)) * BM + (h) * HALF) * DM + (size_t)(tt) * BK) * 2 : \
        ((tt) < NTG + NTA ? (const char*)g.WpaT + ((size_t)((tc_) * HALF) * AOW + (size_t)((tt) - NTG) * BK) * 2 : (const char*)g.WeffT + ((size_t)((tc_) * HALF) * POOLW + (size_t)((tt) - NTG - NTA) * BK) * 2))
#define GM_ITER(CM, SM) do { \
        PG8_LDB(B0, 0, 0); if (CM) PG8_LDB(B1, 0, 1); PG8_SCHED; PG8_LDA(At, 0, 0); PG8_STAGE(PG8_SA(1, 1), a1h1, RA2, Kc); \
        if (CM) PG8_WAIT_V(8); else PG8_WAIT_V(6); PG8_WAIT_L(0); PG8_BAR; PG8_MMA(0, 0, At, B0); if (CM) PG8_MMA(0, 1, At, B1); PG8_BAR; PG8_SCHED; \
        PG8_LDA(At, 0, 1); PG8_STAGE(PG8_SB(0, 0), b2h0, RB2, Ks); if (SM) PG8_STAGE(PG8_SB(0, 1), b2h1, RB2, Ks); PG8_STAGE(PG8_SA(0, 0), a2h0, RA2, Ks); \
        if (SM) PG8_WAIT_V(8); else PG8_WAIT_V(6); PG8_WAIT_L(0); PG8_BAR; PG8_MMA(1, 0, At, B0); if (CM) PG8_MMA(1, 1, At, B1); PG8_BAR; PG8_SCHED; \
        PG8_LDB(B0, 1, 0); if (CM) PG8_LDB(B1, 1, 1); PG8_SCHED; PG8_LDA(At, 1, 0); PG8_STAGE(PG8_SA(0, 1), a2h1, RA2, Ks); \
        if (SM) PG8_WAIT_V(8); else PG8_WAIT_V(6); PG8_WAIT_L(0); PG8_BAR; PG8_MMA(0, 0, At, B0); if (CM) PG8_MMA(0, 1, At, B1); PG8_BAR; PG8_SCHED; \
        PG8_LDA(At, 1, 1); PG8_STAGE(PG8_SB(1, 0), b2h0 + kstep, RB2, Ks); if (SM) PG8_STAGE(PG8_SB(1, 1), b2h1 + kstep, RB2, Ks); PG8_STAGE(PG8_SA(1, 0), a2h0 + kstep, RA2, Ks); \
        if (SM) PG8_WAIT_V(8); else PG8_WAIT_V(6); PG8_WAIT_L(0); PG8_BAR; PG8_MMA(1, 0, At, B0); if (CM) PG8_MMA(1, 1, At, B1); PG8_BAR; PG8_SCHED; } while (0)
    Unit cur, nxt; int ui = 0;
    if (!S.next(0, cur)) return;
    f32x4 acc[2][2][4][2];
#pragma unroll
    for (int a = 0; a < 2; ++a)
#pragma unroll
        for (int b = 0; b < 2; ++b)
#pragma unroll
            for (int m = 0; m < 4; ++m)
#pragma unroll
                for (int n = 0; n < 2; ++n) acc[a][b][m][n] = (f32x4){0.f, 0.f, 0.f, 0.f};
    bf16x8 At[4][2], B0[2][2], B1[2][2];
    PG8_STAGE(PG8_SB(0, 0), GM_BPTR(cur.pn, 0, 0), RB2, kG); PG8_STAGE(PG8_SB(0, 1), GM_BPTR(cur.pn, 1, 0), RB2, kG); PG8_STAGE(PG8_SA(0, 0), GM_APTR(cur.pm, 0, 0), RA2, kG); PG8_STAGE(PG8_SA(0, 1), GM_APTR(cur.pm, 1, 0), RA2, kG);
    if (wr == 1) PG8_BAR;
    PG8_WAIT_V(2); PG8_BAR;
    PG8_STAGE(PG8_SB(1, 0), GM_BPTR(cur.pn, 0, 1), RB2, kG); PG8_STAGE(PG8_SA(1, 0), GM_APTR(cur.pm, 0, 1), RA2, kG); PG8_STAGE(PG8_SB(1, 1), GM_BPTR(cur.pn, 1, 1), RB2, kG);
    PG8_WAIT_V(6); PG8_BAR;
    for (;;) {
        const bool has_next = S.next(ui + 1, nxt);
        u32x2 rho[2][4][2], sgb[2][4][2];
#define GM_SETUP(t_, last_) const int t2 = (last_) ? 0 : (t_) + 2; const int pm2 = ((last_) && has_next) ? nxt.pm : cur.pm, tc2 = ((last_) && has_next) ? nxt.pn : cur.pn; \
            int Kc = GM_K(t_), Ks = GM_K(t2); asm volatile("" : "+s"(Kc), "+s"(Ks)); const char* a1h1 = GM_APTR(cur.pm, 1, (t_) + 1); \
            const char* a2h0 = GM_APTR(pm2, 0, t2); const char* a2h1 = GM_APTR(pm2, 1, t2); const char* b2h0 = GM_BPTR(tc2, 0, t2); const char* b2h1 = GM_BPTR(tc2, 1, t2)
#pragma unroll 1
        for (int t = 0; t < NTG - 2; t += 2) { GM_SETUP(t, false); GM_ITER(1, 1); }
        if (ui == 0) pre();
        { GM_SETUP(NTG - 2, false); GM_ITER(1, 0); }
        {
            int lc0 = wc * 32 + 8 * fq; asm volatile("" : "+v"(lc0));
            const float* bga = g.bias + GA_OFF + cur.pn * HALF + lc0; const float* bgb = g.bias + GB_OFF + cur.pn * HALF + lc0;
            const f32x4 ba0 = *(const f32x4*)bga, ba1 = *(const f32x4*)(bga + 4), bb0 = *(const f32x4*)bgb, bb1 = *(const f32x4*)(bgb + 4);
#pragma unroll
            for (int ai = 0; ai < 2; ++ai)
#pragma unroll
                for (int m = 0; m < 4; ++m)
#pragma unroll
                    for (int n = 0; n < 2; ++n) { const f32x4 ga = acc[ai][0][m][n] + (n ? ba1 : ba0), gb = acc[ai][1][m][n] + (n ? bb1 : bb0); float r[4], sb[4];
#pragma unroll
                        for (int i = 0; i < 4; ++i) { sb[i] = fsig_gate(gb[i]); r[i] = fsig(ga[i]) * __builtin_amdgcn_rcpf(sb[i]); }
                        rho[ai][m][n].x = cvt_pk_bf16(r[0], r[1]); rho[ai][m][n].y = cvt_pk_bf16(r[2], r[3]); sgb[ai][m][n].x = cvt_pk_bf16(sb[0], sb[1]); sgb[ai][m][n].y = cvt_pk_bf16(sb[2], sb[3]);
                        acc[ai][0][m][n] = (f32x4){0.f, 0.f, 0.f, 0.f}; }
        }
#pragma unroll 1
        for (int t = NTG; t < NTG + NTA; t += 2) { GM_SETUP(t, false); GM_ITER(0, 0); }
#pragma unroll
        for (int ai = 0; ai < 2; ++ai)
#pragma unroll
            for (int m = 0; m < 4; ++m)
#pragma unroll
                for (int n = 0; n < 2; ++n) { f32x4& v = acc[ai][0][m][n]; const u32x2 rr = rho[ai][m][n]; v[0] *= bflo(rr.x); v[1] *= bfhi(rr.x); v[2] *= bflo(rr.y); v[3] *= bfhi(rr.y); }
#pragma unroll 1
        for (int t = NTG + NTA; t < NT - 2; t += 2) { GM_SETUP(t, false); GM_ITER(0, 0); }
        { GM_SETUP(NT - 2, true); GM_ITER(0, 1); }
        if (wr == 0) PG8_BAR;
        {
            const int row0 = cur.pm * BM + wr * 64 + fr, col0 = cur.pn * HALF + wc * 32 + 8 * fq;
#pragma unroll
            for (int ai = 0; ai < 2; ++ai)
#pragma unroll
                for (int m = 0; m < 4; ++m) { const f32x4 v0 = acc[ai][0][m][0], v1 = acc[ai][0][m][1]; const u32x2 s0 = sgb[ai][m][0], s1 = sgb[ai][m][1];
                    u32x4 w; w.x = cvt_pk_bf16(v0[0] * bflo(s0.x), v0[1] * bfhi(s0.x)); w.y = cvt_pk_bf16(v0[2] * bflo(s0.y), v0[3] * bfhi(s0.y));
                    w.z = cvt_pk_bf16(v1[0] * bflo(s1.x), v1[1] * bfhi(s1.x)); w.w = cvt_pk_bf16(v1[2] * bflo(s1.y), v1[3] * bfhi(s1.y));
                    *(u32x4*)(g.MIXED + (size_t)(row0 + ai * HALF + m * 16) * DM + col0) = w; }
        }
        if (!has_next) break;
#pragma unroll
        for (int a = 0; a < 2; ++a)
#pragma unroll
            for (int b = 0; b < 2; ++b)
#pragma unroll
                for (int m = 0; m < 4; ++m)
#pragma unroll
                    for (int n = 0; n < 2; ++n) acc[a][b][m][n] = (f32x4){0.f, 0.f, 0.f, 0.f};
        cur = nxt; ++ui;
        if (wr == 1) PG8_BAR;
    }
    PG8_WAIT_V(0);
    PG8_BAR;
#undef PG8_SA
#undef PG8_SB
#undef PG8_STAGE
#undef PG8_LDA
#undef PG8_LDB
#undef PG8_MMA
#undef PG8_WAIT_V
#undef PG8_WAIT_L
#undef PG8_BAR
#undef PG8_SCHED
#undef GM_K
#undef GM_APTR
#undef GM_BPTR
#undef GM_ITER
#undef GM_SETUP
#undef RA2
#undef RB2
}
}

constexpr int NWAVES = 8;
constexpr int RING_OFF = 0, RING_BYTES = 131072;
constexpr int ATTN_LDS = 147456;
constexpr int BIAS_OFF = ATTN_LDS;
constexpr int LDSCTL_OFF = BIAS_OFF + 3 * 4 * 192 * 4;
constexpr int MISC_OFF = LDSCTL_OFF, TILE_E_OFF = LDSCTL_OFF + 256, FIRST_OFF = TILE_E_OFF + 320 * 4;
constexpr int LDS_BYTES = 163840;
static_assert(FIRST_OFF + 64 * 4 <= LDS_BYTES, "LDS map");
constexpr size_t WS_XB = WS_X1B;
constexpr size_t WT_WIN = WS_WT;
constexpr size_t WT_WPA = WT_WIN + (size_t)INW * DM * 2;
constexpr size_t WT_WEFF = WT_WPA + (size_t)DM * AOW * 2;
constexpr size_t WT_WOUT = WT_WEFF + (size_t)DM * POOLW * 2;
constexpr size_t WT_WGU = WT_WOUT + (size_t)DM * DM * 2;
constexpr size_t WT_WD = WT_WGU + (size_t)NEXP * 512 * DM * 2;
static_assert(WT_WD + (size_t)NEXP * DM * DEXP * 2 <= WS_CTL, "weights fit");
constexpr int CW_CNT = 0;
constexpr int CW_BAR = 4096;
constexpr int CW_READY = 8192;
constexpr int CW_Q9 = 30720, CW_TMO = 30784;
constexpr size_t CTL_ZERO_BYTES = 262144;

#define GAS __attribute__((address_space(1)))
#define LAS __attribute__((address_space(3)))
typedef GAS unsigned gu32;
#define RLX_AGENT __ATOMIC_RELAXED, __HIP_MEMORY_SCOPE_AGENT
#define LDS_WAIT() asm volatile("s_waitcnt lgkmcnt(0)" ::: "memory")
#define VM_WAIT() asm volatile("s_waitcnt vmcnt(0)" ::: "memory")
typedef unsigned v4u __attribute__((ext_vector_type(4)));
__device__ __forceinline__ unsigned pk2(float lo, float hi) { return (unsigned)f2bf(lo) | ((unsigned)f2bf(hi) << 16); }

#define XB_TMO      128
#define XB_XCNT(j)  (256  + 64 * (j))
#define XB_XSUB(j)  (1280 + 64 * (j))
#define XB_XGEN(j)  (2304 + 64 * (j))
#define XB_TOP      3328
#define XB_TOPGEN   3392
#define XCD_BAR_WORDS 3456
#define XB_SPIN_CAP (1u << 18)

__device__ __forceinline__ unsigned xb_ld(unsigned* p)              { return __hip_atomic_load(p, __ATOMIC_RELAXED, __HIP_MEMORY_SCOPE_AGENT); }
__device__ __forceinline__ unsigned xb_add(unsigned* p, unsigned v) { return __hip_atomic_fetch_add(p, v, __ATOMIC_RELAXED, __HIP_MEMORY_SCOPE_AGENT); }
__device__ __forceinline__ unsigned xb_xcc_id() { return (unsigned)__builtin_amdgcn_s_getreg((3 << 11) | 20) & 0xFu; }
#define XB_SPIN(cond, bar) do { unsigned _sp = 0; while (cond) { __builtin_amdgcn_s_sleep(1); \
    if ((++_sp & 255u) == 0u) { if (xb_ld(&(bar)[XB_TMO])) break; if (_sp > XB_SPIN_CAP) { atomicAdd(&(bar)[XB_TMO], 1u); break; } } } } while (0)

struct XcdBarrier {
    unsigned* bar; unsigned x; unsigned w;
    volatile LAS unsigned* st;
};

__device__ __forceinline__ XcdBarrier xcd_barrier_post(unsigned* bar, volatile LAS unsigned* st, unsigned w) {
    XcdBarrier b; b.bar = bar; b.x = xb_xcc_id(); b.st = st; b.w = w;
    if (w == 0u && lane_id() == 0) (void)xb_add(&bar[XB_XCNT(b.x)], 1u);
    return b;
}
__device__ __forceinline__ void xcd_barrier_complete(unsigned* bar, unsigned x, unsigned& nloc, unsigned& nx) {
    const unsigned G = gridDim.x * gridDim.y * gridDim.z;
    unsigned sum, cnt, mine, sp = 0u;
    for (;;) {
        sum = 0u; cnt = 0u; mine = 0u;
#pragma unroll
        for (unsigned j = 0; j < 16; ++j) { const unsigned c = xb_ld(&bar[XB_XCNT(j)]); sum += c; cnt += (c > 0u) ? 1u : 0u; mine = (j == x) ? c : mine; }
        if (sum == G) break;
        __builtin_amdgcn_s_sleep(1);
        if ((++sp & 255u) == 0u) { if (xb_ld(&bar[XB_TMO])) break; if (sp > XB_SPIN_CAP) { atomicAdd(&bar[XB_TMO], 1u); break; } }
    }
    nloc = mine > 0u ? mine : 1u; nx = cnt > 0u ? cnt : 1u;
}

__device__ __forceinline__ void xcd_barrier(const XcdBarrier& b) {
    asm volatile("s_waitcnt vmcnt(0)" ::: "memory");
    __syncthreads();
    if (b.w == 0u && lane_id() == 0) {
        unsigned* bar = b.bar;
        __builtin_amdgcn_s_waitcnt(0);
        unsigned nloc = b.st[0], nx = b.st[1];
        if (nloc == 0u) { xcd_barrier_complete(bar, b.x, nloc, nx); b.st[0] = nloc; b.st[1] = nx; }
        const unsigned old = xb_add(&bar[XB_XSUB(b.x)], 1u);
        const unsigned gen = old / nloc;
        if (old + 1u == (gen + 1u) * nloc) {
            __builtin_amdgcn_fence(__ATOMIC_RELEASE, "agent");
            asm volatile("s_waitcnt vmcnt(0)" ::: "memory");
            const unsigned og = xb_add(&bar[XB_TOP], 1u);
            const unsigned tg = og / nx;
            if (og + 1u == (tg + 1u) * nx) xb_add(&bar[XB_TOPGEN], 1u);
            else XB_SPIN(xb_ld(&bar[XB_TOPGEN]) == tg, bar);
            __builtin_amdgcn_fence(__ATOMIC_ACQUIRE, "agent");
            xb_add(&bar[XB_XGEN(b.x)], 1u);
            asm volatile("s_waitcnt vmcnt(0)" ::: "memory");
        } else {
            XB_SPIN(xb_ld(&bar[XB_XGEN(b.x)]) == gen, bar);
            __builtin_amdgcn_fence(__ATOMIC_ACQUIRE, "agent");
            asm volatile("s_waitcnt vmcnt(0)" ::: "memory");
        }
    }
    __syncthreads();
}

__device__ __forceinline__ void xcd_arrive(const XcdBarrier& b) {
    asm volatile("s_waitcnt vmcnt(0)" ::: "memory");
    __syncthreads();
    if (b.w == 0u && lane_id() == 0) {
        unsigned* bar = b.bar;
        __builtin_amdgcn_s_waitcnt(0);
        unsigned nloc = b.st[0], nx = b.st[1];
        if (nloc == 0u) { xcd_barrier_complete(bar, b.x, nloc, nx); b.st[0] = nloc; b.st[1] = nx; }
        const unsigned old = xb_add(&bar[XB_XSUB(b.x)], 1u);
        const unsigned gen = old / nloc; unsigned role = 0u, tg = 0u;
        if (old + 1u == (gen + 1u) * nloc) {
            __builtin_amdgcn_fence(__ATOMIC_RELEASE, "agent");
            asm volatile("s_waitcnt vmcnt(0)" ::: "memory");
            const unsigned og = xb_add(&bar[XB_TOP], 1u); tg = og / nx;
            if (og + 1u == (tg + 1u) * nx) { xb_add(&bar[XB_TOPGEN], 1u); role = 2u; } else role = 1u;
        }
        b.st[2] = role; b.st[3] = gen; b.st[4] = tg;
    }
}
__device__ __forceinline__ void xcd_wait(const XcdBarrier& b) {
    if (b.w == 0u && lane_id() == 0) {
        unsigned* bar = b.bar; const unsigned role = b.st[2], gen = b.st[3], tg = b.st[4];
        if (role) {
            if (role == 1u) XB_SPIN(xb_ld(&bar[XB_TOPGEN]) == tg, bar);
            __builtin_amdgcn_fence(__ATOMIC_ACQUIRE, "agent");
            xb_add(&bar[XB_XGEN(b.x)], 1u);
            asm volatile("s_waitcnt vmcnt(0)" ::: "memory");
        } else {
            XB_SPIN(xb_ld(&bar[XB_XGEN(b.x)]) == gen, bar);
            __builtin_amdgcn_fence(__ATOMIC_ACQUIRE, "agent");
            asm volatile("s_waitcnt vmcnt(0)" ::: "memory");
        }
    }
    asm volatile("s_waitcnt lgkmcnt(0)" ::: "memory"); __builtin_amdgcn_s_barrier(); asm volatile("" ::: "memory");
}


struct Frame {
    LAS unsigned char* lds;
    int wave, vcu, G;
};
struct MArgs { const float* in[20]; float* out; unsigned char* ws; int ph_lo, ph_hi; };

struct TrItem { const float* W; bf16_t* WT; int K, N, k0, n0, drow0; };
__device__ __forceinline__ void tr_load(const TrItem& t, float (&v)[32], int lane) {
#pragma unroll
    for (int i = 0; i < 32; ++i) v[i] = t.W[(size_t)(t.k0 + 2 * i + (lane >> 5)) * t.N + t.n0 + (lane & 31)];
}
__device__ __forceinline__ void tr_store(const TrItem& t, const float (&v)[32], LAS float* scr, int lane) {
#pragma unroll
    for (int i = 0; i < 32; ++i) scr[(2 * i + (lane >> 5)) * 33 + (lane & 31)] = v[i];
    LDS_WAIT(); asm volatile("" ::: "memory");
    const int c = lane & 7;
#pragma unroll
    for (int j = 0; j < 4; ++j) { const int n = (lane >> 3) + 8 * j; const LAS float* s = scr + (8 * c) * 33 + n;
        v4u o; o.x = pk2(s[0 * 33], s[1 * 33]); o.y = pk2(s[2 * 33], s[3 * 33]); o.z = pk2(s[4 * 33], s[5 * 33]); o.w = pk2(s[6 * 33], s[7 * 33]);
        *(GAS v4u*)(t.WT + (size_t)(t.drow0 + n) * t.K + t.k0 + 8 * c) = o; }
    LDS_WAIT(); asm volatile("" ::: "memory");
}
constexpr int TR_IN = (DM / 64) * (INW / 32), TR_PA = (AOW / 64) * (DM / 32), TR_OUT = (DM / 64) * (DM / 32), TR_G = (DM / 64) * (DEXP / 32), TR_D = (DEXP / 64) * (DM / 32);
constexpr int TR_DENSE = TR_IN + TR_PA + TR_OUT, TR_EXP = NEXP * (2 * TR_G + TR_D);
__device__ __forceinline__ TrItem tr_item(const MArgs& a, int it) {
    unsigned char* ws = a.ws; TrItem t; int r = it;
    constexpr int TR_IN_A = (DM / 64) * (GA_OFF / 32);
    if (r < TR_IN) { int kb, n0; if (r < TR_IN_A) { const int nb = GA_OFF / 32; kb = r / nb; n0 = (r % nb) * 32; } else { const int nb = (INW - GA_OFF) / 32, q = r - TR_IN_A; kb = q / nb; n0 = GA_OFF + (q % nb) * 32; }
        t.W = a.in[1]; t.WT = (bf16_t*)(ws + WT_WIN); t.K = DM; t.N = INW; t.k0 = kb * 64; t.n0 = n0;
        t.drow0 = t.n0 < GA_OFF ? t.n0 : (t.n0 < GB_OFF ? GA_OFF + ((t.n0 - GA_OFF) >> 7) * 256 + ((t.n0 - GA_OFF) & 127) : GA_OFF + ((t.n0 - GB_OFF) >> 7) * 256 + 128 + ((t.n0 - GB_OFF) & 127)); return t; } r -= TR_IN;
    if (r < TR_PA) { const int nb = DM / 32; t.W = a.in[6]; t.WT = (bf16_t*)(ws + WT_WPA); t.K = AOW; t.N = DM; t.k0 = (r / nb) * 64; t.n0 = (r % nb) * 32; t.drow0 = t.n0; return t; } r -= TR_PA;
    if (r < TR_OUT) { const int nb = DM / 32; t.W = a.in[8]; t.WT = (bf16_t*)(ws + WT_WOUT); t.K = DM; t.N = DM; t.k0 = (r / nb) * 64; t.n0 = (r % nb) * 32; t.drow0 = t.n0; return t; } r -= TR_OUT;
    const int e = r / (2 * TR_G + TR_D); r -= e * (2 * TR_G + TR_D);
    if (r < 2 * TR_G) { const int up = r >= TR_G; if (up) r -= TR_G; const int nb = DEXP / 32; t.W = (up ? a.in[16] : a.in[15]) + (size_t)e * DM * DEXP; t.WT = (bf16_t*)(ws + WT_WGU); t.K = DM; t.N = DEXP;
        t.k0 = (r / nb) * 64; t.n0 = (r % nb) * 32; t.drow0 = e * 512 + (t.n0 >> 7) * 256 + up * 128 + (t.n0 & 127); return t; }
    r -= 2 * TR_G;
    { const int nb = DM / 32; t.W = a.in[17] + (size_t)e * DEXP * DM; t.WT = (bf16_t*)(ws + WT_WD) + (size_t)e * DM * DEXP; t.K = DEXP; t.N = DM; t.k0 = (r / nb) * 64; t.n0 = (r % nb) * 32; t.drow0 = t.n0; return t; }
}
__device__ __forceinline__ void tr_run(Frame& F, const MArgs& a, int first, int stride, int end) {
    LAS float* scr = (LAS float*)(F.lds + RING_OFF + F.wave * 16384);
    if (first >= end) return;
    float vn[32]; TrItem tn = tr_item(a, first); tr_load(tn, vn, lane_id());
    for (int it = first; it < end; it += stride) {
        float v[32]; TrItem t = tn;
#pragma unroll
        for (int i = 0; i < 32; ++i) v[i] = vn[i];
        if (it + stride < end) { tn = tr_item(a, it + stride); tr_load(tn, vn, lane_id()); }
        tr_store(t, v, scr, lane_id());
    }
}
__device__ __forceinline__ void p0_prologue_a(Frame& F, const MArgs& a) {
    unsigned char* ws = a.ws;
    const int gw = F.vcu * NWAVES + F.wave, NGW = F.G * NWAVES, lane = lane_id();
    tr_run(F, a, gw, NGW, (DM / 64) * (GA_OFF / 32));
    const float* x = a.in[0]; bf16_t* XB = (bf16_t*)(ws + WS_XB);
    for (int it = gw * 8; it < NTOK * DM / 512; it += NGW * 8) {
        f32x4 a0[8], a1[8];
#pragma unroll
        for (int u = 0; u < 8; ++u) { const size_t o = (size_t)(it + u) * 512 + lane * 8; a0[u] = *(const f32x4*)(x + o); a1[u] = *(const f32x4*)(x + o + 4); }
#pragma unroll
        for (int u = 0; u < 8; ++u) { const size_t o = (size_t)(it + u) * 512 + lane * 8;
            v4u w; w.x = pk2(a0[u][0], a0[u][1]); w.y = pk2(a0[u][2], a0[u][3]); w.z = pk2(a1[u][0], a1[u][1]); w.w = pk2(a1[u][2], a1[u][3]);
            *(GAS v4u*)(XB + o) = w; } }
}
__device__ __forceinline__ void p0_prologue_b(Frame& F, const MArgs& a) {
    unsigned char* ws = a.ws;
    const int gw = F.vcu * NWAVES + F.wave, NGW = F.G * NWAVES, lane = lane_id();
    const float* w_pool = a.in[4]; const float* pscale = a.in[5]; const float* w_pp = a.in[7];
    bf16_t* WeffT = (bf16_t*)(ws + WT_WEFF);
    tr_run(F, a, (DM / 64) * (GA_OFF / 32) + gw, NGW, TR_DENSE);
    for (int it = gw; it < (DM / 32) * (POOLW / 32); it += NGW) {
        const int nb = it >> 4, kb = it & 15, g = kb >> 2, n0 = nb * 32, c0 = (kb & 3) * 32, rr = lane & 31, kk = lane >> 5;
        typedef float f32x16 __attribute__((ext_vector_type(16)));
        f32x16 acc = {0.f, 0.f, 0.f, 0.f, 0.f, 0.f, 0.f, 0.f, 0.f, 0.f, 0.f, 0.f, 0.f, 0.f, 0.f, 0.f};
        const float* ap = w_pp + (size_t)(g * 128 + kk) * DM + n0 + rr;
        const float* sp = pscale + g * 128 + kk;
        const float* bp = w_pool + (size_t)(g * 128 + c0 + rr) * 128 + kk;
#pragma unroll 16
        for (int ks = 0; ks < 64; ++ks) { const float av = ap[(size_t)(2 * ks) * DM] * sp[2 * ks], bv = bp[2 * ks];
            acc = __builtin_amdgcn_mfma_f32_32x32x2f32(av, bv, acc, 0, 0, 0); }
#pragma unroll
        for (int i = 0; i < 16; ++i) { const int n = n0 + (i & 3) + 8 * (i >> 2) + 4 * kk;
            WeffT[(size_t)n * POOLW + g * 128 + c0 + rr] = f2bf(acc[i]); }
    }
}

__device__ __forceinline__ int moe_tables(Frame& F, const int* cnt) {
    LAS int* tile_e = (LAS int*)(F.lds + TILE_E_OFF); LAS int* first = (LAS int*)(F.lds + FIRST_OFF);
    __syncthreads();
    if ((F.wave * 64 + lane_id()) < 64) {
        const int e = (F.wave * 64 + lane_id()), nt = (e < NEXP) ? ((__hip_atomic_load(cnt + (e & 31) * 64, RLX_AGENT) + 255) >> 8) : 0;
        int incl = nt;
#pragma unroll
        for (int o = 1; o < 32; o <<= 1) { const int t = __shfl_up(incl, o); if ((e & 31) >= o) incl += t; }
        const int f0 = incl - nt;
        if (e < NEXP) { first[e] = f0; for (int i = 0; i < nt; ++i) tile_e[f0 + i] = e; if (e == NEXP - 1) first[NEXP] = incl; }
    }
    __syncthreads();
    return first[NEXP];
}


typedef float f32x16 __attribute__((ext_vector_type(16)));
typedef short s16x4 __attribute__((ext_vector_type(4)));
constexpr float LOG2E = 1.4426950408889634f;
constexpr float QSCALE = 0.125f * LOG2E;
constexpr int VROW = 192;
__device__ __forceinline__ s16x4 vtr(const LAS unsigned char* p) { return __builtin_bit_cast(s16x4, __builtin_amdgcn_ds_read_tr16_b64_v4i16((LAS s16x4*)p)); }
constexpr int AT_K = 0, AT_V0 = 49152, AT_V1 = 98304;
__device__ __forceinline__ void attn_unit_decode(int un, int& b, int& h, int& g, int& dil, int& L, int& c0, int& l0) {
    const int j = un & 7, bh = un >> 3; h = bh % 12; b = bh / 12; g = h >> 2; dil = 1 << (2 * g); L = SEQ >> (2 * g);
    if (g == 0) { c0 = 0; l0 = 256 * j; } else if (g == 1) { c0 = j >> 1; l0 = 256 * (j & 1); } else { c0 = 2 * j; l0 = 0; }
}
__device__ __forceinline__ size_t attn_krow(int b, int g, int L, int c0, int l0, int wr_) {
    if (g == 2) { const int cls = c0 + ((wr_ >> 7) & 1), l = wr_ & 127; return (size_t)b * SEQ + (size_t)cls * L + l; }
    int l = l0 - 128 + wr_; l = l < 0 ? 0 : l; return (size_t)b * SEQ + (size_t)c0 * L + l;
}
__device__ __forceinline__ void attn_wave_q(int g, int c0, int l0, int w, int& cq, int& lq0) { cq = (g == 2) ? c0 + (w >> 2) : c0; lq0 = (g == 2) ? 32 * (w & 3) : l0 + 32 * w; }
__device__ __forceinline__ void phase_attn(Frame& F, const MArgs& a, const bf16_t* proj, bf16_t* aog, float* lse) {
    LAS float* bias2 = (LAS float*)(F.lds + BIAS_OFF);
    const float* rel_bias = a.in[3];
    int tid0 = (F.wave * 64 + lane_id()); asm volatile("" : "+v"(tid0));
    for (int i = tid0; i < 3 * 4 * 192; i += NWAVES * 64) { const int gs = i / 192, j = i - gs * 192 - 32, g = gs >> 2, dil = 1 << (2 * g);
        bias2[i] = (j >= 0 && j <= 128) ? rel_bias[t5_bucket(j * dil) * 12 + gs] * LOG2E : -1.0e30f; }
    asm volatile("s_waitcnt vmcnt(0) lgkmcnt(0)" ::: "memory"); __builtin_amdgcn_s_barrier(); asm volatile("" ::: "memory");
    LAS unsigned char* ring = F.lds;
    const unsigned lds0 = (unsigned)(size_t)F.lds;
    const int lane = lane_id(), w = F.wave, r = lane & 31, hh = lane >> 5;
    const int NU = BATCH * 12 * 8;
    const int drow = lane >> 3, schunk = (lane & 7) ^ (lane >> 3);
    int koff[4];
#pragma unroll
    for (int ks = 0; ks < 4; ++ks) koff[ks] = r * 128 + ((((2 * ks + hh) ^ (r & 7))) << 4);
    const int trow = 4 * hh + ((lane & 15) >> 2);
    int toff[2];
#pragma unroll
    for (int dt = 0; dt < 2; ++dt) toff[dt] = trow * 128 + (((4 * dt + 2 * ((lane >> 4) & 1) + ((lane & 3) >> 1)) ^ (trow & 7)) << 4) + (lane & 1) * 8;
#define AT_DMA(dst_off, col_off) do { _Pragma("unroll") for (int _p = 0; _p < 6; ++_p) { const int _pc = w + 8 * _p; \
        const bf16_t* _src = proj + attn_krow(b_, g_, L_, c0_, l0_, _pc * 8 + drow) * INW + (col_off) + h_ * HD + schunk * 8; \
        unsigned _keep; const unsigned _dst = (unsigned)__builtin_amdgcn_readfirstlane((int)(lds0 + (unsigned)(dst_off) + (unsigned)_pc * 1024u)); \
        asm volatile("s_mov_b32 %0, m0\n\ts_mov_b32 m0, %2\n\ts_nop 0\n\tglobal_load_lds_dwordx4 %1, off\n\ts_mov_b32 m0, %0" : "=&s"(_keep) : "v"(_src), "s"(_dst) : "memory"); } } while (0)
#define AT_QLOAD(dst) do { int cq_, lq_; attn_wave_q(g_, c0_, l0_, w, cq_, lq_); const bf16_t* _qp = proj + ((size_t)b_ * SEQ + (size_t)cq_ * L_ + lq_ + r) * INW + Q_OFF + h_ * HD + 8 * hh; \
        _Pragma("unroll") for (int ks = 0; ks < 4; ++ks) dst[ks] = *(const bf16x8*)(_qp + 16 * ks); } while (0)
    bf16x8 qn[4];
    int un = F.vcu;
    { int b_, h_, g_, dil_, L_, c0_, l0_; attn_unit_decode(un, b_, h_, g_, dil_, L_, c0_, l0_); (void)dil_;
      AT_QLOAD(qn); AT_DMA(AT_K, K_OFF); AT_DMA(AT_V0, V_OFF); }
    bool first = true;
    for (int par = 0; un < NU; un += F.G, par ^= 1) {
        int b, h, g, dil, L, c0, l0; attn_unit_decode(un, b, h, g, dil, L, c0, l0);
        const bool has_next = (un + F.G) < NU;
        int cq, lq0; attn_wave_q(g, c0, l0, w, cq, lq0);
        const int wbase = (g == 2) ? 128 * (w >> 2) + 32 * (w & 3) - 128 : 32 * w;
        bf16x8 qf[4];
#pragma unroll
        for (int ks = 0; ks < 4; ++ks) qf[ks] = qn[ks];
        if (first) asm volatile("s_waitcnt vmcnt(0)" ::: "memory"); else asm volatile("s_waitcnt vmcnt(9)" ::: "memory");
        first = false;
        __builtin_amdgcn_s_barrier(); asm volatile("" ::: "memory");
        if (has_next) { int b_, h_, g_, dil_, L_, c0_, l0_; attn_unit_decode(un + F.G, b_, h_, g_, dil_, L_, c0_, l0_); (void)dil_;
            AT_QLOAD(qn); if (par == 0) AT_DMA(AT_V1, V_OFF); else AT_DMA(AT_V0, V_OFF); }
        f32x16 st[5];
#pragma unroll
        for (int kt = 0; kt < 5; ++kt) {
            int wrow = wbase + 32 * kt; if (g == 2) { const int lo_ = 128 * (w >> 2); wrow = wrow < lo_ ? lo_ : wrow; }
            f32x16 acc = {0.f, 0.f, 0.f, 0.f, 0.f, 0.f, 0.f, 0.f, 0.f, 0.f, 0.f, 0.f, 0.f, 0.f, 0.f, 0.f};
#pragma unroll
            for (int ks = 0; ks < 4; ++ks) { const bf16x8 kf = *(const LAS bf16x8*)(ring + AT_K + wrow * 128 + koff[ks]);
                acc = __builtin_amdgcn_mfma_f32_32x32x16_bf16(kf, qf[ks], acc, 0, 0, 0); }
            st[kt] = acc;
        }
        asm volatile("s_waitcnt lgkmcnt(0)" ::: "memory"); __builtin_amdgcn_s_barrier(); asm volatile("" ::: "memory");
        if (has_next) { int b_, h_, g_, dil_, L_, c0_, l0_; attn_unit_decode(un + F.G, b_, h_, g_, dil_, L_, c0_, l0_); (void)dil_; AT_DMA(AT_K, K_OFF); }
        const LAS float* bt = bias2 + h * 192 + 32 + 128 + (r - 4 * hh);
        float mx = -1.0e30f;
        if (lq0 >= 128) {
#pragma unroll
            for (int kt = 0; kt < 5; ++kt)
#pragma unroll
                for (int hb = 0; hb < 2; ++hb) { float bvv[8];
#pragma unroll
                    for (int i = 0; i < 8; ++i) bvv[i] = bt[-32 * kt - ((i & 3) + 8 * (2 * hb + (i >> 2)))];
                    asm volatile("" : "+v"(bvv[0]), "+v"(bvv[1]), "+v"(bvv[2]), "+v"(bvv[3]), "+v"(bvv[4]), "+v"(bvv[5]), "+v"(bvv[6]), "+v"(bvv[7]));
#pragma unroll
                    for (int i = 0; i < 8; ++i) { const float sv = st[kt][8 * hb + i] + bvv[i]; st[kt][8 * hb + i] = sv; mx = fmaxf(mx, sv); } }
        } else {
            const int jmax = lq0 + r, jl = 128 + r - 4 * hh;
#pragma unroll
            for (int kt = 0; kt < 5; ++kt)
#pragma unroll
                for (int hb = 0; hb < 2; ++hb) { float bvv[8];
#pragma unroll
                    for (int i = 0; i < 8; ++i) bvv[i] = bt[-32 * kt - ((i & 3) + 8 * (2 * hb + (i >> 2)))];
                    asm volatile("" : "+v"(bvv[0]), "+v"(bvv[1]), "+v"(bvv[2]), "+v"(bvv[3]), "+v"(bvv[4]), "+v"(bvv[5]), "+v"(bvv[6]), "+v"(bvv[7]));
#pragma unroll
                    for (int i = 0; i < 8; ++i) { const int jc = -32 * kt - ((i & 3) + 8 * (2 * hb + (i >> 2)));
                        const float sv = (jl + jc <= jmax) ? st[kt][8 * hb + i] + bvv[i] : -1.0e30f; st[kt][8 * hb + i] = sv; mx = fmaxf(mx, sv); } }
        }
        mx = fmaxf(mx, __shfl_xor(mx, 32));
        float lsum = 0.f;
#pragma unroll
        for (int kt = 0; kt < 5; ++kt)
#pragma unroll
            for (int i = 0; i < 16; ++i) { const float pv = __builtin_amdgcn_exp2f(st[kt][i] - mx); st[kt][i] = pv; lsum += pv; }
        lsum += __shfl_xor(lsum, 32);
        f32x16 o0 = {0.f, 0.f, 0.f, 0.f, 0.f, 0.f, 0.f, 0.f, 0.f, 0.f, 0.f, 0.f, 0.f, 0.f, 0.f, 0.f}, o1 = o0;
        const int vbuf = par ? AT_V1 : AT_V0;
#pragma unroll
        for (int kt = 0; kt < 5; ++kt) {
            int wrow = wbase + 32 * kt; if (g == 2) { const int lo_ = 128 * (w >> 2); wrow = wrow < lo_ ? lo_ : wrow; }
            const LAS unsigned char* vb = ring + vbuf + wrow * 128;
#pragma unroll
            for (int s2 = 0; s2 < 2; ++s2) {
                pg8::u32x4 pw; pw.x = pg8::cvt_pk_bf16(st[kt][8 * s2 + 0], st[kt][8 * s2 + 1]); pw.y = pg8::cvt_pk_bf16(st[kt][8 * s2 + 2], st[kt][8 * s2 + 3]);
                pw.z = pg8::cvt_pk_bf16(st[kt][8 * s2 + 4], st[kt][8 * s2 + 5]); pw.w = pg8::cvt_pk_bf16(st[kt][8 * s2 + 6], st[kt][8 * s2 + 7]);
                const bf16x8 pf = __builtin_bit_cast(bf16x8, pw);
#pragma unroll
                for (int dt = 0; dt < 2; ++dt) {
                    const s16x4 lo = vtr(vb + (16 * s2) * 128 + toff[dt]), hi = vtr(vb + (16 * s2 + 8) * 128 + toff[dt]);
                    const bf16x8 vf = {lo[0], lo[1], lo[2], lo[3], hi[0], hi[1], hi[2], hi[3]};
                    if (dt == 0) o0 = __builtin_amdgcn_mfma_f32_32x32x16_bf16(vf, pf, o0, 0, 0, 0); else o1 = __builtin_amdgcn_mfma_f32_32x32x16_bf16(vf, pf, o1, 0, 0, 0);
                }
            }
        }
        const float inv = 1.f / lsum;
        const int tok = b * SEQ + cq + dil * (lq0 + r);
        bf16_t* op = aog + ((size_t)g * NTOK + tok) * AOW + (h & 3) * HD + 4 * hh;
#pragma unroll
        for (int dt = 0; dt < 2; ++dt)
#pragma unroll
            for (int q4 = 0; q4 < 4; ++q4) { const f32x16& o = dt == 0 ? o0 : o1;
                pg8::u32x2 wv; wv.x = pg8::cvt_pk_bf16(o[4 * q4] * inv, o[4 * q4 + 1] * inv); wv.y = pg8::cvt_pk_bf16(o[4 * q4 + 2] * inv, o[4 * q4 + 3] * inv);
                *(pg8::u32x2*)(op + 32 * dt + 8 * q4) = wv; }
        if (hh == 0) lse[((size_t)g * NTOK + tok) * 4 + (h & 3)] = mx + __builtin_amdgcn_logf(lsum);
        asm volatile("s_waitcnt lgkmcnt(0)" ::: "memory");
    }
    asm volatile("s_waitcnt vmcnt(0) lgkmcnt(0)" ::: "memory"); __builtin_amdgcn_s_barrier(); asm volatile("" ::: "memory");
#undef AT_DMA
#undef AT_QLOAD
}
template <int W, int NI> __device__ __forceinline__ void pool_items(const bf16_t* proj, bf16_t* diff, int tok0, int ch) {
    pg8::u32x4 v[NI][W];
#pragma unroll
    for (int u = 0; u < NI; ++u) { const int tok = tok0 + 8 * u, t = tok & (SEQ - 1); const bf16_t* p = proj + (size_t)tok * INW + POOL_OFF + ch * 8;
#pragma unroll
        for (int j = 0; j < W; ++j) v[u][j] = *(const pg8::u32x4*)(p - (size_t)((t >= j) ? j : 0) * INW); }
#pragma unroll
    for (int u = 0; u < NI; ++u) { const int tok = tok0 + 8 * u, t = tok & (SEQ - 1);
        float s[8];
#pragma unroll
        for (int e = 0; e < 8; ++e) s[e] = 0.f;
#pragma unroll
        for (int j = 0; j < W; ++j) { const float m = (t >= j) ? 1.f : 0.f;
            s[0] += m * pg8::bflo(v[u][j].x); s[1] += m * pg8::bfhi(v[u][j].x); s[2] += m * pg8::bflo(v[u][j].y); s[3] += m * pg8::bfhi(v[u][j].y);
            s[4] += m * pg8::bflo(v[u][j].z); s[5] += m * pg8::bfhi(v[u][j].z); s[6] += m * pg8::bflo(v[u][j].w); s[7] += m * pg8::bfhi(v[u][j].w); }
        const float ic = 1.f / (float)((t + 1 < W) ? t + 1 : W);
        pg8::u32x4 o;
        o.x = pg8::cvt_pk_bf16(s[0] * ic - pg8::bflo(v[u][0].x), s[1] * ic - pg8::bfhi(v[u][0].x)); o.y = pg8::cvt_pk_bf16(s[2] * ic - pg8::bflo(v[u][0].y), s[3] * ic - pg8::bfhi(v[u][0].y));
        o.z = pg8::cvt_pk_bf16(s[4] * ic - pg8::bflo(v[u][0].z), s[5] * ic - pg8::bfhi(v[u][0].z)); o.w = pg8::cvt_pk_bf16(s[6] * ic - pg8::bflo(v[u][0].w), s[7] * ic - pg8::bfhi(v[u][0].w));
        *(pg8::u32x4*)(diff + (size_t)tok * POOLW + ch * 8) = o; }
}
__device__ __forceinline__ void phase_pool(Frame& F, const bf16_t* proj, bf16_t* diff) {
    const int gw = F.vcu * NWAVES + F.wave, NGW = F.G * NWAVES, lane = lane_id();
    for (int it = gw; it < NTOK / 4; it += NGW) {
        const int tg = it >> 3, cg = ((it & 7) + 2 * (it / NGW)) & 7, tok0 = tg * 32 + (lane >> 3), ch = cg * 8 + (lane & 7), gi = cg >> 1;
        if (gi == 0) pool_items<2, 4>(proj, diff, tok0, ch); else if (gi == 1) pool_items<4, 4>(proj, diff, tok0, ch);
        else if (gi == 2) { pool_items<8, 2>(proj, diff, tok0, ch); pool_items<8, 2>(proj, diff, tok0 + 16, ch); }
        else { pool_items<16, 1>(proj, diff, tok0, ch); pool_items<16, 1>(proj, diff, tok0 + 8, ch); pool_items<16, 1>(proj, diff, tok0 + 16, ch); pool_items<16, 1>(proj, diff, tok0 + 24, ch); }
    }
}
__device__ __forceinline__ void phase_combine(Frame& F, const bf16_t* aog, const float* lse, bf16_t* ao) {
    const int gt = (F.vcu * NWAVES + F.wave) * 64 + lane_id(), NGT = F.G * NWAVES * 64;
    for (int it = gt; it < NTOK * 32; it += NGT) {
        const int tok = it >> 5, ch = it & 31, slot = ch >> 3;
        const float l0 = lse[((size_t)0 * NTOK + tok) * 4 + slot], l1 = lse[((size_t)1 * NTOK + tok) * 4 + slot], l2 = lse[((size_t)2 * NTOK + tok) * 4 + slot];
        const float M = fmaxf(l0, fmaxf(l1, l2));
        float w0 = __builtin_amdgcn_exp2f(l0 - M), w1 = __builtin_amdgcn_exp2f(l1 - M), w2 = __builtin_amdgcn_exp2f(l2 - M);
        const float iw = 1.f / (w0 + w1 + w2); w0 *= iw; w1 *= iw; w2 *= iw;
        const pg8::u32x4 a0 = *(const pg8::u32x4*)(aog + ((size_t)0 * NTOK + tok) * AOW + ch * 8), a1 = *(const pg8::u32x4*)(aog + ((size_t)1 * NTOK + tok) * AOW + ch * 8),
                         a2 = *(const pg8::u32x4*)(aog + ((size_t)2 * NTOK + tok) * AOW + ch * 8);
        pg8::u32x4 o;
#define CMB(f) pg8::cvt_pk_bf16(w0 * pg8::bflo(a0.f) + w1 * pg8::bflo(a1.f) + w2 * pg8::bflo(a2.f), w0 * pg8::bfhi(a0.f) + w1 * pg8::bfhi(a1.f) + w2 * pg8::bfhi(a2.f))
        o.x = CMB(x); o.y = CMB(y); o.z = CMB(z); o.w = CMB(w);
#undef CMB
        *(pg8::u32x4*)(ao + (size_t)tok * AOW + ch * 8) = o;
    }
}

constexpr int XS = 1028;
template <class Pre> __device__ __forceinline__ void phase_ln_router(Frame& F, const MArgs& a, const bf16_t* y, bf16_t* x1b, int* cnt, int* list, float* listw, const Pre& pre) {
    const float* x = a.in[0];
    LAS float* xs = (LAS float*)(F.lds + RING_OFF);
    LAS float* part = xs + 16 * XS;
    LAS float* lgs = part + 8 * 16 * 48;
    LAS unsigned* lcnt = (LAS unsigned*)(lgs + 8 * 16 * 40);
    LAS int* rtab = (LAS int*)(lcnt + 32);
    if ((F.wave * 64 + lane_id()) < 32) lcnt[(F.wave * 64 + lane_id())] = 0u;
    const float* g1 = a.in[9]; const float* b1 = a.in[10]; const float* wrg = a.in[11]; const float* brg = a.in[12]; const float* wre = a.in[13]; const float* bre = a.in[14];
    LAS float* gb1 = (LAS float*)(F.lds + RING_OFF + 122880);
    { int tid0 = (F.wave * 64 + lane_id()); asm volatile("" : "+v"(tid0)); for (int i = tid0; i < 2 * DM; i += NWAVES * 64) gb1[i] = (i < DM) ? g1[i] : b1[i - DM]; }
    __syncthreads();
    const int lane = lane_id(), w = F.wave, t16 = lane & 15, q = lane >> 4, tid = (F.wave * 64 + lane_id());
    bf16x8 wBh[4][3], wBl[4][3];
#pragma unroll
    for (int ks = 0; ks < 4; ++ks)
#pragma unroll
        for (int ct = 0; ct < 3; ++ct) { const int o = 16 * ct + t16; float wv[8];
#pragma unroll
            for (int j = 0; j < 8; ++j) { const int k = 128 * w + 32 * ks + 8 * q + j; wv[j] = (o < 4) ? wrg[k * 4 + o] : ((o < 36) ? wre[k * 32 + o - 4] : 0.f); }
            pg8::u32x4 hw, lw;
#pragma unroll
            for (int j2 = 0; j2 < 4; ++j2) { const unsigned hp = pg8::cvt_pk_bf16(wv[2 * j2], wv[2 * j2 + 1]);
                const unsigned lp = pg8::cvt_pk_bf16(wv[2 * j2] - pg8::bflo(hp), wv[2 * j2 + 1] - pg8::bfhi(hp)); hw[j2] = hp; lw[j2] = lp; }
            wBh[ks][ct] = __builtin_bit_cast(bf16x8, hw); wBl[ks][ct] = __builtin_bit_cast(bf16x8, lw); }
    const int ntile = NTOK / 16;
    f32x4 vn[2][4]; pg8::u32x2 yn[2][4];
#define LNR_LOAD(T_) do { _Pragma("unroll") for (int rr = 0; rr < 2; ++rr) _Pragma("unroll") for (int j = 0; j < 4; ++j) { const size_t o_ = (size_t)(16 * (T_) + 2 * w + rr) * DM + lane * 4 + 256 * j; \
        vn[rr][j] = *(const f32x4*)(x + o_); yn[rr][j] = *(const pg8::u32x2*)(y + o_); } } while (0)
    pre();
    LNR_LOAD(F.vcu);
    const float rb0 = ((tid % 36) < 4) ? brg[tid % 36] : bre[(tid % 36) - 4], rb1 = (((tid + NWAVES * 64) % 36) < 4) ? brg[(tid + NWAVES * 64) % 36] : bre[((tid + NWAVES * 64) % 36) - 4];
    int ti = 0;
    for (int T = F.vcu; T < ntile; T += F.G, ++ti) {
        f32x4 v[2][4];
#pragma unroll
        for (int rr = 0; rr < 2; ++rr)
#pragma unroll
            for (int j = 0; j < 4; ++j) { f32x4 z = vn[rr][j] * ALPHA; z[0] += pg8::bflo(yn[rr][j].x); z[1] += pg8::bfhi(yn[rr][j].x); z[2] += pg8::bflo(yn[rr][j].y); z[3] += pg8::bfhi(yn[rr][j].y); v[rr][j] = z; }
        if (T + F.G < ntile) LNR_LOAD(T + F.G);
#pragma unroll
        for (int rr = 0; rr < 2; ++rr) {
            const int tok = 16 * T + 2 * w + rr;
            float s = 0.f;
#pragma unroll
            for (int j = 0; j < 4; ++j) s += (v[rr][j][0] + v[rr][j][1]) + (v[rr][j][2] + v[rr][j][3]);
            const float mean = wave_sum(s) * (1.f / DM); float s2 = 0.f;
#pragma unroll
            for (int j = 0; j < 4; ++j) { const f32x4 d = v[rr][j] - mean; s2 += (d[0] * d[0] + d[1] * d[1]) + (d[2] * d[2] + d[3] * d[3]); }
            const float rstd = 1.f / sqrtf(wave_sum(s2) * (1.f / DM) + LN_EPS);
#pragma unroll
            for (int j = 0; j < 4; ++j) { const int k0 = lane * 4 + 256 * j;
                const f32x4 x1 = (v[rr][j] - mean) * rstd * *(const LAS f32x4*)(gb1 + k0) + *(const LAS f32x4*)(gb1 + DM + k0);
                *(LAS f32x4*)(xs + (2 * w + rr) * XS + k0) = x1;
                pg8::u32x2 pk; pk.x = pg8::cvt_pk_bf16(x1[0], x1[1]); pk.y = pg8::cvt_pk_bf16(x1[2], x1[3]);
                *(pg8::u32x2*)(x1b + (size_t)tok * DM + k0) = pk; }
        }
        __syncthreads();
        f32x4 acc[3];
#pragma unroll
        for (int ct = 0; ct < 3; ++ct) acc[ct] = (f32x4){0.f, 0.f, 0.f, 0.f};
        const LAS float* xr = xs + t16 * XS + 128 * w + 8 * q;
#pragma unroll
        for (int ks = 0; ks < 4; ++ks) { const f32x4 xa = *(const LAS f32x4*)(xr + 32 * ks), xb = *(const LAS f32x4*)(xr + 32 * ks + 4);
            pg8::u32x4 hw, lw;
            hw.x = pg8::cvt_pk_bf16(xa[0], xa[1]); hw.y = pg8::cvt_pk_bf16(xa[2], xa[3]); hw.z = pg8::cvt_pk_bf16(xb[0], xb[1]); hw.w = pg8::cvt_pk_bf16(xb[2], xb[3]);
            lw.x = pg8::cvt_pk_bf16(xa[0] - pg8::bflo(hw.x), xa[1] - pg8::bfhi(hw.x)); lw.y = pg8::cvt_pk_bf16(xa[2] - pg8::bflo(hw.y), xa[3] - pg8::bfhi(hw.y));
            lw.z = pg8::cvt_pk_bf16(xb[0] - pg8::bflo(hw.z), xb[1] - pg8::bfhi(hw.z)); lw.w = pg8::cvt_pk_bf16(xb[2] - pg8::bflo(hw.w), xb[3] - pg8::bfhi(hw.w));
            const bf16x8 ah = __builtin_bit_cast(bf16x8, hw), al = __builtin_bit_cast(bf16x8, lw);
#pragma unroll
            for (int ct = 0; ct < 3; ++ct) {
                acc[ct] = __builtin_amdgcn_mfma_f32_16x16x32_bf16(ah, wBh[ks][ct], acc[ct], 0, 0, 0);
                acc[ct] = __builtin_amdgcn_mfma_f32_16x16x32_bf16(al, wBh[ks][ct], acc[ct], 0, 0, 0);
                acc[ct] = __builtin_amdgcn_mfma_f32_16x16x32_bf16(ah, wBl[ks][ct], acc[ct], 0, 0, 0); } }
#pragma unroll
        for (int ct = 0; ct < 3; ++ct)
#pragma unroll
            for (int rg = 0; rg < 4; ++rg) part[(w * 16 + 4 * q + rg) * 48 + 16 * ct + t16] = acc[ct][rg];
        __syncthreads();
        for (int i = tid; i < 16 * 36; i += NWAVES * 64) { const int tk = i / 36, o = i - tk * 36; float sum = (i < NWAVES * 64) ? rb0 : rb1;
#pragma unroll
            for (int ww = 0; ww < 8; ++ww) sum += part[(ww * 16 + tk) * 48 + o];
            lgs[(ti * 16 + tk) * 40 + o] = sum; }
    }
#undef LNR_LOAD
    __syncthreads();
    for (int sl_ = tid; sl_ < ti * 16; sl_ += NWAVES * 64) {
        const LAS float* sl = lgs + sl_ * 40;
        int gi = 0; float gm = sl[0];
        for (int o = 1; o < 4; ++o) if (sl[o] > gm) { gm = sl[o]; gi = o; }
        float gs = 0.f; for (int o = 0; o < 4; ++o) gs += __expf(sl[o] - gm);
        const float gprob = 1.f / gs;
        const LAS float* el = sl + 4 + gi * 8;
        int i0 = 0; float l0 = el[0];
        for (int o = 1; o < 8; ++o) if (el[o] > l0) { l0 = el[o]; i0 = o; }
        int i1 = -1; float l1 = -3.0e38f;
        for (int o = 0; o < 8; ++o) if (o != i0 && el[o] > l1) { l1 = el[o]; i1 = o; }
        const float e1 = __expf(l1 - l0), w0 = gprob / (1.f + e1), w1 = gprob * e1 / (1.f + e1);
        const int ex0 = gi * 8 + i0, ex1 = gi * 8 + i1;
        const int r0 = (int)__hip_atomic_fetch_add(lcnt + ex0, 1u, __ATOMIC_RELAXED, __HIP_MEMORY_SCOPE_WORKGROUP), r1 = (int)__hip_atomic_fetch_add(lcnt + ex1, 1u, __ATOMIC_RELAXED, __HIP_MEMORY_SCOPE_WORKGROUP);
        rtab[sl_ * 4 + 0] = (ex0 << 16) | r0; rtab[sl_ * 4 + 1] = (ex1 << 16) | r1; ((LAS float*)rtab)[sl_ * 4 + 2] = w0; ((LAS float*)rtab)[sl_ * 4 + 3] = w1;
    }
    __syncthreads();
    if (tid < 32) { const unsigned n = lcnt[tid]; lcnt[tid] = n ? (unsigned)atomicAdd(&cnt[tid * 64], (int)n) : 0u; }
    __syncthreads();
    for (int sl_ = tid; sl_ < ti * 16; sl_ += NWAVES * 64) {
        const int tok = 16 * (F.vcu + (sl_ >> 4) * F.G) + (sl_ & 15);
        const int a0 = rtab[sl_ * 4 + 0], a1 = rtab[sl_ * 4 + 1]; const float w0 = ((LAS float*)rtab)[sl_ * 4 + 2], w1 = ((LAS float*)rtab)[sl_ * 4 + 3];
        const int ex0 = a0 >> 16, ex1 = a1 >> 16, r0 = (a0 & 0xffff) + (int)lcnt[ex0], r1 = (a1 & 0xffff) + (int)lcnt[ex1];
        list[ex0 * NTOK + r0] = tok * 2; listw[ex0 * NTOK + r0] = w0;
        list[ex1 * NTOK + r1] = tok * 2 + 1; listw[ex1 * NTOK + r1] = w1;
    }
}

__device__ __forceinline__ void phase_final(Frame& F, const MArgs& a, const bf16_t* x1b, const bf16_t* po) {
    const float* g2 = a.in[18]; const float* b2 = a.in[19];
    const int gw = F.vcu * NWAVES + F.wave, NGW = F.G * NWAVES, lane = lane_id();
    f32x4 gg2[4], bb2[4];
#pragma unroll
    for (int j = 0; j < 4; ++j) { gg2[j] = *(const f32x4*)(g2 + lane * 4 + 256 * j); bb2[j] = *(const f32x4*)(b2 + lane * 4 + 256 * j); }
    pg8::u32x2 xn[2][4], pan[2][4], pbn[2][4];
#define FIN_LOAD(base_) do { _Pragma("unroll") for (int u = 0; u < 2; ++u) { const int tk = (base_) + u; \
        _Pragma("unroll") for (int j = 0; j < 4; ++j) { const int k0 = lane * 4 + 256 * j; xn[u][j] = *(const pg8::u32x2*)(x1b + (size_t)tk * DM + k0); \
            pan[u][j] = *(const pg8::u32x2*)(po + (size_t)tk * 2 * DM + k0); pbn[u][j] = *(const pg8::u32x2*)(po + (size_t)tk * 2 * DM + DM + k0); } } } while (0)
    FIN_LOAD(gw * 2);
    for (int base = gw * 2; base < NTOK; base += NGW * 2) {
        f32x4 v[2][4]; float s[2] = {0.f, 0.f};
#pragma unroll
        for (int u = 0; u < 2; ++u)
#pragma unroll
            for (int j = 0; j < 4; ++j) { f32x4 t;
                t[0] = ALPHA * pg8::bflo(xn[u][j].x) + (pg8::bflo(pan[u][j].x) + pg8::bflo(pbn[u][j].x)); t[1] = ALPHA * pg8::bfhi(xn[u][j].x) + (pg8::bfhi(pan[u][j].x) + pg8::bfhi(pbn[u][j].x));
                t[2] = ALPHA * pg8::bflo(xn[u][j].y) + (pg8::bflo(pan[u][j].y) + pg8::bflo(pbn[u][j].y)); t[3] = ALPHA * pg8::bfhi(xn[u][j].y) + (pg8::bfhi(pan[u][j].y) + pg8::bfhi(pbn[u][j].y));
                v[u][j] = t; s[u] += (t[0] + t[1]) + (t[2] + t[3]); }
        if (base + NGW * 2 < NTOK) FIN_LOAD(base + NGW * 2);
#pragma unroll
        for (int u = 0; u < 2; ++u) {
            const float mean = wave_sum(s[u]) * (1.f / DM); float s2 = 0.f;
#pragma unroll
            for (int j = 0; j < 4; ++j) { v[u][j] = v[u][j] - mean; s2 += (v[u][j][0] * v[u][j][0] + v[u][j][1] * v[u][j][1]) + (v[u][j][2] * v[u][j][2] + v[u][j][3] * v[u][j][3]); }
            const float rstd = 1.f / sqrtf(wave_sum(s2) * (1.f / DM) + LN_EPS);
            float* row = a.out + (size_t)(base + u) * DM;
#pragma unroll
            for (int j = 0; j < 4; ++j) { const int k0 = lane * 4 + 256 * j; *(f32x4*)(row + k0) = v[u][j] * rstd * gg2[j] + bb2[j]; }
        }
    }
#undef FIN_LOAD
}


struct PreWait { XcdBarrier b; bool on; __device__ __forceinline__ void operator()() const { if (on) xcd_wait(b); } };
__global__ void __launch_bounds__(NWAVES * 64, 2) mega(MArgs args) {
    extern __shared__ __attribute__((aligned(16))) unsigned char lds[];
    Frame F;
    F.lds = (LAS unsigned char*)lds;
    F.wave = __builtin_amdgcn_readfirstlane((int)(threadIdx.x >> 6));
    F.G = gridDim.x; { const int bx = blockIdx.x; F.vcu = (F.G % 8 == 0) ? (bx % 8) * (F.G / 8) + bx / 8 : bx; }
    unsigned char* ws = args.ws;
    gu32* ctl = (gu32*)(ws + WS_CTL);
    { int tid0 = (F.wave * 64 + lane_id()); asm volatile("" : "+v"(tid0)); for (int u = tid0; u < (LDS_BYTES - LDSCTL_OFF) / 4; u += NWAVES * 64) ((LAS unsigned*)(F.lds + LDSCTL_OFF))[u] = 0u; }
    __syncthreads();
    const int lo = args.ph_lo, hi = args.ph_hi;
    const bool multi = (hi - lo) > 1;
    XcdBarrier bar; bar.bar = (unsigned*)(ctl + CW_BAR); bar.x = 0; bar.st = nullptr; bar.w = (unsigned)F.wave;
    if (multi) bar = xcd_barrier_post((unsigned*)(ctl + CW_BAR), (volatile LAS unsigned*)(F.lds + MISC_OFF) + 8, (unsigned)F.wave);
    bf16_t* PROJ = (bf16_t*)(ws + WS_PROJ); bf16_t* MIXED = (bf16_t*)(ws + WS_MIXED); bf16_t* X1B = (bf16_t*)(ws + WS_X1B); bf16_t* XB = (bf16_t*)(ws + WS_XB);
    bf16_t* HID = (bf16_t*)(ws + WS_HID); bf16_t* PO = (bf16_t*)(ws + WS_PO); bf16_t* Y = (bf16_t*)(ws + WS_Z);
    bf16_t* AO = (bf16_t*)((unsigned char*)args.out + DO_AO); bf16_t* DIFF = (bf16_t*)((unsigned char*)args.out + DO_DIFF);
    bf16_t* AOG = (bf16_t*)((unsigned char*)args.out + DO_AOG); float* LSE = (float*)((unsigned char*)args.out + DO_LSE);
    int* cnt = (int*)(ws + WS_CTL) + CW_CNT; int* list = (int*)(ws + WS_LIST); float* listw = (float*)(ws + WS_LISTW);
#define PHASE_0 { p0_prologue_a(F, args); if (multi) xcd_arrive(bar); p0_prologue_b(F, args); if (multi) xcd_wait(bar); }
#define PHASE_1 { pg8::Gemm g{XB, (const bf16_t*)(ws + WT_WIN), DM, F.wave}; pg8::StaticOrder S; S.init(NTOK, GA_OFF, F.G, (int)blockIdx.x);     \
        pg8::EpiProj E{PROJ, args.in[2], QSCALE}; pg8::gemm_phase<pg8::EpiProj, pg8::StaticOrder, true>(F.lds + RING_OFF, g, S, E); \
        if (multi) xcd_arrive(bar);                                     \
          \
        { const int bx = (int)blockIdx.x; if (F.G == 256) { if (bx >= 128) tr_run(F, args, TR_DENSE + ((bx - 128) * NWAVES + F.wave), 1024, TR_DENSE + 10240); \
              else tr_run(F, args, TR_DENSE + 10240 + (bx * NWAVES + F.wave), 1024, TR_DENSE + TR_EXP); } \
          else tr_run(F, args, TR_DENSE + F.vcu * NWAVES + F.wave, F.G * NWAVES, TR_DENSE + TR_EXP); } \
        if (multi) xcd_wait(bar); }
#define PHASE_2 { phase_attn(F, args, PROJ, AOG, LSE); if (multi) xcd_arrive(bar); }
#define PHASE_3 { phase_pool(F, PROJ, DIFF); if (multi) xcd_wait(bar); phase_combine(F, AOG, LSE, AO); if (multi) xcd_arrive(bar); }
#define PHASE_4 { pg8::GemmGM g{XB, (const bf16_t*)(ws + WT_WIN), AO, (const bf16_t*)(ws + WT_WPA), DIFF, (const bf16_t*)(ws + WT_WEFF), args.in[2], MIXED, F.wave}; \
        pg8::StaticOrder S; S.init(NTOK, 2 * DM, F.G, (int)blockIdx.x);     \
        PreWait pre{bar, multi}; pg8::gemm_phase_gm<pg8::StaticOrder>(F.lds + RING_OFF, g, S, pre); }
#define PHASE_5 { }
#define PHASE_6 { pg8::Gemm g{MIXED, (const bf16_t*)(ws + WT_WOUT), DM, F.wave}; pg8::StaticOrder S; S.init(NTOK, DM, F.G, (int)blockIdx.x); \
        pg8::EpiY E{Y}; pg8::gemm_phase<pg8::EpiY, pg8::StaticOrder, true>(F.lds + RING_OFF, g, S, E); if (multi) xcd_arrive(bar); }
#define PHASE_7 { PreWait pre{bar, multi}; phase_ln_router(F, args, Y, X1B, cnt, list, listw, pre); }
#define PHASE_8 { const int ntiles = moe_tables(F, cnt); { pg8::Gemm g{X1B, (const bf16_t*)(ws + WT_WGU), DM, F.wave}; \
        pg8::MoeOrder S{(const LAS int*)(F.lds + TILE_E_OFF), (const LAS int*)(F.lds + FIRST_OFF), cnt, list, 2, F.G, F.vcu, ntiles, true, (unsigned*)(ctl + CW_READY)}; \
        pg8::EpiMoe1 E{HID, cnt, listw}; pg8::gemm_phase<pg8::EpiMoe1, pg8::MoeOrder, true>(F.lds + RING_OFF, g, S, E); } \
          \
        { pg8::Gemm g{HID, (const bf16_t*)(ws + WT_WD), DEXP, F.wave}; \
        pg8::DynMoeOrder S{(const LAS int*)(F.lds + TILE_E_OFF), (const LAS int*)(F.lds + FIRST_OFF), 4, ntiles, (unsigned*)(ctl + CW_Q9), (const unsigned*)(ctl + CW_READY), 16u, (unsigned*)(ctl + CW_TMO), (volatile LAS int*)(F.lds + MISC_OFF + 64), F.wave}; \
        pg8::EpiMoe2 E{PO, cnt, list}; pg8::gemm_phase<pg8::EpiMoe2, pg8::DynMoeOrder, true>(F.lds + RING_OFF, g, S, E); } }
#define PHASE_9 { }
#define PHASE_10 phase_final(F, args, X1B, PO);
#define IN(k) (lo <= (k) && (k) < hi)
#define SEAM(k) do { if (IN(k) && (k) + 1 < hi) xcd_barrier(bar); } while (0)
#define RUN(k, BODY) do { if (IN(k)) { BODY SEAM(k); } } while (0)
    if (IN(0)) PHASE_0
    if (IN(1)) PHASE_1
    if (IN(2)) PHASE_2
    if (IN(3)) PHASE_3
    RUN(4, PHASE_4);
    if (IN(6)) PHASE_6
    RUN(7, PHASE_7);
    RUN(8, PHASE_8);
    RUN(10, PHASE_10);
#undef IN
#undef SEAM
#undef RUN
}

#ifndef SINGLE_LAUNCH
#define SINGLE_LAUNCH 1
#endif
constexpr int NPHASES = 11;
#ifndef DUP_MASK
#define DUP_MASK 0
#endif
extern "C" void kernel_launch(void* const* d_in, const int* in_sizes, int n_in, void* d_out, int out_size, void* d_ws, size_t ws_size, hipStream_t stream) {
    static int grid = 0;
    if (grid == 0) {
        if (n_in != 20 || in_sizes[0] != NTOK * DM || out_size != NTOK * DM || ws_size < WS_END) {
            fprintf(stderr, "kernel_launch: unexpected shapes (n_in %d, in0 %d, out %d, ws %zu)\n", n_in, n_in > 0 ? in_sizes[0] : -1, out_size, ws_size); grid = -1; return; }
        int dev = 0, cus = 0, per_cu = 0;
        if (hipGetDevice(&dev) != hipSuccess || hipDeviceGetAttribute(&cus, hipDeviceAttributeMultiprocessorCount, dev) != hipSuccess) { grid = -1; return; }
        if (hipFuncSetAttribute((const void*)mega, hipFuncAttributeMaxDynamicSharedMemorySize, LDS_BYTES) != hipSuccess) { fprintf(stderr, "kernel_launch: hipFuncSetAttribute failed\n"); grid = -1; return; }
        if (hipOccupancyMaxActiveBlocksPerMultiprocessor(&per_cu, (const void*)mega, NWAVES * 64, LDS_BYTES) != hipSuccess || per_cu < 1) {
            fprintf(stderr, "kernel_launch: occupancy query reports %d workgroups per CU\n", per_cu); (void)hipGetLastError(); grid = -1; return; }
        if (cus != 256) { fprintf(stderr, "kernel_launch: built for a 256-CU device (LDS tables of the LN/router phase are sized for 8 token tiles per workgroup); found %d CUs\n", cus); grid = -1; return; }
        grid = cus;
    }
    if (grid < 0) return;
    (void)hipMemsetAsync((unsigned char*)d_ws + WS_CTL, 0, CTL_ZERO_BYTES, stream);
    MArgs a{};
    for (int i = 0; i < 20; ++i) a.in[i] = (const float*)d_in[i];
    a.out = (float*)d_out; a.ws = (unsigned char*)d_ws;
    if (SINGLE_LAUNCH) { a.ph_lo = 0; a.ph_hi = NPHASES; hipLaunchKernelGGL(mega, dim3(grid), dim3(NWAVES * 64), LDS_BYTES, stream, a); return; }
    for (int p = 0; p < NPHASES; ++p) { a.ph_lo = p; a.ph_hi = p + 1;
        for (int rep = 0; rep < 1 + ((DUP_MASK >> p) & 1); ++rep) { if (rep && p == 7) (void)hipMemsetAsync((unsigned char*)d_ws + WS_CTL, 0, 8192, stream); hipLaunchKernelGGL(mega, dim3(grid), dim3(NWAVES * 64), LDS_BYTES, stream, a); } }
}
```

```cpp
#define SINGLE_LAUNCH 1
#include <hip/hip_runtime.h>
#include <cstdint>
#include <cstdio>

typedef unsigned short bf16_t;
typedef short bf16x8 __attribute__((ext_vector_type(8)));
typedef float f32x4 __attribute__((ext_vector_type(4)));

constexpr int BATCH = 16, SEQ = 2048, DM = 1024, NTOK = BATCH * SEQ;
constexpr int HD = 64, ATTW = 768, AOW = 256, POOLW = 512, INW = 4864;
constexpr int Q_OFF = 0, K_OFF = 768, V_OFF = 1536, POOL_OFF = 2304, GA_OFF = 2816, GB_OFF = 3840;
constexpr int NEXP = 32, DEXP = 256, NGRP = 4, EPG = 8;
constexpr float LN_EPS = 1e-5f;
constexpr float ALPHA = 1.189207115002721f;
constexpr int MAXROWS = 65536 + NEXP * 256;

constexpr size_t MiB = 1u << 20;
constexpr size_t WS_PROJ = 0;
constexpr size_t WS_PO = 0;
constexpr size_t WS_HID = 130 * MiB;
constexpr size_t WS_Z = 166 * MiB;
constexpr size_t WS_MIXED = 304 * MiB;
constexpr size_t WS_X1B = 368 * MiB;
constexpr size_t WS_WT = 432 * MiB;
constexpr size_t WS_CTL = 500 * MiB;
constexpr size_t WS_LIST = 501 * MiB;
constexpr size_t WS_LISTW = 505 * MiB;
constexpr size_t WS_TINFO = 509 * MiB;
constexpr size_t WS_END = 512 * MiB;
constexpr size_t DO_AO = 0, DO_DIFF = 16 * MiB, DO_AOG = 48 * MiB, DO_LSE = 96 * MiB;

__device__ __forceinline__ int lane_id() { int l; asm volatile("v_mbcnt_lo_u32_b32 %0, -1, 0\n\tv_mbcnt_hi_u32_b32 %0, -1, %0" : "=v"(l)); return l; }
__device__ __forceinline__ bf16_t f2bf(float f) { unsigned u = __float_as_uint(f); return (bf16_t)((u + 0x7fffu + ((u >> 16) & 1u)) >> 16); }
__device__ __forceinline__ float bf2f(bf16_t h) { return __uint_as_float(((unsigned)h) << 16); }
__device__ __forceinline__ bf16_t cvt_in(float v) { return f2bf(v); }
__device__ __forceinline__ bf16_t cvt_in(bf16_t v) { return v; }
__device__ __forceinline__ float sigmoidf_(float v) { return 1.f / (1.f + __expf(-v)); }
#define DPP_ADD(v, CTRL) ((v) + __builtin_bit_cast(float, __builtin_amdgcn_update_dpp(0, __builtin_bit_cast(int, (v)), (CTRL), 0xf, 0xf, true)))
__device__ __forceinline__ float wave_sum(float v) {
    v = DPP_ADD(v, 0xB1);
    v = DPP_ADD(v, 0x4E);
    v = DPP_ADD(v, 0x141);
    v = DPP_ADD(v, 0x140);
    const int iv = __builtin_bit_cast(int, v);
    return (__builtin_bit_cast(float, __builtin_amdgcn_readlane(iv, 0)) + __builtin_bit_cast(float, __builtin_amdgcn_readlane(iv, 16)))
         + (__builtin_bit_cast(float, __builtin_amdgcn_readlane(iv, 32)) + __builtin_bit_cast(float, __builtin_amdgcn_readlane(iv, 48)));
}
__device__ __forceinline__ float wave_max(float v) {
#pragma unroll
    for (int o = 1; o < 64; o <<= 1) v = fmaxf(v, __shfl_xor(v, o));
    return v;
}

__device__ __forceinline__ int t5_bucket(int dist) {
    if (dist < 16) return dist;
    const float d = (float)dist;
    int large = 16 + (int)(logf(d / 16.0f) / logf(128.0f) * 16.0f);
    return large < 31 ? large : 31;
}


namespace pg8 {
#define PG8_LAS __attribute__((address_space(3)))
typedef unsigned u32x4 __attribute__((ext_vector_type(4)));
typedef unsigned u32x2 __attribute__((ext_vector_type(2)));
constexpr int BM = 256, BK = 64, HALF = 128, HTB = HALF * BK * 2  , STAGE_BYTES = 8 * HTB, NXCD = 8, WGM = 8;

__host__ __device__ __forceinline__ int lds_byte(int r, int c) { const int st = (r >> 4) * 2 + (c >> 5), rr = r & 15, cc = c & 31, ob = rr * 64 + cc * 2; return st * 1024 + (ob ^ (((ob >> 9) & 1) << 5)); }
__host__ __device__ __forceinline__ void stage_rc(int b, int& R, int& C) { const int st = b / 1024, sb = b % 1024, swz = sb ^ (((sb >> 9) & 1) << 5); R = (st >> 1) * 16 + swz / 64; C = (st & 1) * 32 + (swz % 64) / 2; }
__host__ __device__ __forceinline__ int perm32(int rho) { const int n = rho >> 4, i = rho & 15; return 8 * (i >> 2) + 4 * n + (i & 3); }

struct Unit { int pm, pn, e, rt; };
struct Gemm { const bf16_t* A; const bf16_t* Bt; int K; int wave; };

struct StaticOrder {
    int nM, nN, nwg, G, c;
    __device__ void init(int M, int N, int G_, int c_) { nM = M / BM; nN = N / BM; nwg = nM * nN; G = G_; c = c_; }
    __device__ bool next(int i, Unit& u) const {
        const long L = (long)i * G + c; if (L >= nwg) return false;
        int wgid = (int)L; { const int q = nwg / NXCD, r = nwg % NXCD, xcd = wgid % NXCD, off = wgid / NXCD; wgid = (xcd < r ? xcd * (q + 1) : r * (q + 1) + (xcd - r) * q) + off; }
        const int nig = WGM * nN, gid = wgid / nig, fm = gid * WGM, gsz = (nM - fm) < WGM ? (nM - fm) : WGM;
        u.pm = fm + ((wgid % nig) % gsz); u.pn = (wgid % nig) / gsz; u.e = 0; u.rt = 0; return true;
    }
    __device__ __forceinline__ int arow(const Unit& u, int r) const { return u.pm * BM + r; }
    __device__ __forceinline__ void done(const Unit&) const {}
};

struct MoeOrder {
    const PG8_LAS int* tile_e; const PG8_LAS int* first; const int* cnt; const int* list; int nN, G, c, ntiles; bool gather; unsigned* ready;
    __device__ bool next(int i, Unit& u) const {
        const int L = i * G + c; if (L >= ntiles * nN) return false;
        const int rt = L / nN, pn = L - rt * nN, e = tile_e[rt];
        u.pm = rt; u.pn = e * nN + pn; u.e = e; u.rt = rt - first[e]; return true;
    }
    __device__ __forceinline__ int arow(const Unit& u, int r) const {
        if (!gather) return u.pm * BM + r;
        const int idx = u.rt * BM + r; return idx < cnt[u.e * 64] ? (list[u.e * NTOK + idx] >> 1) : 0;
    }
    __device__ __forceinline__ void done(const Unit& u) const {
        asm volatile("s_waitcnt vmcnt(0)" ::: "memory");
        if (lane_id() == 0) __hip_atomic_fetch_add(ready + 64 * u.pm, 1u, __ATOMIC_RELAXED, __HIP_MEMORY_SCOPE_AGENT);
    }
};
struct DynMoeOrder {
    const PG8_LAS int* tile_e; const PG8_LAS int* first; int nN, ntiles; unsigned* queue; const unsigned* ready; unsigned need; unsigned* tmo; volatile PG8_LAS int* slot; int wave;
    __device__ bool next(int i, Unit& u) const {
        if (wave == 0) {
            int L = 0; if (lane_id() == 0) L = (int)__hip_atomic_fetch_add(queue, 1u, __ATOMIC_RELAXED, __HIP_MEMORY_SCOPE_AGENT);
            L = __builtin_amdgcn_readfirstlane(L);
            if (L < ntiles * nN) {
                const int rt = L / nN; unsigned spins = 0;
                while ((unsigned)__builtin_amdgcn_readfirstlane(__hip_atomic_load(ready + 64 * rt, __ATOMIC_RELAXED, __HIP_MEMORY_SCOPE_AGENT)) < need) {
                    __builtin_amdgcn_s_sleep(2);
                    if (++spins > (1u << 20)) { if (lane_id() == 0) __hip_atomic_store(tmo, 1u, __ATOMIC_RELAXED, __HIP_MEMORY_SCOPE_AGENT); break; } }
                __builtin_amdgcn_fence(__ATOMIC_ACQUIRE, "agent");
                asm volatile("s_waitcnt vmcnt(0)" ::: "memory");
            } else L = -1;
            if (lane_id() == 0) slot[i & 1] = L;
            asm volatile("s_waitcnt lgkmcnt(0)" ::: "memory");
        }
        __builtin_amdgcn_s_barrier(); asm volatile("" ::: "memory");
        const int L = slot[i & 1]; if (L < 0) return false;
        const int rt = L / nN, pn = L - rt * nN, e = tile_e[rt];
        u.pm = rt; u.pn = e * nN + pn; u.e = e; u.rt = rt - first[e]; return true;
    }
    __device__ __forceinline__ int arow(const Unit& u, int r) const { return u.pm * BM + r; }
    __device__ __forceinline__ void done(const Unit&) const {}
};

__device__ __forceinline__ unsigned cvt_pk_bf16(float lo, float hi) { unsigned r; asm volatile("v_cvt_pk_bf16_f32 %0, %1, %2" : "=v"(r) : "v"(lo), "v"(hi)); return r; }
__device__ __forceinline__ float bflo(unsigned w) { return __uint_as_float(w << 16); }
__device__ __forceinline__ float bfhi(unsigned w) { return __uint_as_float(w & 0xffff0000u); }
__device__ __forceinline__ float fsig(float v) { return __builtin_amdgcn_rcpf(1.f + __builtin_amdgcn_exp2f(-1.4426950408889634f * v)); }
__device__ __forceinline__ float fsig_gate(float v) { return fmaxf(fsig(v), 1.0e-7f); }

struct EpiProj {
    static constexpr bool PERM = true;
    bf16_t* O; const float* bias; float qscale;
    __device__ __forceinline__ void operator()(const f32x4 (&acc)[2][2][4][2], const Unit& u, int wr, int wc, int fr, int fq) const {
        const int row0 = u.pm * BM + wr * 64 + fr, lc0 = wc * 32 + 8 * fq;
        const bool gate = u.pn >= 11;
        const int lg = (u.pn < 9) ? 2 * (u.pn % 3) : 0;
        const int cb0 = gate ? GA_OFF + (u.pn - 11) * HALF + lc0 : u.pn * BM + lc0, cb1 = gate ? GB_OFF + (u.pn - 11) * HALF + lc0 : u.pn * BM + HALF + lc0;
        f32x4 bv[2][2];
#pragma unroll
        for (int n = 0; n < 2; ++n) { bv[0][n] = *(const f32x4*)(bias + cb0 + 4 * n); bv[1][n] = *(const f32x4*)(bias + cb1 + 4 * n); }
#pragma unroll
        for (int ai = 0; ai < 2; ++ai)
#pragma unroll
            for (int m = 0; m < 4; ++m) { const int rg = row0 + ai * HALF + m * 16, t = rg & (SEQ - 1), prow = (rg & ~(SEQ - 1)) + ((t & ((1 << lg) - 1)) << (11 - lg)) + (t >> lg);
                bf16_t* rowp = O + (size_t)prow * INW;
                f32x4 a0 = acc[ai][0][m][0] + bv[0][0], a1 = acc[ai][0][m][1] + bv[0][1], b0 = acc[ai][1][m][0] + bv[1][0], b1 = acc[ai][1][m][1] + bv[1][1];
                if (u.pn < 3) { a0 = a0 * qscale; a1 = a1 * qscale; b0 = b0 * qscale; b1 = b1 * qscale; }
                if (gate) {
#pragma unroll
                    for (int i = 0; i < 4; ++i) { const float s0 = fsig_gate(b0[i]), s1 = fsig_gate(b1[i]); a0[i] = fsig(a0[i]) * __builtin_amdgcn_rcpf(s0); a1[i] = fsig(a1[i]) * __builtin_amdgcn_rcpf(s1); b0[i] = s0; b1[i] = s1; } }
                u32x4 w; w.x = cvt_pk_bf16(a0[0], a0[1]); w.y = cvt_pk_bf16(a0[2], a0[3]); w.z = cvt_pk_bf16(a1[0], a1[1]); w.w = cvt_pk_bf16(a1[2], a1[3]);
                *(u32x4*)(rowp + cb0) = w;
                w.x = cvt_pk_bf16(b0[0], b0[1]); w.y = cvt_pk_bf16(b0[2], b0[3]); w.z = cvt_pk_bf16(b1[0], b1[1]); w.w = cvt_pk_bf16(b1[2], b1[3]);
                *(u32x4*)(rowp + cb1) = w; }
    }
};
template <bool ACCUM> struct EpiGate {
    static constexpr bool PERM = true;
    bf16_t* O; const bf16_t* gate;
    __device__ __forceinline__ void operator()(const f32x4 (&acc)[2][2][4][2], const Unit& u, int wr, int wc, int fr, int fq) const {
        const int row0 = u.pm * BM + wr * 64 + fr, col0 = u.pn * BM + wc * 32 + 8 * fq;
#pragma unroll
        for (int ai = 0; ai < 2; ++ai)
#pragma unroll
            for (int m = 0; m < 4; ++m) { const size_t r = (size_t)(row0 + ai * HALF + m * 16);
#pragma unroll
                for (int bj = 0; bj < 2; ++bj) {
                    const u32x4 gw = *(const u32x4*)(gate + r * INW + col0 + bj * HALF);
                    bf16_t* op = O + r * DM + col0 + bj * HALF;
                    f32x4 v0 = acc[ai][bj][m][0], v1 = acc[ai][bj][m][1];
                    v0[0] *= bflo(gw.x); v0[1] *= bfhi(gw.x); v0[2] *= bflo(gw.y); v0[3] *= bfhi(gw.y);
                    v1[0] *= bflo(gw.z); v1[1] *= bfhi(gw.z); v1[2] *= bflo(gw.w); v1[3] *= bfhi(gw.w);
                    if (ACCUM) { const u32x4 ow = *(const u32x4*)op;
                        v0[0] += bflo(ow.x); v0[1] += bfhi(ow.x); v0[2] += bflo(ow.y); v0[3] += bfhi(ow.y);
                        v1[0] += bflo(ow.z); v1[1] += bfhi(ow.z); v1[2] += bflo(ow.w); v1[3] += bfhi(ow.w); }
                    u32x4 w; w.x = cvt_pk_bf16(v0[0], v0[1]); w.y = cvt_pk_bf16(v0[2], v0[3]); w.z = cvt_pk_bf16(v1[0], v1[1]); w.w = cvt_pk_bf16(v1[2], v1[3]);
                    *(u32x4*)op = w; } }
    }
};
struct EpiMix {
    static constexpr bool PERM = true;
    bf16_t* O; const bf16_t* ga; const bf16_t* gb;
    __device__ __forceinline__ void mid(f32x4 (&acc)[2][2][4][2], const Unit& u, int wr, int wc, int fr, int fq) const {
        int row0 = u.pm * BM + wr * 64 + fr, col0 = u.pn * BM + wc * 32 + 8 * fq;
        asm volatile("" : "+v"(row0), "+v"(col0));
#pragma unroll
        for (int ai = 0; ai < 2; ++ai)
#pragma unroll
            for (int m = 0; m < 4; ++m) { const size_t r = (size_t)(row0 + ai * HALF + m * 16);
#pragma unroll
                for (int bj = 0; bj < 2; ++bj) {
                    const u32x4 a = *(const u32x4*)(ga + r * INW + col0 + bj * HALF);
                    f32x4& v0 = acc[ai][bj][m][0]; f32x4& v1 = acc[ai][bj][m][1];
                    v0[0] *= bflo(a.x); v0[1] *= bfhi(a.x); v0[2] *= bflo(a.y); v0[3] *= bfhi(a.y);
                    v1[0] *= bflo(a.z); v1[1] *= bfhi(a.z); v1[2] *= bflo(a.w); v1[3] *= bfhi(a.w); }
                if (m == 3) asm volatile("" ::: "memory"); }
    }
    __device__ __forceinline__ void operator()(const f32x4 (&acc)[2][2][4][2], const Unit& u, int wr, int wc, int fr, int fq) const {
        const int row0 = u.pm * BM + wr * 64 + fr, col0 = u.pn * BM + wc * 32 + 8 * fq;
#pragma unroll
        for (int ai = 0; ai < 2; ++ai)
#pragma unroll
            for (int m = 0; m < 4; ++m) { const size_t r = (size_t)(row0 + ai * HALF + m * 16);
#pragma unroll
                for (int bj = 0; bj < 2; ++bj) {
                    const u32x4 b = *(const u32x4*)(gb + r * INW + col0 + bj * HALF);
                    const f32x4 v0 = acc[ai][bj][m][0], v1 = acc[ai][bj][m][1];
                    u32x4 w; w.x = cvt_pk_bf16(v0[0] * bflo(b.x), v0[1] * bfhi(b.x)); w.y = cvt_pk_bf16(v0[2] * bflo(b.y), v0[3] * bfhi(b.y));
                    w.z = cvt_pk_bf16(v1[0] * bflo(b.z), v1[1] * bfhi(b.z)); w.w = cvt_pk_bf16(v1[2] * bflo(b.w), v1[3] * bfhi(b.w));
                    *(u32x4*)(O + r * DM + col0 + bj * HALF) = w; }
                if (m == 3) asm volatile("" ::: "memory"); }
    }
};
struct EpiY {
    static constexpr bool PERM = true;
    bf16_t* Y;
    __device__ __forceinline__ void operator()(const f32x4 (&acc)[2][2][4][2], const Unit& u, int wr, int wc, int fr, int fq) const {
        const int col0 = u.pn * BM + wc * 32 + 8 * fq;
#pragma unroll
        for (int ai = 0; ai < 2; ++ai)
#pragma unroll
            for (int m = 0; m < 4; ++m) { bf16_t* rowp = Y + (size_t)(u.pm * BM + ai * HALF + wr * 64 + m * 16 + fr) * DM + col0;
#pragma unroll
                for (int bj = 0; bj < 2; ++bj) { const f32x4 v0 = acc[ai][bj][m][0], v1 = acc[ai][bj][m][1];
                    u32x4 w; w.x = cvt_pk_bf16(v0[0], v0[1]); w.y = cvt_pk_bf16(v0[2], v0[3]); w.z = cvt_pk_bf16(v1[0], v1[1]); w.w = cvt_pk_bf16(v1[2], v1[3]);
                    *(u32x4*)(rowp + bj * HALF) = w; } }
    }
};
struct EpiMoe1 {
    static constexpr bool PERM = true;
    bf16_t* hid; const int* cnt; const float* listw;
    __device__ __forceinline__ void operator()(const f32x4 (&acc)[2][2][4][2], const Unit& u, int wr, int wc, int fr, int fq) const {
        const int n_e = cnt[u.e * 64], pnl = u.pn & 1, hc0 = pnl * 128 + wc * 32 + 8 * fq;
        const __amdgpu_buffer_rsrc_t rs = __builtin_amdgcn_make_buffer_rsrc(hid, 0, MAXROWS * DEXP * 2, 0x00020000);
#pragma unroll
        for (int ai = 0; ai < 2; ++ai)
#pragma unroll
            for (int m = 0; m < 4; ++m) { const int r = ai * HALF + wr * 64 + m * 16 + fr, idx = u.rt * BM + r;
                const float w = idx < n_e ? listw[u.e * NTOK + idx] : 0.f;
                float h[8];
#pragma unroll
                for (int n = 0; n < 2; ++n)
#pragma unroll
                    for (int i = 0; i < 4; ++i) { const float g = acc[ai][0][m][n][i], uu = acc[ai][1][m][n][i]; h[n * 4 + i] = w * g * fsig(g) * uu; }
                u32x4 o; o.x = cvt_pk_bf16(h[0], h[1]); o.y = cvt_pk_bf16(h[2], h[3]); o.z = cvt_pk_bf16(h[4], h[5]); o.w = cvt_pk_bf16(h[6], h[7]);
                __builtin_amdgcn_raw_buffer_store_b128(o, rs, (unsigned)(((u.pm * BM + r) * DEXP + hc0) * 2), 0,   16); }
    }
};
struct EpiMoe2 {
    static constexpr bool PERM = true;
    bf16_t* po; const int* cnt; const int* list;
    __device__ __forceinline__ void operator()(const f32x4 (&acc)[2][2][4][2], const Unit& u, int wr, int wc, int fr, int fq) const {
        const int col0 = (u.pn & 3) * BM + wc * 32 + 8 * fq, n_e = cnt[u.e * 64];
#pragma unroll
        for (int ai = 0; ai < 2; ++ai)
#pragma unroll
            for (int m = 0; m < 4; ++m) { const int r = ai * HALF + wr * 64 + m * 16 + fr, idx = u.rt * BM + r;
                const int drow = idx < n_e ? list[u.e * NTOK + idx] : 2 * NTOK + r;
                bf16_t* rowp = po + (size_t)drow * DM + col0;
#pragma unroll
                for (int bj = 0; bj < 2; ++bj) { const f32x4 v0 = acc[ai][bj][m][0], v1 = acc[ai][bj][m][1];
                    u32x4 w; w.x = cvt_pk_bf16(v0[0], v0[1]); w.y = cvt_pk_bf16(v0[2], v0[3]); w.z = cvt_pk_bf16(v1[0], v1[1]); w.w = cvt_pk_bf16(v1[2], v1[3]);
                    *(u32x4*)(rowp + bj * HALF) = w; } }
    }
};

template <class Epi, class Sched, bool ALIGN_EPI>
__device__ __forceinline__ void gemm_phase(PG8_LAS unsigned char* lds, const Gemm g, const Sched& S, const Epi& E) {
    const int wid = g.wave, lane = lane_id(), tid = wid * 64 + lane, wr = wid >> 2, wc = wid & 3, fr = lane & 15, fq = lane >> 4;
    const int K = g.K, nt = K / BK;
    int RA[2]; unsigned CA[2], voffB[2];
#pragma unroll
    for (int i = 0; i < 2; ++i) { int R, C; stage_rc(tid * 16 + i * 8192, R, C); const int Rb = Epi::PERM ? ((R & ~31) + perm32(R & 31)) : R;
        RA[i] = R; CA[i] = (unsigned)C * 2u; voffB[i] = (unsigned)(Rb * K + C) * 2u; }
    const size_t kstep = (size_t)(BK * 2);
    const size_t hstep = (size_t)HALF * K * 2;
    const size_t tstep = 2 * hstep;
    const unsigned ldsw = (unsigned)wid * 1024u;
    const int aoff = lds_byte(wr * 64 + fr, fq * 8), boff = lds_byte(wc * 32 + fr, fq * 8);
#define PG8_SA(b, h) (((b) * 2 + (h)) * HTB)
#define PG8_SB(b, h) ((4 + (b) * 2 + (h)) * HTB)
#define PG8_STAGE(bufoff, gbase, voff) do { _Pragma("unroll") for (int _i = 0; _i < 2; ++_i) \
        __builtin_amdgcn_global_load_lds((const unsigned*)((const char*)(gbase) + (voff)[_i]), (PG8_LAS unsigned*)(lds + (bufoff) + ldsw + _i * 8192), 16, 0, 0); } while (0)
#define PG8_LDA(dst, b, h) do { _Pragma("unroll") for (int m = 0; m < 4; ++m) _Pragma("unroll") for (int k = 0; k < 2; ++k) dst[m][k] = *(const PG8_LAS bf16x8*)(lds + PG8_SA(b, h) + aoff + m * 2048 + k * 1024); } while (0)
#define PG8_LDB(dst, b, h) do { _Pragma("unroll") for (int n = 0; n < 2; ++n) _Pragma("unroll") for (int k = 0; k < 2; ++k) dst[n][k] = *(const PG8_LAS bf16x8*)(lds + PG8_SB(b, h) + boff + n * 2048 + k * 1024); } while (0)
#define PG8_MMA(ai, bj, At, Bt) do { __builtin_amdgcn_s_setprio(1); _Pragma("unroll") for (int m = 0; m < 4; ++m) _Pragma("unroll") for (int n = 0; n < 2; ++n) _Pragma("unroll") for (int k = 0; k < 2; ++k) \
        acc[ai][bj][m][n] = __builtin_amdgcn_mfma_f32_16x16x32_bf16(Bt[n][k], At[m][k], acc[ai][bj][m][n], 0, 0, 0); __builtin_amdgcn_s_setprio(0); } while (0)
#define PG8_WAIT_V(n) asm volatile("s_waitcnt vmcnt(" #n ")" ::: "memory")
#define PG8_WAIT_L(n) asm volatile("s_waitcnt lgkmcnt(" #n ")" ::: "memory")
#define PG8_BAR __builtin_amdgcn_s_barrier()
#define PG8_SCHED __builtin_amdgcn_sched_barrier(0)
#define PG8_AOFF(dst, U) do { _Pragma("unroll") for (int _h = 0; _h < 2; ++_h) _Pragma("unroll") for (int _i = 0; _i < 2; ++_i) \
        dst[_h][_i] = (unsigned)S.arow(U, _h * HALF + RA[_i]) * (unsigned)(K * 2) + CA[_i]; } while (0)
    Unit cur, nxt; int ui = 0;
    if (!S.next(0, cur)) return;
    f32x4 acc[2][2][4][2];
#pragma unroll
    for (int a = 0; a < 2; ++a)
#pragma unroll
        for (int b = 0; b < 2; ++b)
#pragma unroll
            for (int m = 0; m < 4; ++m)
#pragma unroll
                for (int n = 0; n < 2; ++n) acc[a][b][m][n] = (f32x4){0.f, 0.f, 0.f, 0.f};
    bf16x8 At[4][2], B0[2][2], B1[2][2];
    unsigned offC[2][2], offN[2][2];
    PG8_AOFF(offC, cur);
    const char* A0 = (const char*)g.A;
    const char* cB = (const char*)g.Bt + (size_t)cur.pn * tstep;
    PG8_STAGE(PG8_SB(0, 0), cB, voffB); PG8_STAGE(PG8_SB(0, 1), cB + hstep, voffB); PG8_STAGE(PG8_SA(0, 0), A0, offC[0]); PG8_STAGE(PG8_SA(0, 1), A0, offC[1]);
    if (wr == 1) PG8_BAR;
    PG8_WAIT_V(2); PG8_BAR;
    PG8_STAGE(PG8_SB(1, 0), cB + kstep, voffB); PG8_STAGE(PG8_SA(1, 0), A0 + kstep, offC[0]); PG8_STAGE(PG8_SB(1, 1), cB + hstep + kstep, voffB);
    PG8_WAIT_V(6); PG8_BAR;
    for (;;) {
        const bool has_next = S.next(ui + 1, nxt);
        if (has_next) PG8_AOFF(offN, nxt);
        const char* nB = has_next ? (const char*)g.Bt + (size_t)nxt.pn * tstep : cB;
#pragma unroll 1
        for (int t = 0; t < nt; t += 2) {
            const bool last = (t == nt - 2);
            const char* a1 = A0 + (size_t)(t + 1) * kstep;
            const char* a2 = last ? A0 : A0 + (size_t)(t + 2) * kstep; const char* b2 = last ? nB : cB + (size_t)(t + 2) * kstep;
            const char* a3 = a2 + kstep; const char* b3 = b2 + kstep;
            PG8_LDB(B0, 0, 0); PG8_LDB(B1, 0, 1); PG8_SCHED; PG8_LDA(At, 0, 0); PG8_STAGE(PG8_SA(1, 1), a1, offC[1]);
            if (last && has_next) {
#pragma unroll
                for (int _h = 0; _h < 2; ++_h)
#pragma unroll
                    for (int _i = 0; _i < 2; ++_i) offC[_h][_i] = offN[_h][_i];
            }
            PG8_WAIT_V(8); PG8_WAIT_L(0); PG8_BAR; PG8_MMA(0, 0, At, B0); PG8_MMA(0, 1, At, B1); PG8_BAR; PG8_SCHED;
            PG8_LDA(At, 0, 1); PG8_STAGE(PG8_SB(0, 0), b2, voffB); PG8_STAGE(PG8_SB(0, 1), b2 + hstep, voffB); PG8_STAGE(PG8_SA(0, 0), a2, offC[0]);
            PG8_WAIT_V(8); PG8_WAIT_L(0); PG8_BAR; PG8_MMA(1, 0, At, B0); PG8_MMA(1, 1, At, B1); PG8_BAR; PG8_SCHED;
            PG8_LDB(B0, 1, 0); PG8_LDB(B1, 1, 1); PG8_SCHED; PG8_LDA(At, 1, 0); PG8_STAGE(PG8_SA(0, 1), a2, offC[1]);
            PG8_WAIT_V(8); PG8_WAIT_L(0); PG8_BAR; PG8_MMA(0, 0, At, B0); PG8_MMA(0, 1, At, B1); PG8_BAR; PG8_SCHED;
            PG8_LDA(At, 1, 1); PG8_STAGE(PG8_SB(1, 0), b3, voffB); PG8_STAGE(PG8_SB(1, 1), b3 + hstep, voffB); PG8_STAGE(PG8_SA(1, 0), a3, offC[0]);
            PG8_WAIT_V(8); PG8_WAIT_L(0); PG8_BAR; PG8_MMA(1, 0, At, B0); PG8_MMA(1, 1, At, B1); PG8_BAR; PG8_SCHED;
        }
        if constexpr (ALIGN_EPI) { if (wr == 0) PG8_BAR; }
        E(acc, cur, wr, wc, fr, fq); S.done(cur);
        if (!has_next) break;
#pragma unroll
        for (int a = 0; a < 2; ++a)
#pragma unroll
            for (int b = 0; b < 2; ++b)
#pragma unroll
                for (int m = 0; m < 4; ++m)
#pragma unroll
                    for (int n = 0; n < 2; ++n) acc[a][b][m][n] = (f32x4){0.f, 0.f, 0.f, 0.f};
        cur = nxt; cB = nB; ++ui;
        if constexpr (ALIGN_EPI) { if (wr == 1) PG8_BAR; }
    }
    PG8_WAIT_V(0);
    if constexpr (!ALIGN_EPI) { if (wr == 0) PG8_BAR; }
    PG8_BAR;
#undef PG8_SA
#undef PG8_SB
#undef PG8_STAGE
#undef PG8_LDA
#undef PG8_LDB
#undef PG8_MMA
#undef PG8_WAIT_V
#undef PG8_WAIT_L
#undef PG8_BAR
#undef PG8_SCHED
#undef PG8_AOFF
}

struct Gemm2 { const bf16_t* A0; const bf16_t* B0; int K0; const bf16_t* A1; const bf16_t* B1; int K1; int wave; };
template <class Epi, class Sched, bool ALIGN_EPI>
__device__ __forceinline__ void gemm_phase2(PG8_LAS unsigned char* lds, const Gemm2 g, const Sched& S, const Epi& E) {
    const int wid = g.wave, lane = lane_id(), tid = wid * 64 + lane, wr = wid >> 2, wc = wid & 3, fr = lane & 15, fq = lane >> 4;
    const int nt0 = g.K0 / BK, nt = nt0 + g.K1 / BK;
    unsigned RA2[2], RB2[2], C2[2];
#pragma unroll
    for (int i = 0; i < 2; ++i) { int R, C; stage_rc(tid * 16 + i * 8192, R, C); const int Rb = Epi::PERM ? ((R & ~31) + perm32(R & 31)) : R;
        RA2[i] = (unsigned)R * 2u; RB2[i] = (unsigned)Rb * 2u; C2[i] = (unsigned)C * 2u; }
    const size_t kstep = (size_t)(BK * 2);
    const unsigned ldsw = (unsigned)wid * 1024u;
    const int aoff = lds_byte(wr * 64 + fr, fq * 8), boff = lds_byte(wc * 32 + fr, fq * 8);
#define PG8_SA(b, h) (((b) * 2 + (h)) * HTB)
#define PG8_SB(b, h) ((4 + (b) * 2 + (h)) * HTB)
#define PG8_STAGE(bufoff, gbase, R2, Kb) do { _Pragma("unroll") for (int _i = 0; _i < 2; ++_i) \
        __builtin_amdgcn_global_load_lds((const unsigned*)((const char*)(gbase) + ((R2)[_i] * (unsigned)(Kb) + C2[_i])), (PG8_LAS unsigned*)(lds + (bufoff) + ldsw + _i * 8192), 16, 0, 0); } while (0)
#define PG8_LDA(dst, b, h) do { _Pragma("unroll") for (int m = 0; m < 4; ++m) _Pragma("unroll") for (int k = 0; k < 2; ++k) dst[m][k] = *(const PG8_LAS bf16x8*)(lds + PG8_SA(b, h) + aoff + m * 2048 + k * 1024); } while (0)
#define PG8_LDB(dst, b, h) do { _Pragma("unroll") for (int n = 0; n < 2; ++n) _Pragma("unroll") for (int k = 0; k < 2; ++k) dst[n][k] = *(const PG8_LAS bf16x8*)(lds + PG8_SB(b, h) + boff + n * 2048 + k * 1024); } while (0)
#define PG8_MMA(ai, bj, At, Bt) do { __builtin_amdgcn_s_setprio(1); _Pragma("unroll") for (int m = 0; m < 4; ++m) _Pragma("unroll") for (int n = 0; n < 2; ++n) _Pragma("unroll") for (int k = 0; k < 2; ++k) \
        acc[ai][bj][m][n] = __builtin_amdgcn_mfma_f32_16x16x32_bf16(Bt[n][k], At[m][k], acc[ai][bj][m][n], 0, 0, 0); __builtin_amdgcn_s_setprio(0); } while (0)
#define PG8_WAIT_V(n) asm volatile("s_waitcnt vmcnt(" #n ")" ::: "memory")
#define PG8_WAIT_L(n) asm volatile("s_waitcnt lgkmcnt(" #n ")" ::: "memory")
#define PG8_BAR __builtin_amdgcn_s_barrier()
#define PG8_SCHED __builtin_amdgcn_sched_barrier(0)
#define PG8_APTR(pm_, h, tt) ((tt) < nt0 ? (const char*)g.A0 + ((size_t)((pm_) * BM + (h) * HALF) * g.K0 + (size_t)(tt) * BK) * 2 : (const char*)g.A1 + ((size_t)((pm_) * BM + (h) * HALF) * g.K1 + (size_t)((tt) - nt0) * BK) * 2)
#define PG8_BPTR(pn_, h, tt) ((tt) < nt0 ? (const char*)g.B0 + ((size_t)((pn_) * BM + (h) * HALF) * g.K0 + (size_t)(tt) * BK) * 2 : (const char*)g.B1 + ((size_t)((pn_) * BM + (h) * HALF) * g.K1 + (size_t)((tt) - nt0) * BK) * 2)
    Unit cur, nxt; int ui = 0;
    if (!S.next(0, cur)) return;
    f32x4 acc[2][2][4][2];
#pragma unroll
    for (int a = 0; a < 2; ++a)
#pragma unroll
        for (int b = 0; b < 2; ++b)
#pragma unroll
            for (int m = 0; m < 4; ++m)
#pragma unroll
                for (int n = 0; n < 2; ++n) acc[a][b][m][n] = (f32x4){0.f, 0.f, 0.f, 0.f};
    bf16x8 At[4][2], B0[2][2], B1[2][2];
    PG8_STAGE(PG8_SB(0, 0), PG8_BPTR(cur.pn, 0, 0), RB2, g.K0); PG8_STAGE(PG8_SB(0, 1), PG8_BPTR(cur.pn, 1, 0), RB2, g.K0); PG8_STAGE(PG8_SA(0, 0), PG8_APTR(cur.pm, 0, 0), RA2, g.K0); PG8_STAGE(PG8_SA(0, 1), PG8_APTR(cur.pm, 1, 0), RA2, g.K0);
    if (wr == 1) PG8_BAR;
    PG8_WAIT_V(2); PG8_BAR;
    PG8_STAGE(PG8_SB(1, 0), PG8_BPTR(cur.pn, 0, 1), RB2, g.K0); PG8_STAGE(PG8_SA(1, 0), PG8_APTR(cur.pm, 0, 1), RA2, g.K0); PG8_STAGE(PG8_SB(1, 1), PG8_BPTR(cur.pn, 1, 1), RB2, g.K0);
    PG8_WAIT_V(6); PG8_BAR;
    for (;;) {
        const bool has_next = S.next(ui + 1, nxt);
#pragma unroll 1
        for (int t = 0; t < nt; t += 2) {
            const bool last = (t == nt - 2);
            if (t == nt0) E.mid(acc, cur, wr, wc, fr, fq);
            const bool s1 = t >= nt0;
            const int t2 = last ? 0 : t + 2; const bool s2 = t2 >= nt0;
            const int pm2 = (last && has_next) ? nxt.pm : cur.pm, pn2 = (last && has_next) ? nxt.pn : cur.pn;
            const int Ks1 = s1 ? g.K1 : g.K0, Ks2 = s2 ? g.K1 : g.K0;
            const char* a1h1 = PG8_APTR(cur.pm, 1, t + 1);
            const char* a2h0 = PG8_APTR(pm2, 0, t2); const char* a2h1 = PG8_APTR(pm2, 1, t2);
            const char* b2h0 = PG8_BPTR(pn2, 0, t2); const char* b2h1 = PG8_BPTR(pn2, 1, t2);
            PG8_LDB(B0, 0, 0); PG8_LDB(B1, 0, 1); PG8_SCHED; PG8_LDA(At, 0, 0); PG8_STAGE(PG8_SA(1, 1), a1h1, RA2, Ks1);
            PG8_WAIT_V(8); PG8_WAIT_L(0); PG8_BAR; PG8_MMA(0, 0, At, B0); PG8_MMA(0, 1, At, B1); PG8_BAR; PG8_SCHED;
            PG8_LDA(At, 0, 1); PG8_STAGE(PG8_SB(0, 0), b2h0, RB2, Ks2); PG8_STAGE(PG8_SB(0, 1), b2h1, RB2, Ks2); PG8_STAGE(PG8_SA(0, 0), a2h0, RA2, Ks2);
            PG8_WAIT_V(8); PG8_WAIT_L(0); PG8_BAR; PG8_MMA(1, 0, At, B0); PG8_MMA(1, 1, At, B1); PG8_BAR; PG8_SCHED;
            PG8_LDB(B0, 1, 0); PG8_LDB(B1, 1, 1); PG8_SCHED; PG8_LDA(At, 1, 0); PG8_STAGE(PG8_SA(0, 1), a2h1, RA2, Ks2);
            PG8_WAIT_V(8); PG8_WAIT_L(0); PG8_BAR; PG8_MMA(0, 0, At, B0); PG8_MMA(0, 1, At, B1); PG8_BAR; PG8_SCHED;
            PG8_LDA(At, 1, 1); PG8_STAGE(PG8_SB(1, 0), b2h0 + kstep, RB2, Ks2); PG8_STAGE(PG8_SB(1, 1), b2h1 + kstep, RB2, Ks2); PG8_STAGE(PG8_SA(1, 0), a2h0 + kstep, RA2, Ks2);
            PG8_WAIT_V(8); PG8_WAIT_L(0); PG8_BAR; PG8_MMA(1, 0, At, B0); PG8_MMA(1, 1, At, B1); PG8_BAR; PG8_SCHED;
        }
        if constexpr (ALIGN_EPI) { if (wr == 0) PG8_BAR; }
        E(acc, cur, wr, wc, fr, fq);
        if (!has_next) break;
#pragma unroll
        for (int a = 0; a < 2; ++a)
#pragma unroll
            for (int b = 0; b < 2; ++b)
#pragma unroll
                for (int m = 0; m < 4; ++m)
#pragma unroll
                    for (int n = 0; n < 2; ++n) acc[a][b][m][n] = (f32x4){0.f, 0.f, 0.f, 0.f};
        cur = nxt; ++ui;
        if constexpr (ALIGN_EPI) { if (wr == 1) PG8_BAR; }
    }
    PG8_WAIT_V(0);
    if constexpr (!ALIGN_EPI) { if (wr == 0) PG8_BAR; }
    PG8_BAR;
#undef PG8_SA
#undef PG8_SB
#undef PG8_STAGE
#undef PG8_LDA
#undef PG8_LDB
#undef PG8_MMA
#undef PG8_WAIT_V
#undef PG8_WAIT_L
#undef PG8_BAR
#undef PG8_SCHED
#undef PG8_APTR
#undef PG8_BPTR
}
struct GemmGM { const bf16_t* XB; const bf16_t* WinT; const bf16_t* AO; const bf16_t* WpaT; const bf16_t* DIFF; const bf16_t* WeffT; const float* bias; bf16_t* MIXED; int wave; };
template <class Sched, class Pre>
__device__ __forceinline__ void gemm_phase_gm(PG8_LAS unsigned char* lds, const GemmGM g, const Sched& S, const Pre& pre) {
    const int wid = g.wave, lane = lane_id(), tid = wid * 64 + lane, wr = wid >> 2, wc = wid & 3, fr = lane & 15, fq = lane >> 4;
    constexpr int NTG = DM / BK, NTA = AOW / BK, NTP = POOLW / BK, NT = NTG + NTA + NTP;
    static_assert(NTG % 2 == 0 && NTA % 2 == 0 && NTP % 2 == 0, "segment boundaries on even K-tiles");
    unsigned RCB[2];
#pragma unroll
    for (int i = 0; i < 2; ++i) { int R, C; stage_rc(tid * 16 + i * 8192, R, C); const int Rb = (R & ~31) + perm32(R & 31);
        RCB[i] = ((unsigned)Rb << 16) | ((unsigned)R << 8) | (unsigned)C; }
    const size_t kstep = (size_t)(BK * 2);
    const unsigned ldsw = (unsigned)wid * 1024u;
    const int aoff = lds_byte(wr * 64 + fr, fq * 8), boff = lds_byte(wc * 32 + fr, fq * 8);
#define PG8_SA(b, h) (((b) * 2 + (h)) * HTB)
#define PG8_SB(b, h) ((4 + (b) * 2 + (h)) * HTB)
#define RA2 8
#define RB2 16
#define PG8_STAGE(bufoff, gbase, SH, Kb) do { _Pragma("unroll") for (int _i = 0; _i < 2; ++_i) \
        __builtin_amdgcn_global_load_lds((const unsigned*)((const char*)(gbase) + ((((RCB[_i] >> (SH)) & 0xffu) * (unsigned)(Kb) + (RCB[_i] & 0xffu)) * 2u)), (PG8_LAS unsigned*)(lds + (bufoff) + ldsw + _i * 8192), 16, 0, 0); } while (0)
#define PG8_LDA(dst, b, h) do { _Pragma("unroll") for (int m = 0; m < 4; ++m) _Pragma("unroll") for (int k = 0; k < 2; ++k) dst[m][k] = *(const PG8_LAS bf16x8*)(lds + PG8_SA(b, h) + aoff + m * 2048 + k * 1024); } while (0)
#define PG8_LDB(dst, b, h) do { _Pragma("unroll") for (int n = 0; n < 2; ++n) _Pragma("unroll") for (int k = 0; k < 2; ++k) dst[n][k] = *(const PG8_LAS bf16x8*)(lds + PG8_SB(b, h) + boff + n * 2048 + k * 1024); } while (0)
#define PG8_MMA(ai, bj, At, Bt) do { __builtin_amdgcn_s_setprio(1); _Pragma("unroll") for (int m = 0; m < 4; ++m) _Pragma("unroll") for (int n = 0; n < 2; ++n) _Pragma("unroll") for (int k = 0; k < 2; ++k) \
        acc[ai][bj][m][n] = __builtin_amdgcn_mfma_f32_16x16x32_bf16(Bt[n][k], At[m][k], acc[ai][bj][m][n], 0, 0, 0); __builtin_amdgcn_s_setprio(0); } while (0)
#define PG8_WAIT_V(n) asm volatile("s_waitcnt vmcnt(" #n ")" ::: "memory")
#define PG8_WAIT_L(n) asm volatile("s_waitcnt lgkmcnt(" #n ")" ::: "memory")
#define PG8_BAR __builtin_amdgcn_s_barrier()
#define PG8_SCHED __builtin_amdgcn_sched_barrier(0)
    int kG = DM, kA = AOW, kP = POOLW; asm volatile("" : "+s"(kG), "+s"(kA), "+s"(kP));
#define GM_K(tt) ((tt) < NTG ? kG : ((tt) < NTG + NTA ? kA : kP))
#define GM_APTR(pm_, h, tt) ((tt) < NTG ? (const char*)g.XB + ((size_t)((pm_) * BM + (h) * HALF) * DM + (size_t)(tt) * BK) * 2 : \
        ((tt) < NTG + NTA ? (const char*)g.AO + ((size_t)((pm_) * BM + (h) * HALF) * AOW + (size_t)((tt) - NTG) * BK) * 2 : (const char*)g.DIFF + ((size_t)((pm_) * BM + (h) * HALF) * POOLW + (size_t)((tt) - NTG - NTA) * BK) * 2))
#define GM_BPTR(tc_, h, tt) ((tt) < NTG ? (const char*)g.WinT + ((size_t)((11 + (tc_)) * BM + (h) * HALF) * DM + (size_t)(tt) * BK) * 2 : \
        ((tt) < NTG + NTA ? (const char*)g.WpaT + ((size_t)((tc_) * HALF) * AOW + (size_t)((tt) - NTG) * BK) * 2 : (const char*)g.WeffT + ((size_t)((tc_) * HALF) * POOLW + (size_t)((tt) - NTG - NTA) * BK) * 2))
#define GM_ITER(CM, SM) do { \
        PG8_LDB(B0, 0, 0); if (CM) PG8_LDB(B1, 0, 1); PG8_SCHED; PG8_LDA(At, 0, 0); PG8_STAGE(PG8_SA(1, 1), a1h1, RA2, Kc); \
        if (CM) PG8_WAIT_V(8); else PG8_WAIT_V(6); PG8_WAIT_L(0); PG8_BAR; PG8_MMA(0, 0, At, B0); if (CM) PG8_MMA(0, 1, At, B1); PG8_BAR; PG8_SCHED; \
        PG8_LDA(At, 0, 1); PG8_STAGE(PG8_SB(0, 0), b2h0, RB2, Ks); if (SM) PG8_STAGE(PG8_SB(0, 1), b2h1, RB2, Ks); PG8_STAGE(PG8_SA(0, 0), a2h0, RA2, Ks); \
        if (SM) PG8_WAIT_V(8); else PG8_WAIT_V(6); PG8_WAIT_L(0); PG8_BAR; PG8_MMA(1, 0, At, B0); if (CM) PG8_MMA(1, 1, At, B1); PG8_BAR; PG8_SCHED; \
        PG8_LDB(B0, 1, 0); if (CM) PG8_LDB(B1, 1, 1); PG8_SCHED; PG8_LDA(At, 1, 0); PG8_STAGE(PG8_SA(0, 1), a2h1, RA2, Ks); \
        if (SM) PG8_WAIT_V(8); else PG8_WAIT_V(6); PG8_WAIT_L(0); PG8_BAR; PG8_MMA(0, 0, At, B0); if (CM) PG8_MMA(0, 1, At, B1); PG8_BAR; PG8_SCHED; \
        PG8_LDA(At, 1, 1); PG8_STAGE(PG8_SB(1, 0), b2h0 + kstep, RB2, Ks); if (SM) PG8_STAGE(PG8_SB(1, 1), b2h1 + kstep, RB2, Ks); PG8_STAGE(PG8_SA(1, 0), a2h0 + kstep, RA2, Ks); \
        if (SM) PG8_WAIT_V(8); else PG8_WAIT_V(6); PG8_WAIT_L(0); PG8_BAR; PG8_MMA(1, 0, At, B0); if (CM) PG8_MMA(1, 1, At, B1); PG8_BAR; PG8_SCHED; } while (0)
    Unit cur, nxt; int ui = 0;
    if (!S.next(0, cur)) return;
    f32x4 acc[2][2][4][2];
#pragma unroll
    for (int a = 0; a < 2; ++a)
#pragma unroll
        for (int b = 0; b < 2; ++b)
#pragma unroll
            for (int m = 0; m < 4; ++m)
#pragma unroll
                for (int n = 0; n < 2; ++n) acc[a][b][m][n] = (f32x4){0.f, 0.f, 0.f, 0.f};
    bf16x8 At[4][2], B0[2][2], B1[2][2];
    PG8_STAGE(PG8_SB(0, 0), GM_BPTR(cur.pn, 0, 0), RB2, kG); PG8_STAGE(PG8_SB(0, 1), GM_BPTR(cur.pn, 1, 0), RB2, kG); PG8_STAGE(PG8_SA(0, 0), GM_APTR(cur.pm, 0, 0), RA2, kG); PG8_STAGE(PG8_SA(0, 1), GM_APTR(cur.pm, 1, 0), RA2, kG);
    if (wr == 1) PG8_BAR;
    PG8_WAIT_V(2); PG8_BAR;
    PG8_STAGE(PG8_SB(1, 0), GM_BPTR(cur.pn, 0, 1), RB2, kG); PG8_STAGE(PG8_SA(1, 0), GM_APTR(cur.pm, 0, 1), RA2, kG); PG8_STAGE(PG8_SB(1, 1), GM_BPTR(cur.pn, 1, 1), RB2, kG);
    PG8_WAIT_V(6); PG8_BAR;
    for (;;) {
        const bool has_next = S.next(ui + 1, nxt);
        u32x2 rho[2][4][2], sgb[2][4][2];
#define GM_SETUP(t_, last_) const int t2 = (last_) ? 0 : (t_) + 2; const int pm2 = ((last_) && has_next) ? nxt.pm : cur.pm, tc2 = ((last_) && has_next) ? nxt.pn : cur.pn; \
            int Kc = GM_K(t_), Ks = GM_K(t2); asm volatile("" : "+s"(Kc), "+s"(Ks)); const char* a1h1 = GM_APTR(cur.pm, 1, (t_) + 1); \
            const char* a2h0 = GM_APTR(pm2, 0, t2); const char* a2h1 = GM_APTR(pm2, 1, t2); const char* b2h0 = GM_BPTR(tc2, 0, t2); const char* b2h1 = GM_BPTR(tc2, 1, t2)
#pragma unroll 1
        for (int t = 0; t < NTG - 2; t += 2) { GM_SETUP(t, false); GM_ITER(1, 1); }
        if (ui == 0) pre();
        { GM_SETUP(NTG - 2, false); GM_ITER(1, 0); }
        {
            int lc0 = wc * 32 + 8 * fq; asm volatile("" : "+v"(lc0));
            const float* bga = g.bias + GA_OFF + cur.pn * HALF + lc0; const float* bgb = g.bias + GB_OFF + cur.pn * HALF + lc0;
            const f32x4 ba0 = *(const f32x4*)bga, ba1 = *(const f32x4*)(bga + 4), bb0 = *(const f32x4*)bgb, bb1 = *(const f32x4*)(bgb + 4);
#pragma unroll
            for (int ai = 0; ai < 2; ++ai)
#pragma unroll
                for (int m = 0; m < 4; ++m)
#pragma unroll
                    for (int n = 0; n < 2; ++n) { const f32x4 ga = acc[ai][0][m][n] + (n ? ba1 : ba0), gb = acc[ai][1][m][n] + (n ? bb1 : bb0); float r[4], sb[4];
#pragma unroll
                        for (int i = 0; i < 4; ++i) { sb[i] = fsig_gate(gb[i]); r[i] = fsig(ga[i]) * __builtin_amdgcn_rcpf(sb[i]); }
                        rho[ai][m][n].x = cvt_pk_bf16(r[0], r[1]); rho[ai][m][n].y = cvt_pk_bf16(r[2], r[3]); sgb[ai][m][n].x = cvt_pk_bf16(sb[0], sb[1]); sgb[ai][m][n].y = cvt_pk_bf16(sb[2], sb[3]);
                        acc[ai][0][m][n] = (f32x4){0.f, 0.f, 0.f, 0.f}; }
        }
#pragma unroll 1
        for (int t = NTG; t < NTG + NTA; t += 2) { GM_SETUP(t, false); GM_ITER(0, 0); }
#pragma unroll
        for (int ai = 0; ai < 2; ++ai)
#pragma unroll
            for (int m = 0; m < 4; ++m)
#pragma unroll
                for (int n = 0; n < 2; ++n) { f32x4& v = acc[ai][0][m][n]; const u32x2 rr = rho[ai][m][n]; v[0] *= bflo(rr.x); v[1] *= bfhi(rr.x); v[2] *= bflo(rr.y); v[3] *= bfhi(rr.y); }
#pragma unroll 1
        for (int t = NTG + NTA; t < NT - 2; t += 2) { GM_SETUP(t, false); GM_ITER(0, 0); }
        { GM_SETUP(NT - 2, true); GM_ITER(0, 1); }
        if (wr == 0) PG8_BAR;
        {
            const int row0 = cur.pm * BM + wr * 64 + fr, col0 = cur.pn * HALF + wc * 32 + 8 * fq;
#pragma unroll
            for (int ai = 0; ai < 2; ++ai)
#pragma unroll
                for (int m = 0; m < 4; ++m) { const f32x4 v0 = acc[ai][0][m][0], v1 = acc[ai][0][m][1]; const u32x2 s0 = sgb[ai][m][0], s1 = sgb[ai][m][1];
                    u32x4 w; w.x = cvt_pk_bf16(v0[0] * bflo(s0.x), v0[1] * bfhi(s0.x)); w.y = cvt_pk_bf16(v0[2] * bflo(s0.y), v0[3] * bfhi(s0.y));
                    w.z = cvt_pk_bf16(v1[0] * bflo(s1.x), v1[1] * bfhi(s1.x)); w.w = cvt_pk_bf16(v1[2] * bflo(s1.y), v1[3] * bfhi(s1.y));
                    *(u32x4*)(g.MIXED + (size_t)(row0 + ai * HALF + m * 16) * DM + col0) = w; }
        }
        if (!has_next) break;
#pragma unroll
        for (int a = 0; a < 2; ++a)
#pragma unroll
            for (int b = 0; b < 2; ++b)
#pragma unroll
                for (int m = 0; m < 4; ++m)
#pragma unroll
                    for (int n = 0; n < 2; ++n) acc[a][b][m][n] = (f32x4){0.f, 0.f, 0.f, 0.f};
        cur = nxt; ++ui;
        if (wr == 1) PG8_BAR;
    }
    PG8_WAIT_V(0);
    PG8_BAR;
#undef PG8_SA
#undef PG8_SB
#undef PG8_STAGE
#undef PG8_LDA
#undef PG8_LDB
#undef PG8_MMA
#undef PG8_WAIT_V
#undef PG8_WAIT_L
#undef PG8_BAR
#undef PG8_SCHED
#undef GM_K
#undef GM_APTR
#undef GM_BPTR
#undef GM_ITER
#undef GM_SETUP
#undef RA2
#undef RB2
}
}

constexpr int NWAVES = 8;
constexpr int RING_OFF = 0, RING_BYTES = 131072;
constexpr int ATTN_LDS = 147456;
constexpr int BIAS_OFF = ATTN_LDS;
constexpr int LDSCTL_OFF = BIAS_OFF + 3 * 4 * 192 * 4;
constexpr int MISC_OFF = LDSCTL_OFF, TILE_E_OFF = LDSCTL_OFF + 256, FIRST_OFF = TILE_E_OFF + 320 * 4;
constexpr int LDS_BYTES = 163840;
static_assert(FIRST_OFF + 64 * 4 <= LDS_BYTES, "LDS map");
constexpr size_t WS_XB = WS_X1B;
constexpr size_t WT_WIN = WS_WT;
constexpr size_t WT_WPA = WT_WIN + (size_t)INW * DM * 2;
constexpr size_t WT_WEFF = WT_WPA + (size_t)DM * AOW * 2;
constexpr size_t WT_WOUT = WT_WEFF + (size_t)DM * POOLW * 2;
constexpr size_t WT_WGU = WT_WOUT + (size_t)DM * DM * 2;
constexpr size_t WT_WD = WT_WGU + (size_t)NEXP * 512 * DM * 2;
static_assert(WT_WD + (size_t)NEXP * DM * DEXP * 2 <= WS_CTL, "weights fit");
constexpr int CW_CNT = 0;
constexpr int CW_BAR = 4096;
constexpr int CW_READY = 8192;
constexpr int CW_Q9 = 30720, CW_TMO = 30784;
constexpr size_t CTL_ZERO_BYTES = 262144;
#ifdef TPROBE
constexpr int CW_TS = 32768, CW_ACC = 49152;
#define TSTAMP(k) do { asm volatile("" ::: "memory"); if (F.wave == 0 && lane_id() == 0) __hip_atomic_store((unsigned*)(args.ws + WS_CTL) + CW_TS + (int)blockIdx.x * 32 + (k), (unsigned)__builtin_amdgcn_s_memrealtime(), __ATOMIC_RELAXED, __HIP_MEMORY_SCOPE_AGENT); asm volatile("" ::: "memory"); } while (0)
#else
#define TSTAMP(k) do { } while (0)
#endif

#define GAS __attribute__((address_space(1)))
#define LAS __attribute__((address_space(3)))
typedef GAS unsigned gu32;
#define RLX_AGENT __ATOMIC_RELAXED, __HIP_MEMORY_SCOPE_AGENT
#define LDS_WAIT() asm volatile("s_waitcnt lgkmcnt(0)" ::: "memory")
#define VM_WAIT() asm volatile("s_waitcnt vmcnt(0)" ::: "memory")
typedef unsigned v4u __attribute__((ext_vector_type(4)));
__device__ __forceinline__ unsigned pk2(float lo, float hi) { return (unsigned)f2bf(lo) | ((unsigned)f2bf(hi) << 16); }

#define XB_TMO      128
#define XB_XCNT(j)  (256  + 64 * (j))
#define XB_XSUB(j)  (1280 + 64 * (j))
#define XB_XGEN(j)  (2304 + 64 * (j))
#define XB_TOP      3328
#define XB_TOPGEN   3392
#define XCD_BAR_WORDS 3456
#define XB_SPIN_CAP (1u << 18)

__device__ __forceinline__ unsigned xb_ld(unsigned* p)              { return __hip_atomic_load(p, __ATOMIC_RELAXED, __HIP_MEMORY_SCOPE_AGENT); }
__device__ __forceinline__ unsigned xb_add(unsigned* p, unsigned v) { return __hip_atomic_fetch_add(p, v, __ATOMIC_RELAXED, __HIP_MEMORY_SCOPE_AGENT); }
__device__ __forceinline__ unsigned xb_xcc_id() { return (unsigned)__builtin_amdgcn_s_getreg((3 << 11) | 20) & 0xFu; }
#define XB_SPIN(cond, bar) do { unsigned _sp = 0; while (cond) { __builtin_amdgcn_s_sleep(1); \
    if ((++_sp & 255u) == 0u) { if (xb_ld(&(bar)[XB_TMO])) break; if (_sp > XB_SPIN_CAP) { atomicAdd(&(bar)[XB_TMO], 1u); break; } } } } while (0)

struct XcdBarrier {
    unsigned* bar; unsigned x; unsigned w;
    volatile LAS unsigned* st;
};

__device__ __forceinline__ XcdBarrier xcd_barrier_post(unsigned* bar, volatile LAS unsigned* st, unsigned w) {
    XcdBarrier b; b.bar = bar; b.x = xb_xcc_id(); b.st = st; b.w = w;
    if (w == 0u && lane_id() == 0) (void)xb_add(&bar[XB_XCNT(b.x)], 1u);
    return b;
}
__device__ __forceinline__ void xcd_barrier_complete(unsigned* bar, unsigned x, unsigned& nloc, unsigned& nx) {
    const unsigned G = gridDim.x * gridDim.y * gridDim.z;
    unsigned sum, cnt, mine, sp = 0u;
    for (;;) {
        sum = 0u; cnt = 0u; mine = 0u;
#pragma unroll
        for (unsigned j = 0; j < 16; ++j) { const unsigned c = xb_ld(&bar[XB_XCNT(j)]); sum += c; cnt += (c > 0u) ? 1u : 0u; mine = (j == x) ? c : mine; }
        if (sum == G) break;
        __builtin_amdgcn_s_sleep(1);
        if ((++sp & 255u) == 0u) { if (xb_ld(&bar[XB_TMO])) break; if (sp > XB_SPIN_CAP) { atomicAdd(&bar[XB_TMO], 1u); break; } }
    }
    nloc = mine > 0u ? mine : 1u; nx = cnt > 0u ? cnt : 1u;
}

__device__ __forceinline__ void xcd_barrier(const XcdBarrier& b) {
    asm volatile("s_waitcnt vmcnt(0)" ::: "memory");
    __syncthreads();
    if (b.w == 0u && lane_id() == 0) {
        unsigned* bar = b.bar;
        __builtin_amdgcn_s_waitcnt(0);
        unsigned nloc = b.st[0], nx = b.st[1];
        if (nloc == 0u) { xcd_barrier_complete(bar, b.x, nloc, nx); b.st[0] = nloc; b.st[1] = nx; }
        const unsigned old = xb_add(&bar[XB_XSUB(b.x)], 1u);
        const unsigned gen = old / nloc;
        if (old + 1u == (gen + 1u) * nloc) {
            __builtin_amdgcn_fence(__ATOMIC_RELEASE, "agent");
            asm volatile("s_waitcnt vmcnt(0)" ::: "memory");
            const unsigned og = xb_add(&bar[XB_TOP], 1u);
            const unsigned tg = og / nx;
            if (og + 1u == (tg + 1u) * nx) xb_add(&bar[XB_TOPGEN], 1u);
            else XB_SPIN(xb_ld(&bar[XB_TOPGEN]) == tg, bar);
            __builtin_amdgcn_fence(__ATOMIC_ACQUIRE, "agent");
            xb_add(&bar[XB_XGEN(b.x)], 1u);
            asm volatile("s_waitcnt vmcnt(0)" ::: "memory");
        } else {
            XB_SPIN(xb_ld(&bar[XB_XGEN(b.x)]) <= gen, bar);
            __builtin_amdgcn_fence(__ATOMIC_ACQUIRE, "agent");
            asm volatile("s_waitcnt vmcnt(0)" ::: "memory");
        }
    }
    __syncthreads();
}

__device__ __forceinline__ void xcd_arrive(const XcdBarrier& b) {
    asm volatile("s_waitcnt vmcnt(0)" ::: "memory");
    __syncthreads();
    if (b.w == 0u && lane_id() == 0) {
        unsigned* bar = b.bar;
        __builtin_amdgcn_s_waitcnt(0);
        unsigned nloc = b.st[0], nx = b.st[1];
        if (nloc == 0u) { xcd_barrier_complete(bar, b.x, nloc, nx); b.st[0] = nloc; b.st[1] = nx; }
        const unsigned old = xb_add(&bar[XB_XSUB(b.x)], 1u);
        const unsigned gen = old / nloc; unsigned role = 0u, tg = 0u;
        if (old + 1u == (gen + 1u) * nloc) {
            __builtin_amdgcn_fence(__ATOMIC_RELEASE, "agent");
            asm volatile("s_waitcnt vmcnt(0)" ::: "memory");
            const unsigned og = xb_add(&bar[XB_TOP], 1u); tg = og / nx;
            if (og + 1u == (tg + 1u) * nx) { xb_add(&bar[XB_TOPGEN], 1u); role = 2u; } else role = 1u;
        }
        b.st[2] = role; b.st[3] = gen; b.st[4] = tg;
    }
}
__device__ __forceinline__ void xcd_wait(const XcdBarrier& b) {
    if (b.w == 0u && lane_id() == 0) {
        unsigned* bar = b.bar; const unsigned role = b.st[2], gen = b.st[3], tg = b.st[4];
        if (role) {
            if (role == 1u) XB_SPIN(xb_ld(&bar[XB_TOPGEN]) <= tg, bar);
            __builtin_amdgcn_fence(__ATOMIC_ACQUIRE, "agent");
            xb_add(&bar[XB_XGEN(b.x)], 1u);
            asm volatile("s_waitcnt vmcnt(0)" ::: "memory");
        } else {
            XB_SPIN(xb_ld(&bar[XB_TOPGEN]) <= gen, bar);
            __builtin_amdgcn_fence(__ATOMIC_ACQUIRE, "agent");
            asm volatile("s_waitcnt vmcnt(0)" ::: "memory");
        }
    }
    asm volatile("s_waitcnt lgkmcnt(0)" ::: "memory"); __builtin_amdgcn_s_barrier(); asm volatile("" ::: "memory");
}


struct Frame {
    LAS unsigned char* lds;
    int wave, vcu, G;
};
struct MArgs { const float* in[20]; float* out; unsigned char* ws; int ph_lo, ph_hi; };

struct TrItem { const float* W; bf16_t* WT; int K, N, k0, n0, drow0; };
__device__ __forceinline__ void tr_load(const TrItem& t, float (&v)[32], int lane) {
#pragma unroll
    for (int i = 0; i < 32; ++i) v[i] = t.W[(size_t)(t.k0 + 2 * i + (lane >> 5)) * t.N + t.n0 + (lane & 31)];
}
__device__ __forceinline__ void tr_store(const TrItem& t, const float (&v)[32], LAS float* scr, int lane) {
#pragma unroll
    for (int i = 0; i < 32; ++i) scr[(2 * i + (lane >> 5)) * 33 + (lane & 31)] = v[i];
    LDS_WAIT(); asm volatile("" ::: "memory");
    const int c = lane & 7;
#pragma unroll
    for (int j = 0; j < 4; ++j) { const int n = (lane >> 3) + 8 * j; const LAS float* s = scr + (8 * c) * 33 + n;
        v4u o; o.x = pk2(s[0 * 33], s[1 * 33]); o.y = pk2(s[2 * 33], s[3 * 33]); o.z = pk2(s[4 * 33], s[5 * 33]); o.w = pk2(s[6 * 33], s[7 * 33]);
        *(GAS v4u*)(t.WT + (size_t)(t.drow0 + n) * t.K + t.k0 + 8 * c) = o; }
    LDS_WAIT(); asm volatile("" ::: "memory");
}
constexpr int TR_IN = (DM / 64) * (INW / 32), TR_PA = (AOW / 64) * (DM / 32), TR_OUT = (DM / 64) * (DM / 32), TR_G = (DM / 64) * (DEXP / 32), TR_D = (DEXP / 64) * (DM / 32);
constexpr int TR_DENSE = TR_IN + TR_PA + TR_OUT, TR_EXP = NEXP * (2 * TR_G + TR_D);
__device__ __forceinline__ TrItem tr_item(const MArgs& a, int it) {
    unsigned char* ws = a.ws; TrItem t; int r = it;
    constexpr int TR_IN_A = (DM / 64) * (GA_OFF / 32);
    if (r < TR_IN) { int kb, n0; if (r < TR_IN_A) { const int nb = GA_OFF / 32; kb = r / nb; n0 = (r % nb) * 32; } else { const int nb = (INW - GA_OFF) / 32, q = r - TR_IN_A; kb = q / nb; n0 = GA_OFF + (q % nb) * 32; }
        t.W = a.in[1]; t.WT = (bf16_t*)(ws + WT_WIN); t.K = DM; t.N = INW; t.k0 = kb * 64; t.n0 = n0;
        t.drow0 = t.n0 < GA_OFF ? t.n0 : (t.n0 < GB_OFF ? GA_OFF + ((t.n0 - GA_OFF) >> 7) * 256 + ((t.n0 - GA_OFF) & 127) : GA_OFF + ((t.n0 - GB_OFF) >> 7) * 256 + 128 + ((t.n0 - GB_OFF) & 127)); return t; } r -= TR_IN;
    if (r < TR_PA) { const int nb = DM / 32; t.W = a.in[6]; t.WT = (bf16_t*)(ws + WT_WPA); t.K = AOW; t.N = DM; t.k0 = (r / nb) * 64; t.n0 = (r % nb) * 32; t.drow0 = t.n0; return t; } r -= TR_PA;
    if (r < TR_OUT) { const int nb = DM / 32; t.W = a.in[8]; t.WT = (bf16_t*)(ws + WT_WOUT); t.K = DM; t.N = DM; t.k0 = (r / nb) * 64; t.n0 = (r % nb) * 32; t.drow0 = t.n0; return t; } r -= TR_OUT;
    const int e = r / (2 * TR_G + TR_D); r -= e * (2 * TR_G + TR_D);
    if (r < 2 * TR_G) { const int up = r >= TR_G; if (up) r -= TR_G; const int nb = DEXP / 32; t.W = (up ? a.in[16] : a.in[15]) + (size_t)e * DM * DEXP; t.WT = (bf16_t*)(ws + WT_WGU); t.K = DM; t.N = DEXP;
        t.k0 = (r / nb) * 64; t.n0 = (r % nb) * 32; t.drow0 = e * 512 + (t.n0 >> 7) * 256 + up * 128 + (t.n0 & 127); return t; }
    r -= 2 * TR_G;
    { const int nb = DM / 32; t.W = a.in[17] + (size_t)e * DEXP * DM; t.WT = (bf16_t*)(ws + WT_WD) + (size_t)e * DM * DEXP; t.K = DEXP; t.N = DM; t.k0 = (r / nb) * 64; t.n0 = (r % nb) * 32; t.drow0 = t.n0; return t; }
}
__device__ __forceinline__ void tr_run(Frame& F, const MArgs& a, int first, int stride, int end) {
    LAS float* scr = (LAS float*)(F.lds + RING_OFF + F.wave * 16384);
    if (first >= end) return;
    float vn[32]; TrItem tn = tr_item(a, first); tr_load(tn, vn, lane_id());
    for (int it = first; it < end; it += stride) {
        float v[32]; TrItem t = tn;
#pragma unroll
        for (int i = 0; i < 32; ++i) v[i] = vn[i];
        if (it + stride < end) { tn = tr_item(a, it + stride); tr_load(tn, vn, lane_id()); }
        tr_store(t, v, scr, lane_id());
    }
}
__device__ __forceinline__ void p0_prologue_a(Frame& F, const MArgs& a) {
    unsigned char* ws = a.ws;
    const int gw = F.vcu * NWAVES + F.wave, NGW = F.G * NWAVES, lane = lane_id();
    tr_run(F, a, gw, NGW, (DM / 64) * (GA_OFF / 32));
    const float* x = a.in[0]; bf16_t* XB = (bf16_t*)(ws + WS_XB);
    for (int it = gw * 8; it < NTOK * DM / 512; it += NGW * 8) {
        f32x4 a0[8], a1[8];
#pragma unroll
        for (int u = 0; u < 8; ++u) { const size_t o = (size_t)(it + u) * 512 + lane * 8; a0[u] = *(const f32x4*)(x + o); a1[u] = *(const f32x4*)(x + o + 4); }
#pragma unroll
        for (int u = 0; u < 8; ++u) { const size_t o = (size_t)(it + u) * 512 + lane * 8;
            v4u w; w.x = pk2(a0[u][0], a0[u][1]); w.y = pk2(a0[u][2], a0[u][3]); w.z = pk2(a1[u][0], a1[u][1]); w.w = pk2(a1[u][2], a1[u][3]);
            *(GAS v4u*)(XB + o) = w; } }
}
__device__ __forceinline__ void p0_prologue_b(Frame& F, const MArgs& a) {
    unsigned char* ws = a.ws;
    const int gw = F.vcu * NWAVES + F.wave, NGW = F.G * NWAVES, lane = lane_id();
    const float* w_pool = a.in[4]; const float* pscale = a.in[5]; const float* w_pp = a.in[7];
    bf16_t* WeffT = (bf16_t*)(ws + WT_WEFF);
    tr_run(F, a, (DM / 64) * (GA_OFF / 32) + gw, NGW, TR_DENSE);
    for (int it = gw; it < (DM / 32) * (POOLW / 32); it += NGW) {
        const int nb = it >> 4, kb = it & 15, g = kb >> 2, n0 = nb * 32, c0 = (kb & 3) * 32, rr = lane & 31, kk = lane >> 5;
        typedef float f32x16 __attribute__((ext_vector_type(16)));
        f32x16 acc = {0.f, 0.f, 0.f, 0.f, 0.f, 0.f, 0.f, 0.f, 0.f, 0.f, 0.f, 0.f, 0.f, 0.f, 0.f, 0.f};
        const float* ap = w_pp + (size_t)(g * 128 + kk) * DM + n0 + rr;
        const float* sp = pscale + g * 128 + kk;
        const float* bp = w_pool + (size_t)(g * 128 + c0 + rr) * 128 + kk;
#pragma unroll 16
        for (int ks = 0; ks < 64; ++ks) { const float av = ap[(size_t)(2 * ks) * DM] * sp[2 * ks], bv = bp[2 * ks];
            acc = __builtin_amdgcn_mfma_f32_32x32x2f32(av, bv, acc, 0, 0, 0); }
#pragma unroll
        for (int i = 0; i < 16; ++i) { const int n = n0 + (i & 3) + 8 * (i >> 2) + 4 * kk;
            WeffT[(size_t)n * POOLW + g * 128 + c0 + rr] = f2bf(acc[i]); }
    }
}

__device__ __forceinline__ int moe_tables(Frame& F, const int* cnt) {
    LAS int* tile_e = (LAS int*)(F.lds + TILE_E_OFF); LAS int* first = (LAS int*)(F.lds + FIRST_OFF);
    __syncthreads();
    if ((F.wave * 64 + lane_id()) < 64) {
        const int e = (F.wave * 64 + lane_id()), nt = (e < NEXP) ? ((__hip_atomic_load(cnt + (e & 31) * 64, RLX_AGENT) + 255) >> 8) : 0;
        int incl = nt;
#pragma unroll
        for (int o = 1; o < 32; o <<= 1) { const int t = __shfl_up(incl, o); if ((e & 31) >= o) incl += t; }
        const int f0 = incl - nt;
        if (e < NEXP) { first[e] = f0; for (int i = 0; i < nt; ++i) tile_e[f0 + i] = e; if (e == NEXP - 1) first[NEXP] = incl; }
    }
    __syncthreads();
    return first[NEXP];
}


typedef float f32x16 __attribute__((ext_vector_type(16)));
typedef short s16x4 __attribute__((ext_vector_type(4)));
constexpr float LOG2E = 1.4426950408889634f;
constexpr float QSCALE = 0.125f * LOG2E;
constexpr int VROW = 192;
__device__ __forceinline__ s16x4 vtr(const LAS unsigned char* p) { return __builtin_bit_cast(s16x4, __builtin_amdgcn_ds_read_tr16_b64_v4i16((LAS s16x4*)p)); }
constexpr int AT_K = 0, AT_V0 = 49152, AT_V1 = 98304;
__device__ __forceinline__ void attn_unit_decode(int un, int& b, int& h, int& g, int& dil, int& L, int& c0, int& l0) {
    const int j = un & 7, bh = un >> 3; h = bh % 12; b = bh / 12; g = h >> 2; dil = 1 << (2 * g); L = SEQ >> (2 * g);
    if (g == 0) { c0 = 0; l0 = 256 * j; } else if (g == 1) { c0 = j >> 1; l0 = 256 * (j & 1); } else { c0 = 2 * j; l0 = 0; }
}
__device__ __forceinline__ size_t attn_krow(int b, int g, int L, int c0, int l0, int wr_) {
    if (g == 2) { const int cls = c0 + ((wr_ >> 7) & 1), l = wr_ & 127; return (size_t)b * SEQ + (size_t)cls * L + l; }
    int l = l0 - 128 + wr_; l = l < 0 ? 0 : l; return (size_t)b * SEQ + (size_t)c0 * L + l;
}
__device__ __forceinline__ void attn_wave_q(int g, int c0, int l0, int w, int& cq, int& lq0) { cq = (g == 2) ? c0 + (w >> 2) : c0; lq0 = (g == 2) ? 32 * (w & 3) : l0 + 32 * w; }
__device__ __forceinline__ void phase_attn(Frame& F, const MArgs& a, const bf16_t* proj, bf16_t* aog, float* lse) {
    LAS float* bias2 = (LAS float*)(F.lds + BIAS_OFF);
    const float* rel_bias = a.in[3];
    int tid0 = (F.wave * 64 + lane_id()); asm volatile("" : "+v"(tid0));
    for (int i = tid0; i < 3 * 4 * 192; i += NWAVES * 64) { const int gs = i / 192, j = i - gs * 192 - 32, g = gs >> 2, dil = 1 << (2 * g);
        bias2[i] = (j >= 0 && j <= 128) ? rel_bias[t5_bucket(j * dil) * 12 + gs] * LOG2E : -1.0e30f; }
    asm volatile("s_waitcnt vmcnt(0) lgkmcnt(0)" ::: "memory"); __builtin_amdgcn_s_barrier(); asm volatile("" ::: "memory");
    LAS unsigned char* ring = F.lds;
    const unsigned lds0 = (unsigned)(size_t)F.lds;
    const int lane = lane_id(), w = F.wave, r = lane & 31, hh = lane >> 5;
    const int NU = BATCH * 12 * 8;
    const int drow = lane >> 3, schunk = (lane & 7) ^ (lane >> 3);
    int koff[4];
#pragma unroll
    for (int ks = 0; ks < 4; ++ks) koff[ks] = r * 128 + ((((2 * ks + hh) ^ (r & 7))) << 4);
    const int trow = 4 * hh + ((lane & 15) >> 2);
    int toff[2];
#pragma unroll
    for (int dt = 0; dt < 2; ++dt) toff[dt] = trow * 128 + (((4 * dt + 2 * ((lane >> 4) & 1) + ((lane & 3) >> 1)) ^ (trow & 7)) << 4) + (lane & 1) * 8;
#define AT_DMA(dst_off, col_off) do { _Pragma("unroll") for (int _p = 0; _p < 6; ++_p) { const int _pc = w + 8 * _p; \
        const bf16_t* _src = proj + attn_krow(b_, g_, L_, c0_, l0_, _pc * 8 + drow) * INW + (col_off) + h_ * HD + schunk * 8; \
        unsigned _keep; const unsigned _dst = (unsigned)__builtin_amdgcn_readfirstlane((int)(lds0 + (unsigned)(dst_off) + (unsigned)_pc * 1024u)); \
        asm volatile("s_mov_b32 %0, m0\n\ts_mov_b32 m0, %2\n\ts_nop 0\n\tglobal_load_lds_dwordx4 %1, off\n\ts_mov_b32 m0, %0" : "=&s"(_keep) : "v"(_src), "s"(_dst) : "memory"); } } while (0)
#define AT_QLOAD(dst) do { int cq_, lq_; attn_wave_q(g_, c0_, l0_, w, cq_, lq_); const bf16_t* _qp = proj + ((size_t)b_ * SEQ + (size_t)cq_ * L_ + lq_ + r) * INW + Q_OFF + h_ * HD + 8 * hh; \
        _Pragma("unroll") for (int ks = 0; ks < 4; ++ks) dst[ks] = *(const bf16x8*)(_qp + 16 * ks); } while (0)
    bf16x8 qn[4];
    int un = F.vcu;
    { int b_, h_, g_, dil_, L_, c0_, l0_; attn_unit_decode(un, b_, h_, g_, dil_, L_, c0_, l0_); (void)dil_;
      AT_QLOAD(qn); AT_DMA(AT_K, K_OFF); AT_DMA(AT_V0, V_OFF); }
    bool first = true;
    for (int par = 0; un < NU; un += F.G, par ^= 1) {
        int b, h, g, dil, L, c0, l0; attn_unit_decode(un, b, h, g, dil, L, c0, l0);
        const bool has_next = (un + F.G) < NU;
        int cq, lq0; attn_wave_q(g, c0, l0, w, cq, lq0);
        const int wbase = (g == 2) ? 128 * (w >> 2) + 32 * (w & 3) - 128 : 32 * w;
        bf16x8 qf[4];
#pragma unroll
        for (int ks = 0; ks < 4; ++ks) qf[ks] = qn[ks];
        if (first) asm volatile("s_waitcnt vmcnt(0)" ::: "memory"); else asm volatile("s_waitcnt vmcnt(9)" ::: "memory");
        first = false;
        __builtin_amdgcn_s_barrier(); asm volatile("" ::: "memory");
        if (has_next) { int b_, h_, g_, dil_, L_, c0_, l0_; attn_unit_decode(un + F.G, b_, h_, g_, dil_, L_, c0_, l0_); (void)dil_;
            AT_QLOAD(qn); if (par == 0) AT_DMA(AT_V1, V_OFF); else AT_DMA(AT_V0, V_OFF); }
        f32x16 st[5];
#pragma unroll
        for (int kt = 0; kt < 5; ++kt) {
            int wrow = wbase + 32 * kt; if (g == 2) { const int lo_ = 128 * (w >> 2); wrow = wrow < lo_ ? lo_ : wrow; }
            f32x16 acc = {0.f, 0.f, 0.f, 0.f, 0.f, 0.f, 0.f, 0.f, 0.f, 0.f, 0.f, 0.f, 0.f, 0.f, 0.f, 0.f};
#pragma unroll
            for (int ks = 0; ks < 4; ++ks) { const bf16x8 kf = *(const LAS bf16x8*)(ring + AT_K + wrow * 128 + koff[ks]);
                acc = __builtin_amdgcn_mfma_f32_32x32x16_bf16(kf, qf[ks], acc, 0, 0, 0); }
            st[kt] = acc;
        }
        asm volatile("s_waitcnt lgkmcnt(0)" ::: "memory"); __builtin_amdgcn_s_barrier(); asm volatile("" ::: "memory");
        if (has_next) { int b_, h_, g_, dil_, L_, c0_, l0_; attn_unit_decode(un + F.G, b_, h_, g_, dil_, L_, c0_, l0_); (void)dil_; AT_DMA(AT_K, K_OFF); }
        const LAS float* bt = bias2 + h * 192 + 32 + 128 + (r - 4 * hh);
        float mx = -1.0e30f;
        if (lq0 >= 128) {
#pragma unroll
            for (int kt = 0; kt < 5; ++kt)
#pragma unroll
                for (int hb = 0; hb < 2; ++hb) { float bvv[8];
#pragma unroll
                    for (int i = 0; i < 8; ++i) bvv[i] = bt[-32 * kt - ((i & 3) + 8 * (2 * hb + (i >> 2)))];
                    asm volatile("" : "+v"(bvv[0]), "+v"(bvv[1]), "+v"(bvv[2]), "+v"(bvv[3]), "+v"(bvv[4]), "+v"(bvv[5]), "+v"(bvv[6]), "+v"(bvv[7]));
#pragma unroll
                    for (int i = 0; i < 8; ++i) { const float sv = st[kt][8 * hb + i] + bvv[i]; st[kt][8 * hb + i] = sv; mx = fmaxf(mx, sv); } }
        } else {
            const int jmax = lq0 + r, jl = 128 + r - 4 * hh;
#pragma unroll
            for (int kt = 0; kt < 5; ++kt)
#pragma unroll
                for (int hb = 0; hb < 2; ++hb) { float bvv[8];
#pragma unroll
                    for (int i = 0; i < 8; ++i) bvv[i] = bt[-32 * kt - ((i & 3) + 8 * (2 * hb + (i >> 2)))];
                    asm volatile("" : "+v"(bvv[0]), "+v"(bvv[1]), "+v"(bvv[2]), "+v"(bvv[3]), "+v"(bvv[4]), "+v"(bvv[5]), "+v"(bvv[6]), "+v"(bvv[7]));
#pragma unroll
                    for (int i = 0; i < 8; ++i) { const int jc = -32 * kt - ((i & 3) + 8 * (2 * hb + (i >> 2)));
                        const float sv = (jl + jc <= jmax) ? st[kt][8 * hb + i] + bvv[i] : -1.0e30f; st[kt][8 * hb + i] = sv; mx = fmaxf(mx, sv); } }
        }
        mx = fmaxf(mx, __shfl_xor(mx, 32));
        float lsum = 0.f;
#pragma unroll
        for (int kt = 0; kt < 5; ++kt)
#pragma unroll
            for (int i = 0; i < 16; ++i) { const float pv = __builtin_amdgcn_exp2f(st[kt][i] - mx); st[kt][i] = pv; lsum += pv; }
        lsum += __shfl_xor(lsum, 32);
        f32x16 o0 = {0.f, 0.f, 0.f, 0.f, 0.f, 0.f, 0.f, 0.f, 0.f, 0.f, 0.f, 0.f, 0.f, 0.f, 0.f, 0.f}, o1 = o0;
        const int vbuf = par ? AT_V1 : AT_V0;
#pragma unroll
        for (int kt = 0; kt < 5; ++kt) {
            int wrow = wbase + 32 * kt; if (g == 2) { const int lo_ = 128 * (w >> 2); wrow = wrow < lo_ ? lo_ : wrow; }
            const LAS unsigned char* vb = ring + vbuf + wrow * 128;
#pragma unroll
            for (int s2 = 0; s2 < 2; ++s2) {
                pg8::u32x4 pw; pw.x = pg8::cvt_pk_bf16(st[kt][8 * s2 + 0], st[kt][8 * s2 + 1]); pw.y = pg8::cvt_pk_bf16(st[kt][8 * s2 + 2], st[kt][8 * s2 + 3]);
                pw.z = pg8::cvt_pk_bf16(st[kt][8 * s2 + 4], st[kt][8 * s2 + 5]); pw.w = pg8::cvt_pk_bf16(st[kt][8 * s2 + 6], st[kt][8 * s2 + 7]);
                const bf16x8 pf = __builtin_bit_cast(bf16x8, pw);
#pragma unroll
                for (int dt = 0; dt < 2; ++dt) {
                    const s16x4 lo = vtr(vb + (16 * s2) * 128 + toff[dt]), hi = vtr(vb + (16 * s2 + 8) * 128 + toff[dt]);
                    const bf16x8 vf = {lo[0], lo[1], lo[2], lo[3], hi[0], hi[1], hi[2], hi[3]};
                    if (dt == 0) o0 = __builtin_amdgcn_mfma_f32_32x32x16_bf16(vf, pf, o0, 0, 0, 0); else o1 = __builtin_amdgcn_mfma_f32_32x32x16_bf16(vf, pf, o1, 0, 0, 0);
                }
            }
        }
        const float inv = 1.f / lsum;
        const int tok = b * SEQ + cq + dil * (lq0 + r);
        bf16_t* op = aog + ((size_t)g * NTOK + tok) * AOW + (h & 3) * HD + 4 * hh;
#pragma unroll
        for (int dt = 0; dt < 2; ++dt)
#pragma unroll
            for (int q4 = 0; q4 < 4; ++q4) { const f32x16& o = dt == 0 ? o0 : o1;
                pg8::u32x2 wv; wv.x = pg8::cvt_pk_bf16(o[4 * q4] * inv, o[4 * q4 + 1] * inv); wv.y = pg8::cvt_pk_bf16(o[4 * q4 + 2] * inv, o[4 * q4 + 3] * inv);
                *(pg8::u32x2*)(op + 32 * dt + 8 * q4) = wv; }
        if (hh == 0) lse[((size_t)g * NTOK + tok) * 4 + (h & 3)] = mx + __builtin_amdgcn_logf(lsum);
        asm volatile("s_waitcnt lgkmcnt(0)" ::: "memory");
    }
    asm volatile("s_waitcnt vmcnt(0) lgkmcnt(0)" ::: "memory"); __builtin_amdgcn_s_barrier(); asm volatile("" ::: "memory");
#undef AT_DMA
#undef AT_QLOAD
}
template <int W, int NI> __device__ __forceinline__ void pool_items(const bf16_t* proj, bf16_t* diff, int tok0, int ch) {
    pg8::u32x4 v[NI][W];
#pragma unroll
    for (int u = 0; u < NI; ++u) { const int tok = tok0 + 8 * u, t = tok & (SEQ - 1); const bf16_t* p = proj + (size_t)tok * INW + POOL_OFF + ch * 8;
#pragma unroll
        for (int j = 0; j < W; ++j) v[u][j] = *(const pg8::u32x4*)(p - (size_t)((t >= j) ? j : 0) * INW); }
#pragma unroll
    for (int u = 0; u < NI; ++u) { const int tok = tok0 + 8 * u, t = tok & (SEQ - 1);
        float s[8];
#pragma unroll
        for (int e = 0; e < 8; ++e) s[e] = 0.f;
#pragma unroll
        for (int j = 0; j < W; ++j) { const float m = (t >= j) ? 1.f : 0.f;
            s[0] += m * pg8::bflo(v[u][j].x); s[1] += m * pg8::bfhi(v[u][j].x); s[2] += m * pg8::bflo(v[u][j].y); s[3] += m * pg8::bfhi(v[u][j].y);
            s[4] += m * pg8::bflo(v[u][j].z); s[5] += m * pg8::bfhi(v[u][j].z); s[6] += m * pg8::bflo(v[u][j].w); s[7] += m * pg8::bfhi(v[u][j].w); }
        const float ic = 1.f / (float)((t + 1 < W) ? t + 1 : W);
        pg8::u32x4 o;
        o.x = pg8::cvt_pk_bf16(s[0] * ic - pg8::bflo(v[u][0].x), s[1] * ic - pg8::bfhi(v[u][0].x)); o.y = pg8::cvt_pk_bf16(s[2] * ic - pg8::bflo(v[u][0].y), s[3] * ic - pg8::bfhi(v[u][0].y));
        o.z = pg8::cvt_pk_bf16(s[4] * ic - pg8::bflo(v[u][0].z), s[5] * ic - pg8::bfhi(v[u][0].z)); o.w = pg8::cvt_pk_bf16(s[6] * ic - pg8::bflo(v[u][0].w), s[7] * ic - pg8::bfhi(v[u][0].w));
        *(pg8::u32x4*)(diff + (size_t)tok * POOLW + ch * 8) = o; }
}
__device__ __forceinline__ void phase_pool(Frame& F, const bf16_t* proj, bf16_t* diff) {
    const int gw = F.vcu * NWAVES + F.wave, NGW = F.G * NWAVES, lane = lane_id();
    for (int it = gw; it < NTOK / 4; it += NGW) {
        const int tg = it >> 3, cg = ((it & 7) + 2 * (it / NGW)) & 7, tok0 = tg * 32 + (lane >> 3), ch = cg * 8 + (lane & 7), gi = cg >> 1;
        if (gi == 0) pool_items<2, 4>(proj, diff, tok0, ch); else if (gi == 1) pool_items<4, 4>(proj, diff, tok0, ch);
        else if (gi == 2) { pool_items<8, 2>(proj, diff, tok0, ch); pool_items<8, 2>(proj, diff, tok0 + 16, ch); }
        else { pool_items<16, 1>(proj, diff, tok0, ch); pool_items<16, 1>(proj, diff, tok0 + 8, ch); pool_items<16, 1>(proj, diff, tok0 + 16, ch); pool_items<16, 1>(proj, diff, tok0 + 24, ch); }
    }
}
__device__ __forceinline__ void phase_combine(Frame& F, const bf16_t* aog, const float* lse, bf16_t* ao) {
    const int gt = (F.vcu * NWAVES + F.wave) * 64 + lane_id(), NGT = F.G * NWAVES * 64;
    for (int it = gt; it < NTOK * 32; it += NGT) {
        const int tok = it >> 5, ch = it & 31, slot = ch >> 3;
        const float l0 = lse[((size_t)0 * NTOK + tok) * 4 + slot], l1 = lse[((size_t)1 * NTOK + tok) * 4 + slot], l2 = lse[((size_t)2 * NTOK + tok) * 4 + slot];
        const float M = fmaxf(l0, fmaxf(l1, l2));
        float w0 = __builtin_amdgcn_exp2f(l0 - M), w1 = __builtin_amdgcn_exp2f(l1 - M), w2 = __builtin_amdgcn_exp2f(l2 - M);
        const float iw = 1.f / (w0 + w1 + w2); w0 *= iw; w1 *= iw; w2 *= iw;
        const pg8::u32x4 a0 = *(const pg8::u32x4*)(aog + ((size_t)0 * NTOK + tok) * AOW + ch * 8), a1 = *(const pg8::u32x4*)(aog + ((size_t)1 * NTOK + tok) * AOW + ch * 8),
                         a2 = *(const pg8::u32x4*)(aog + ((size_t)2 * NTOK + tok) * AOW + ch * 8);
        pg8::u32x4 o;
#define CMB(f) pg8::cvt_pk_bf16(w0 * pg8::bflo(a0.f) + w1 * pg8::bflo(a1.f) + w2 * pg8::bflo(a2.f), w0 * pg8::bfhi(a0.f) + w1 * pg8::bfhi(a1.f) + w2 * pg8::bfhi(a2.f))
        o.x = CMB(x); o.y = CMB(y); o.z = CMB(z); o.w = CMB(w);
#undef CMB
        *(pg8::u32x4*)(ao + (size_t)tok * AOW + ch * 8) = o;
    }
}

constexpr int XS = 1028;
template <class Pre> __device__ __forceinline__ void phase_ln_router(Frame& F, const MArgs& a, const bf16_t* y, bf16_t* x1b, int* cnt, int* list, float* listw, const Pre& pre) {
    const float* x = a.in[0];
    LAS float* xs = (LAS float*)(F.lds + RING_OFF);
    LAS float* part = xs + 16 * XS;
    LAS float* lgs = part + 8 * 16 * 48;
    LAS unsigned* lcnt = (LAS unsigned*)(lgs + 8 * 16 * 40);
    LAS int* rtab = (LAS int*)(lcnt + 32);
    if ((F.wave * 64 + lane_id()) < 32) lcnt[(F.wave * 64 + lane_id())] = 0u;
    const float* g1 = a.in[9]; const float* b1 = a.in[10]; const float* wrg = a.in[11]; const float* brg = a.in[12]; const float* wre = a.in[13]; const float* bre = a.in[14];
    LAS float* gb1 = (LAS float*)(F.lds + RING_OFF + 122880);
    { int tid0 = (F.wave * 64 + lane_id()); asm volatile("" : "+v"(tid0)); for (int i = tid0; i < 2 * DM; i += NWAVES * 64) gb1[i] = (i < DM) ? g1[i] : b1[i - DM]; }
    __syncthreads();
    const int lane = lane_id(), w = F.wave, t16 = lane & 15, q = lane >> 4, tid = (F.wave * 64 + lane_id());
    bf16x8 wBh[4][3], wBl[4][3];
#pragma unroll
    for (int ks = 0; ks < 4; ++ks)
#pragma unroll
        for (int ct = 0; ct < 3; ++ct) { const int o = 16 * ct + t16; float wv[8];
#pragma unroll
            for (int j = 0; j < 8; ++j) { const int k = 128 * w + 32 * ks + 8 * q + j; wv[j] = (o < 4) ? wrg[k * 4 + o] : ((o < 36) ? wre[k * 32 + o - 4] : 0.f); }
            pg8::u32x4 hw, lw;
#pragma unroll
            for (int j2 = 0; j2 < 4; ++j2) { const unsigned hp = pg8::cvt_pk_bf16(wv[2 * j2], wv[2 * j2 + 1]);
                const unsigned lp = pg8::cvt_pk_bf16(wv[2 * j2] - pg8::bflo(hp), wv[2 * j2 + 1] - pg8::bfhi(hp)); hw[j2] = hp; lw[j2] = lp; }
            wBh[ks][ct] = __builtin_bit_cast(bf16x8, hw); wBl[ks][ct] = __builtin_bit_cast(bf16x8, lw); }
    const int ntile = NTOK / 16;
    f32x4 vn[2][4]; pg8::u32x2 yn[2][4];
#define LNR_LOAD(T_) do { _Pragma("unroll") for (int rr = 0; rr < 2; ++rr) _Pragma("unroll") for (int j = 0; j < 4; ++j) { const size_t o_ = (size_t)(16 * (T_) + 2 * w + rr) * DM + lane * 4 + 256 * j; \
        vn[rr][j] = *(const f32x4*)(x + o_); yn[rr][j] = *(const pg8::u32x2*)(y + o_); } } while (0)
    pre();
    LNR_LOAD(F.vcu);
    const float rb0 = ((tid % 36) < 4) ? brg[tid % 36] : bre[(tid % 36) - 4], rb1 = (((tid + NWAVES * 64) % 36) < 4) ? brg[(tid + NWAVES * 64) % 36] : bre[((tid + NWAVES * 64) % 36) - 4];
    int ti = 0;
    for (int T = F.vcu; T < ntile; T += F.G, ++ti) {
        f32x4 v[2][4];
#pragma unroll
        for (int rr = 0; rr < 2; ++rr)
#pragma unroll
            for (int j = 0; j < 4; ++j) { f32x4 z = vn[rr][j] * ALPHA; z[0] += pg8::bflo(yn[rr][j].x); z[1] += pg8::bfhi(yn[rr][j].x); z[2] += pg8::bflo(yn[rr][j].y); z[3] += pg8::bfhi(yn[rr][j].y); v[rr][j] = z; }
        if (T + F.G < ntile) LNR_LOAD(T + F.G);
#pragma unroll
        for (int rr = 0; rr < 2; ++rr) {
            const int tok = 16 * T + 2 * w + rr;
            float s = 0.f;
#pragma unroll
            for (int j = 0; j < 4; ++j) s += (v[rr][j][0] + v[rr][j][1]) + (v[rr][j][2] + v[rr][j][3]);
            const float mean = wave_sum(s) * (1.f / DM); float s2 = 0.f;
#pragma unroll
            for (int j = 0; j < 4; ++j) { const f32x4 d = v[rr][j] - mean; s2 += (d[0] * d[0] + d[1] * d[1]) + (d[2] * d[2] + d[3] * d[3]); }
            const float rstd = 1.f / sqrtf(wave_sum(s2) * (1.f / DM) + LN_EPS);
#pragma unroll
            for (int j = 0; j < 4; ++j) { const int k0 = lane * 4 + 256 * j;
                const f32x4 x1 = (v[rr][j] - mean) * rstd * *(const LAS f32x4*)(gb1 + k0) + *(const LAS f32x4*)(gb1 + DM + k0);
                *(LAS f32x4*)(xs + (2 * w + rr) * XS + k0) = x1;
                pg8::u32x2 pk; pk.x = pg8::cvt_pk_bf16(x1[0], x1[1]); pk.y = pg8::cvt_pk_bf16(x1[2], x1[3]);
                *(pg8::u32x2*)(x1b + (size_t)tok * DM + k0) = pk; }
        }
        __syncthreads();
        f32x4 acc[3];
#pragma unroll
        for (int ct = 0; ct < 3; ++ct) acc[ct] = (f32x4){0.f, 0.f, 0.f, 0.f};
        const LAS float* xr = xs + t16 * XS + 128 * w + 8 * q;
#pragma unroll
        for (int ks = 0; ks < 4; ++ks) { const f32x4 xa = *(const LAS f32x4*)(xr + 32 * ks), xb = *(const LAS f32x4*)(xr + 32 * ks + 4);
            pg8::u32x4 hw, lw;
            hw.x = pg8::cvt_pk_bf16(xa[0], xa[1]); hw.y = pg8::cvt_pk_bf16(xa[2], xa[3]); hw.z = pg8::cvt_pk_bf16(xb[0], xb[1]); hw.w = pg8::cvt_pk_bf16(xb[2], xb[3]);
            lw.x = pg8::cvt_pk_bf16(xa[0] - pg8::bflo(hw.x), xa[1] - pg8::bfhi(hw.x)); lw.y = pg8::cvt_pk_bf16(xa[2] - pg8::bflo(hw.y), xa[3] - pg8::bfhi(hw.y));
            lw.z = pg8::cvt_pk_bf16(xb[0] - pg8::bflo(hw.z), xb[1] - pg8::bfhi(hw.z)); lw.w = pg8::cvt_pk_bf16(xb[2] - pg8::bflo(hw.w), xb[3] - pg8::bfhi(hw.w));
            const bf16x8 ah = __builtin_bit_cast(bf16x8, hw), al = __builtin_bit_cast(bf16x8, lw);
#pragma unroll
            for (int ct = 0; ct < 3; ++ct) {
                acc[ct] = __builtin_amdgcn_mfma_f32_16x16x32_bf16(ah, wBh[ks][ct], acc[ct], 0, 0, 0);
                acc[ct] = __builtin_amdgcn_mfma_f32_16x16x32_bf16(al, wBh[ks][ct], acc[ct], 0, 0, 0);
                acc[ct] = __builtin_amdgcn_mfma_f32_16x16x32_bf16(ah, wBl[ks][ct], acc[ct], 0, 0, 0); } }
#pragma unroll
        for (int ct = 0; ct < 3; ++ct)
#pragma unroll
            for (int rg = 0; rg < 4; ++rg) part[(w * 16 + 4 * q + rg) * 48 + 16 * ct + t16] = acc[ct][rg];
        __syncthreads();
        for (int i = tid; i < 16 * 36; i += NWAVES * 64) { const int tk = i / 36, o = i - tk * 36; float sum = (i < NWAVES * 64) ? rb0 : rb1;
#pragma unroll
            for (int ww = 0; ww < 8; ++ww) sum += part[(ww * 16 + tk) * 48 + o];
            lgs[(ti * 16 + tk) * 40 + o] = sum; }
    }
#undef LNR_LOAD
    __syncthreads();
    for (int sl_ = tid; sl_ < ti * 16; sl_ += NWAVES * 64) {
        const LAS float* sl = lgs + sl_ * 40;
        int gi = 0; float gm = sl[0];
        for (int o = 1; o < 4; ++o) if (sl[o] > gm) { gm = sl[o]; gi = o; }
        float gs = 0.f; for (int o = 0; o < 4; ++o) gs += __expf(sl[o] - gm);
        const float gprob = 1.f / gs;
        const LAS float* el = sl + 4 + gi * 8;
        int i0 = 0; float l0 = el[0];
        for (int o = 1; o < 8; ++o) if (el[o] > l0) { l0 = el[o]; i0 = o; }
        int i1 = -1; float l1 = -3.0e38f;
        for (int o = 0; o < 8; ++o) if (o != i0 && el[o] > l1) { l1 = el[o]; i1 = o; }
        const float e1 = __expf(l1 - l0), w0 = gprob / (1.f + e1), w1 = gprob * e1 / (1.f + e1);
        const int ex0 = gi * 8 + i0, ex1 = gi * 8 + i1;
        const int r0 = (int)__hip_atomic_fetch_add(lcnt + ex0, 1u, __ATOMIC_RELAXED, __HIP_MEMORY_SCOPE_WORKGROUP), r1 = (int)__hip_atomic_fetch_add(lcnt + ex1, 1u, __ATOMIC_RELAXED, __HIP_MEMORY_SCOPE_WORKGROUP);
        rtab[sl_ * 4 + 0] = (ex0 << 16) | r0; rtab[sl_ * 4 + 1] = (ex1 << 16) | r1; ((LAS float*)rtab)[sl_ * 4 + 2] = w0; ((LAS float*)rtab)[sl_ * 4 + 3] = w1;
    }
    __syncthreads();
    if (tid < 32) { const unsigned n = lcnt[tid]; lcnt[tid] = n ? (unsigned)atomicAdd(&cnt[tid * 64], (int)n) : 0u; }
    __syncthreads();
    for (int sl_ = tid; sl_ < ti * 16; sl_ += NWAVES * 64) {
        const int tok = 16 * (F.vcu + (sl_ >> 4) * F.G) + (sl_ & 15);
        const int a0 = rtab[sl_ * 4 + 0], a1 = rtab[sl_ * 4 + 1]; const float w0 = ((LAS float*)rtab)[sl_ * 4 + 2], w1 = ((LAS float*)rtab)[sl_ * 4 + 3];
        const int ex0 = a0 >> 16, ex1 = a1 >> 16, r0 = (a0 & 0xffff) + (int)lcnt[ex0], r1 = (a1 & 0xffff) + (int)lcnt[ex1];
        list[ex0 * NTOK + r0] = tok * 2; listw[ex0 * NTOK + r0] = w0;
        list[ex1 * NTOK + r1] = tok * 2 + 1; listw[ex1 * NTOK + r1] = w1;
    }
}

#ifdef TPROBE
__device__ __forceinline__ void phase_final(Frame& F, const MArgs& a, const bf16_t* x1b, const bf16_t* po, const float pscale, const float pbump) {
#else
__device__ __forceinline__ void phase_final(Frame& F, const MArgs& a, const bf16_t* x1b, const bf16_t* po) {
#endif
    const float* g2 = a.in[18]; const float* b2 = a.in[19];
    const int gw = F.vcu * NWAVES + F.wave, NGW = F.G * NWAVES, lane = lane_id();
    f32x4 gg2[4], bb2[4];
#pragma unroll
    for (int j = 0; j < 4; ++j) { gg2[j] = *(const f32x4*)(g2 + lane * 4 + 256 * j); bb2[j] = *(const f32x4*)(b2 + lane * 4 + 256 * j); }
    pg8::u32x2 xn[2][4], pan[2][4], pbn[2][4];
#define FIN_LOAD(base_) do { _Pragma("unroll") for (int u = 0; u < 2; ++u) { const int tk = (base_) + u; \
        _Pragma("unroll") for (int j = 0; j < 4; ++j) { const int k0 = lane * 4 + 256 * j; xn[u][j] = *(const pg8::u32x2*)(x1b + (size_t)tk * DM + k0); \
            pan[u][j] = *(const pg8::u32x2*)(po + (size_t)tk * 2 * DM + k0); pbn[u][j] = *(const pg8::u32x2*)(po + (size_t)tk * 2 * DM + DM + k0); } } } while (0)
    FIN_LOAD(gw * 2);
    for (int base = gw * 2; base < NTOK; base += NGW * 2) {
        f32x4 v[2][4]; float s[2] = {0.f, 0.f};
#pragma unroll
        for (int u = 0; u < 2; ++u)
#pragma unroll
            for (int j = 0; j < 4; ++j) { f32x4 t;
                t[0] = ALPHA * pg8::bflo(xn[u][j].x) + (pg8::bflo(pan[u][j].x) + pg8::bflo(pbn[u][j].x)); t[1] = ALPHA * pg8::bfhi(xn[u][j].x) + (pg8::bfhi(pan[u][j].x) + pg8::bfhi(pbn[u][j].x));
                t[2] = ALPHA * pg8::bflo(xn[u][j].y) + (pg8::bflo(pan[u][j].y) + pg8::bflo(pbn[u][j].y)); t[3] = ALPHA * pg8::bfhi(xn[u][j].y) + (pg8::bfhi(pan[u][j].y) + pg8::bfhi(pbn[u][j].y));
                v[u][j] = t; s[u] += (t[0] + t[1]) + (t[2] + t[3]); }
        if (base + NGW * 2 < NTOK) FIN_LOAD(base + NGW * 2);
#pragma unroll
        for (int u = 0; u < 2; ++u) {
            const float mean = wave_sum(s[u]) * (1.f / DM); float s2 = 0.f;
#pragma unroll
            for (int j = 0; j < 4; ++j) { v[u][j] = v[u][j] - mean; s2 += (v[u][j][0] * v[u][j][0] + v[u][j][1] * v[u][j][1]) + (v[u][j][2] * v[u][j][2] + v[u][j][3] * v[u][j][3]); }
            const float rstd = 1.f / sqrtf(wave_sum(s2) * (1.f / DM) + LN_EPS);
            float* row = a.out + (size_t)(base + u) * DM;
#pragma unroll
            for (int j = 0; j < 4; ++j) { const int k0 = lane * 4 + 256 * j; f32x4 o_ = v[u][j] * rstd * gg2[j] + bb2[j];
#ifdef TPROBE
                if (base + u == 0 && k0 == 0) o_[0] += pbump; else o_[0] *= pscale;
                o_[1] *= pscale; o_[2] *= pscale; o_[3] *= pscale;
#endif
                *(f32x4*)(row + k0) = o_; }
        }
    }
#undef FIN_LOAD
}


#ifdef TPROBE
struct PreWait { XcdBarrier b; bool on; unsigned* ts; int k; int wave; __device__ __forceinline__ void operator()() const {
    if (wave == 0 && lane_id() == 0) __hip_atomic_store(ts + k, (unsigned)__builtin_amdgcn_s_memrealtime(), __ATOMIC_RELAXED, __HIP_MEMORY_SCOPE_AGENT);
    if (on) xcd_wait(b);
    if (wave == 0 && lane_id() == 0) __hip_atomic_store(ts + k + 1, (unsigned)__builtin_amdgcn_s_memrealtime(), __ATOMIC_RELAXED, __HIP_MEMORY_SCOPE_AGENT); } };
#define PREWAIT(k_) PreWait pre{bar, multi, (unsigned*)(args.ws + WS_CTL) + CW_TS + (int)blockIdx.x * 32, (k_), F.wave}
#else
struct PreWait { XcdBarrier b; bool on; __device__ __forceinline__ void operator()() const { if (on) xcd_wait(b); } };
#define PREWAIT(k_) PreWait pre{bar, multi}
#endif
__global__ void __launch_bounds__(NWAVES * 64, 2) mega(MArgs args) {
    extern __shared__ __attribute__((aligned(16))) unsigned char lds[];
    Frame F;
    F.lds = (LAS unsigned char*)lds;
    F.wave = __builtin_amdgcn_readfirstlane((int)(threadIdx.x >> 6));
    F.G = gridDim.x; { const int bx = blockIdx.x; F.vcu = (F.G % 8 == 0) ? (bx % 8) * (F.G / 8) + bx / 8 : bx; }
    unsigned char* ws = args.ws;
    gu32* ctl = (gu32*)(ws + WS_CTL);
    { int tid0 = (F.wave * 64 + lane_id()); asm volatile("" : "+v"(tid0)); for (int u = tid0; u < (LDS_BYTES - LDSCTL_OFF) / 4; u += NWAVES * 64) ((LAS unsigned*)(F.lds + LDSCTL_OFF))[u] = 0u; }
    __syncthreads();
    const int lo = args.ph_lo, hi = args.ph_hi;
    const bool multi = (hi - lo) > 1;
    XcdBarrier bar; bar.bar = (unsigned*)(ctl + CW_BAR); bar.x = 0; bar.st = nullptr; bar.w = (unsigned)F.wave;
    if (multi) bar = xcd_barrier_post((unsigned*)(ctl + CW_BAR), (volatile LAS unsigned*)(F.lds + MISC_OFF) + 8, (unsigned)F.wave);
    bf16_t* PROJ = (bf16_t*)(ws + WS_PROJ); bf16_t* MIXED = (bf16_t*)(ws + WS_MIXED); bf16_t* X1B = (bf16_t*)(ws + WS_X1B); bf16_t* XB = (bf16_t*)(ws + WS_XB);
    bf16_t* HID = (bf16_t*)(ws + WS_HID); bf16_t* PO = (bf16_t*)(ws + WS_PO); bf16_t* Y = (bf16_t*)(ws + WS_Z);
    bf16_t* AO = (bf16_t*)((unsigned char*)args.out + DO_AO); bf16_t* DIFF = (bf16_t*)((unsigned char*)args.out + DO_DIFF);
    bf16_t* AOG = (bf16_t*)((unsigned char*)args.out + DO_AOG); float* LSE = (float*)((unsigned char*)args.out + DO_LSE);
    int* cnt = (int*)(ws + WS_CTL) + CW_CNT; int* list = (int*)(ws + WS_LIST); float* listw = (float*)(ws + WS_LISTW);
#define PHASE_0 { TSTAMP(0); p0_prologue_a(F, args); TSTAMP(1); if (multi) xcd_arrive(bar); p0_prologue_b(F, args); TSTAMP(2); if (multi) xcd_wait(bar); TSTAMP(3); }
#define PHASE_1 { pg8::Gemm g{XB, (const bf16_t*)(ws + WT_WIN), DM, F.wave}; pg8::StaticOrder S; S.init(NTOK, GA_OFF, F.G, (int)blockIdx.x);     \
        pg8::EpiProj E{PROJ, args.in[2], QSCALE}; pg8::gemm_phase<pg8::EpiProj, pg8::StaticOrder, true>(F.lds + RING_OFF, g, S, E); TSTAMP(4); \
        if (multi) xcd_arrive(bar);                                     \
          \
        { const int bx = (int)blockIdx.x; if (F.G == 256) { if (bx >= 128) tr_run(F, args, TR_DENSE + ((bx - 128) * NWAVES + F.wave), 1024, TR_DENSE + 10240); \
              else tr_run(F, args, TR_DENSE + 10240 + (bx * NWAVES + F.wave), 1024, TR_DENSE + TR_EXP); } \
          else tr_run(F, args, TR_DENSE + F.vcu * NWAVES + F.wave, F.G * NWAVES, TR_DENSE + TR_EXP); } \
        TSTAMP(5); if (multi) xcd_wait(bar); TSTAMP(6); }
#define PHASE_2 { phase_attn(F, args, PROJ, AOG, LSE); TSTAMP(7); if (multi) xcd_arrive(bar); }
#define PHASE_3 { phase_pool(F, PROJ, DIFF); TSTAMP(8); if (multi) xcd_wait(bar); TSTAMP(9); phase_combine(F, AOG, LSE, AO); TSTAMP(10); if (multi) xcd_arrive(bar); }
#define PHASE_4 { pg8::GemmGM g{XB, (const bf16_t*)(ws + WT_WIN), AO, (const bf16_t*)(ws + WT_WPA), DIFF, (const bf16_t*)(ws + WT_WEFF), args.in[2], MIXED, F.wave}; \
        pg8::StaticOrder S; S.init(NTOK, 2 * DM, F.G, (int)blockIdx.x);     \
        PREWAIT(11); pg8::gemm_phase_gm<pg8::StaticOrder>(F.lds + RING_OFF, g, S, pre); TSTAMP(13); }
#define PHASE_5 { }
#define PHASE_6 { TSTAMP(14); pg8::Gemm g{MIXED, (const bf16_t*)(ws + WT_WOUT), DM, F.wave}; pg8::StaticOrder S; S.init(NTOK, DM, F.G, (int)blockIdx.x); \
        pg8::EpiY E{Y}; pg8::gemm_phase<pg8::EpiY, pg8::StaticOrder, true>(F.lds + RING_OFF, g, S, E); TSTAMP(15); if (multi) xcd_arrive(bar); }
#define PHASE_7 { PREWAIT(16); phase_ln_router(F, args, Y, X1B, cnt, list, listw, pre); TSTAMP(18); }
#define PHASE_8 { TSTAMP(19); const int ntiles = moe_tables(F, cnt); { pg8::Gemm g{X1B, (const bf16_t*)(ws + WT_WGU), DM, F.wave}; \
        pg8::MoeOrder S{(const LAS int*)(F.lds + TILE_E_OFF), (const LAS int*)(F.lds + FIRST_OFF), cnt, list, 2, F.G, F.vcu, ntiles, true, (unsigned*)(ctl + CW_READY)}; \
        pg8::EpiMoe1 E{HID, cnt, listw}; pg8::gemm_phase<pg8::EpiMoe1, pg8::MoeOrder, true>(F.lds + RING_OFF, g, S, E); } TSTAMP(20); \
          \
        { pg8::Gemm g{HID, (const bf16_t*)(ws + WT_WD), DEXP, F.wave}; \
        pg8::DynMoeOrder S{(const LAS int*)(F.lds + TILE_E_OFF), (const LAS int*)(F.lds + FIRST_OFF), 4, ntiles, (unsigned*)(ctl + CW_Q9), (const unsigned*)(ctl + CW_READY), 16u, (unsigned*)(ctl + CW_TMO), (volatile LAS int*)(F.lds + MISC_OFF + 64), F.wave}; \
        pg8::EpiMoe2 E{PO, cnt, list}; pg8::gemm_phase<pg8::EpiMoe2, pg8::DynMoeOrder, true>(F.lds + RING_OFF, g, S, E); } TSTAMP(21); }
#define PHASE_9 { }
#ifdef TPROBE
#define PHASE_10 { float pscale = 1.f, pbump = 0.f; if (multi) { unsigned* tsb = (unsigned*)(args.ws + WS_CTL) + CW_TS + (int)blockIdx.x * 32; unsigned* acc = (unsigned*)(args.ws + WS_CTL) + CW_ACC; \
        if (F.wave == 0 && lane_id() == 0) { __hip_atomic_store(tsb + 22, (unsigned)__builtin_amdgcn_s_memrealtime(), __ATOMIC_RELAXED, __HIP_MEMORY_SCOPE_AGENT); \
            const unsigned d1 = __hip_atomic_load(tsb + TP_B, __ATOMIC_RELAXED, __HIP_MEMORY_SCOPE_AGENT) - __hip_atomic_load(tsb + TP_A, __ATOMIC_RELAXED, __HIP_MEMORY_SCOPE_AGENT); \
            const unsigned d2 = __hip_atomic_load(tsb + TP_D, __ATOMIC_RELAXED, __HIP_MEMORY_SCOPE_AGENT) - __hip_atomic_load(tsb + TP_C, __ATOMIC_RELAXED, __HIP_MEMORY_SCOPE_AGENT); \
            atomicAdd(acc + 0, d1); atomicMax(acc + 1, d1); atomicAdd(acc + 2, d2); atomicMax(acc + 3, d2); } \
        xcd_barrier(bar); \
        const float v1 = TP_M1 ? (float)__hip_atomic_load(acc + 1, __ATOMIC_RELAXED, __HIP_MEMORY_SCOPE_AGENT) : (float)__hip_atomic_load(acc + 0, __ATOMIC_RELAXED, __HIP_MEMORY_SCOPE_AGENT) * (1.f / 256.f); \
        const float v2 = TP_M2 ? (float)__hip_atomic_load(acc + 3, __ATOMIC_RELAXED, __HIP_MEMORY_SCOPE_AGENT) : (float)__hip_atomic_load(acc + 2, __ATOMIC_RELAXED, __HIP_MEMORY_SCOPE_AGENT) * (1.f / 256.f); \
        pscale = 0.988f - (float)(TP_E) * v1 * 0.01f / (float)(TP_T1); pbump = 30.f * v2 * 0.01f / (float)(TP_T2); } \
        phase_final(F, args, X1B, PO, pscale, pbump); }
#else
#define PHASE_10 phase_final(F, args, X1B, PO);
#endif
#define IN(k) (lo <= (k) && (k) < hi)
#define SEAM(k) do { if (IN(k) && (k) + 1 < hi) xcd_barrier(bar); } while (0)
#define RUN(k, BODY) do { if (IN(k)) { BODY SEAM(k); } } while (0)
    if (IN(0)) PHASE_0
    if (IN(1)) PHASE_1
    if (IN(2)) PHASE_2
    if (IN(3)) PHASE_3
    RUN(4, PHASE_4);
    if (IN(6)) PHASE_6
    RUN(7, PHASE_7);
    RUN(8, PHASE_8);
    RUN(10, PHASE_10);
#undef IN
#undef SEAM
#undef RUN
}

#ifndef SINGLE_LAUNCH
#define SINGLE_LAUNCH 1
#endif
constexpr int NPHASES = 11;
#ifndef DUP_MASK
#define DUP_MASK 0
#endif
extern "C" void kernel_launch(void* const* d_in, const int* in_sizes, int n_in, void* d_out, int out_size, void* d_ws, size_t ws_size, hipStream_t stream) {
    static int grid = 0;
    if (grid == 0) {
        if (n_in != 20 || in_sizes[0] != NTOK * DM || out_size != NTOK * DM || ws_size < WS_END) {
            fprintf(stderr, "kernel_launch: unexpected shapes (n_in %d, in0 %d, out %d, ws %zu)\n", n_in, n_in > 0 ? in_sizes[0] : -1, out_size, ws_size); grid = -1; return; }
        int dev = 0, cus = 0, per_cu = 0;
        if (hipGetDevice(&dev) != hipSuccess || hipDeviceGetAttribute(&cus, hipDeviceAttributeMultiprocessorCount, dev) != hipSuccess) { grid = -1; return; }
        if (hipFuncSetAttribute((const void*)mega, hipFuncAttributeMaxDynamicSharedMemorySize, LDS_BYTES) != hipSuccess) { fprintf(stderr, "kernel_launch: hipFuncSetAttribute failed\n"); grid = -1; return; }
        if (hipOccupancyMaxActiveBlocksPerMultiprocessor(&per_cu, (const void*)mega, NWAVES * 64, LDS_BYTES) != hipSuccess || per_cu < 1) {
            fprintf(stderr, "kernel_launch: occupancy query reports %d workgroups per CU\n", per_cu); (void)hipGetLastError(); grid = -1; return; }
        if (cus != 256) { fprintf(stderr, "kernel_launch: built for a 256-CU device (LDS tables of the LN/router phase are sized for 8 token tiles per workgroup); found %d CUs\n", cus); grid = -1; return; }
        grid = cus;
    }
    if (grid < 0) return;
    (void)hipMemsetAsync((unsigned char*)d_ws + WS_CTL, 0, CTL_ZERO_BYTES, stream);
    MArgs a{};
    for (int i = 0; i < 20; ++i) a.in[i] = (const float*)d_in[i];
    a.out = (float*)d_out; a.ws = (unsigned char*)d_ws;
    if (SINGLE_LAUNCH) { a.ph_lo = 0; a.ph_hi = NPHASES; hipLaunchKernelGGL(mega, dim3(grid), dim3(NWAVES * 64), LDS_BYTES, stream, a); return; }
    for (int p = 0; p < NPHASES; ++p) { a.ph_lo = p; a.ph_hi = p + 1;
        for (int rep = 0; rep < 1 + ((DUP_MASK >> p) & 1); ++rep) { if (rep && p == 7) (void)hipMemsetAsync((unsigned char*)d_ws + WS_CTL, 0, 8192, stream); hipLaunchKernelGGL(mega, dim3(grid), dim3(NWAVES * 64), LDS_BYTES, stream, a); } }
}
```

```cpp
#define SINGLE_LAUNCH 1
#include <hip/hip_runtime.h>
#include <cstdint>
#include <cstdio>

typedef unsigned short bf16_t;
typedef short bf16x8 __attribute__((ext_vector_type(8)));
typedef float f32x4 __attribute__((ext_vector_type(4)));

constexpr int BATCH = 16, SEQ = 2048, DM = 1024, NTOK = BATCH * SEQ;
constexpr int QKV_BSTR = SEQ + 16;
constexpr int HD = 64, ATTW = 768, AOW = 256, POOLW = 512, INW = 4864;
constexpr int Q_OFF = 0, K_OFF = 768, V_OFF = 1536, POOL_OFF = 2304, GA_OFF = 2816, GB_OFF = 3840;
constexpr int NEXP = 32, DEXP = 256, NGRP = 4, EPG = 8;
constexpr float LN_EPS = 1e-5f;
constexpr float ALPHA = 1.189207115002721f;
constexpr int MAXROWS = 65536 + NEXP * 256;

constexpr size_t MiB = 1u << 20;
constexpr size_t WS_PROJ = 0;
constexpr size_t WS_PO = 0;
constexpr size_t WS_HID = 130 * MiB;
constexpr size_t WS_Z = 166 * MiB;
constexpr size_t WS_MIXED = 304 * MiB;
constexpr size_t WS_X1B = 368 * MiB;
constexpr size_t WS_WT = 432 * MiB;
constexpr size_t WS_CTL = 500 * MiB;
constexpr size_t WS_LIST = 501 * MiB;
constexpr size_t WS_LISTW = 505 * MiB;
constexpr size_t WS_TINFO = 509 * MiB;
constexpr size_t WS_END = 512 * MiB;
constexpr size_t DO_AO = 0, DO_DIFF = 16 * MiB, DO_AOG = 48 * MiB, DO_LSE = 96 * MiB;

__device__ __forceinline__ int lane_id() { int l; asm volatile("v_mbcnt_lo_u32_b32 %0, -1, 0\n\tv_mbcnt_hi_u32_b32 %0, -1, %0" : "=v"(l)); return l; }
__device__ __forceinline__ bf16_t f2bf(float f) { unsigned u = __float_as_uint(f); return (bf16_t)((u + 0x7fffu + ((u >> 16) & 1u)) >> 16); }
__device__ __forceinline__ float bf2f(bf16_t h) { return __uint_as_float(((unsigned)h) << 16); }
__device__ __forceinline__ bf16_t cvt_in(float v) { return f2bf(v); }
__device__ __forceinline__ bf16_t cvt_in(bf16_t v) { return v; }
__device__ __forceinline__ float sigmoidf_(float v) { return 1.f / (1.f + __expf(-v)); }
#define DPP_ADD(v, CTRL) ((v) + __builtin_bit_cast(float, __builtin_amdgcn_update_dpp(0, __builtin_bit_cast(int, (v)), (CTRL), 0xf, 0xf, true)))
__device__ __forceinline__ float wave_sum(float v) {
    v = DPP_ADD(v, 0xB1);
    v = DPP_ADD(v, 0x4E);
    v = DPP_ADD(v, 0x141);
    v = DPP_ADD(v, 0x140);
    const int iv = __builtin_bit_cast(int, v);
    return (__builtin_bit_cast(float, __builtin_amdgcn_readlane(iv, 0)) + __builtin_bit_cast(float, __builtin_amdgcn_readlane(iv, 16)))
         + (__builtin_bit_cast(float, __builtin_amdgcn_readlane(iv, 32)) + __builtin_bit_cast(float, __builtin_amdgcn_readlane(iv, 48)));
}
__device__ __forceinline__ float wave_max(float v) {
#pragma unroll
    for (int o = 1; o < 64; o <<= 1) v = fmaxf(v, __shfl_xor(v, o));
    return v;
}

__device__ __forceinline__ int t5_bucket(int dist) {
    if (dist < 16) return dist;
    const float d = (float)dist;
    int large = 16 + (int)(logf(d / 16.0f) / logf(128.0f) * 16.0f);
    return large < 31 ? large : 31;
}


namespace pg8 {
#define PG8_LAS __attribute__((address_space(3)))
typedef unsigned u32x4 __attribute__((ext_vector_type(4)));
typedef unsigned u32x2 __attribute__((ext_vector_type(2)));
constexpr int BM = 256, BK = 64, HALF = 128, HTB = HALF * BK * 2  , STAGE_BYTES = 8 * HTB, NXCD = 8, WGM = 8;

__host__ __device__ __forceinline__ int lds_byte(int r, int c) { const int st = (r >> 4) * 2 + (c >> 5), rr = r & 15, cc = c & 31, ob = rr * 64 + cc * 2; return st * 1024 + (ob ^ (((ob >> 9) & 1) << 5)); }
__host__ __device__ __forceinline__ void stage_rc(int b, int& R, int& C) { const int st = b / 1024, sb = b % 1024, swz = sb ^ (((sb >> 9) & 1) << 5); R = (st >> 1) * 16 + swz / 64; C = (st & 1) * 32 + (swz % 64) / 2; }
__host__ __device__ __forceinline__ int perm32(int rho) { const int n = rho >> 4, i = rho & 15; return 8 * (i >> 2) + 4 * n + (i & 3); }

struct Unit { int pm, pn, e, rt; };
struct Gemm { const bf16_t* A; const bf16_t* Bt; int K; int wave; int noepi; };

struct StaticOrder {
    int nM, nN, nwg, G, c;
    __device__ void init(int M, int N, int G_, int c_) { nM = M / BM; nN = N / BM; nwg = nM * nN; G = G_; c = c_; }
    __device__ bool next(int i, Unit& u) const {
        const long L = (long)i * G + c; if (L >= nwg) return false;
        int wgid = (int)L; { const int q = nwg / NXCD, r = nwg % NXCD, xcd = wgid % NXCD, off = wgid / NXCD; wgid = (xcd < r ? xcd * (q + 1) : r * (q + 1) + (xcd - r) * q) + off; }
        const int nig = WGM * nN, gid = wgid / nig, fm = gid * WGM, gsz = (nM - fm) < WGM ? (nM - fm) : WGM;
        u.pm = fm + ((wgid % nig) % gsz); u.pn = (wgid % nig) / gsz; u.e = 0; u.rt = 0; return true;
    }
    __device__ __forceinline__ int arow(const Unit& u, int r) const { return u.pm * BM + r; }
    __device__ __forceinline__ void done(const Unit&) const {}
};

struct MoeOrder {
    const PG8_LAS int* tile_e; const PG8_LAS int* first; const int* cnt; const int* list; int nN, G, c, ntiles; bool gather; unsigned* ready;
    __device__ bool next(int i, Unit& u) const {
        const int L = i * G + c; if (L >= ntiles * nN) return false;
        const int rt = L / nN, pn = L - rt * nN, e = tile_e[rt];
        u.pm = rt; u.pn = e * nN + pn; u.e = e; u.rt = rt - first[e]; return true;
    }
    __device__ __forceinline__ int arow(const Unit& u, int r) const {
        if (!gather) return u.pm * BM + r;
        const int idx = u.rt * BM + r; return idx < cnt[u.e * 64] ? (list[u.e * NTOK + idx] >> 1) : 0;
    }
    __device__ __forceinline__ void done(const Unit& u) const {
        asm volatile("s_waitcnt vmcnt(0)" ::: "memory");
        if (lane_id() == 0) __hip_atomic_fetch_add(ready + 64 * u.pm, 1u, __ATOMIC_RELAXED, __HIP_MEMORY_SCOPE_AGENT);
    }
};
struct DynMoeOrder {
    const PG8_LAS int* tile_e; const PG8_LAS int* first; int nN, ntiles; unsigned* queue; const unsigned* ready; unsigned need; unsigned* tmo; volatile PG8_LAS int* slot; int wave;
    __device__ bool next(int i, Unit& u) const {
        if (wave == 0) {
            int L = 0; if (lane_id() == 0) L = (int)__hip_atomic_fetch_add(queue, 1u, __ATOMIC_RELAXED, __HIP_MEMORY_SCOPE_AGENT);
            L = __builtin_amdgcn_readfirstlane(L);
            if (L < ntiles * nN) {
                const int rt = L / nN; unsigned spins = 0;
                while ((unsigned)__builtin_amdgcn_readfirstlane(__hip_atomic_load(ready + 64 * rt, __ATOMIC_RELAXED, __HIP_MEMORY_SCOPE_AGENT)) < need) {
                    __builtin_amdgcn_s_sleep(2);
                    if (++spins > (1u << 20)) { if (lane_id() == 0) __hip_atomic_store(tmo, 1u, __ATOMIC_RELAXED, __HIP_MEMORY_SCOPE_AGENT); break; } }
                __builtin_amdgcn_fence(__ATOMIC_ACQUIRE, "agent");
                asm volatile("s_waitcnt vmcnt(0)" ::: "memory");
            } else L = -1;
            if (lane_id() == 0) slot[i & 1] = L;
            asm volatile("s_waitcnt lgkmcnt(0)" ::: "memory");
        }
        __builtin_amdgcn_s_barrier(); asm volatile("" ::: "memory");
        const int L = slot[i & 1]; if (L < 0) return false;
        const int rt = L / nN, pn = L - rt * nN, e = tile_e[rt];
        u.pm = rt; u.pn = e * nN + pn; u.e = e; u.rt = rt - first[e]; return true;
    }
    __device__ __forceinline__ int arow(const Unit& u, int r) const { return u.pm * BM + r; }
    __device__ __forceinline__ void done(const Unit&) const {}
};

__device__ __forceinline__ unsigned cvt_pk_bf16(float lo, float hi) { unsigned r; asm volatile("v_cvt_pk_bf16_f32 %0, %1, %2" : "=v"(r) : "v"(lo), "v"(hi)); return r; }
__device__ __forceinline__ float bflo(unsigned w) { return __uint_as_float(w << 16); }
__device__ __forceinline__ float bfhi(unsigned w) { return __uint_as_float(w & 0xffff0000u); }
__device__ __forceinline__ float fsig(float v) { return __builtin_amdgcn_rcpf(1.f + __builtin_amdgcn_exp2f(-1.4426950408889634f * v)); }
__device__ __forceinline__ float fsig_gate(float v) { return fmaxf(fsig(v), 1.0e-7f); }

struct EpiProj {
    static constexpr bool PERM = true;
    bf16_t* O; const float* bias; float qscale; int pf;
    __device__ __forceinline__ void operator()(const f32x4 (&acc)[2][2][4][2], const Unit& u, int wr, int wc, int fr, int fq) const {
        const int row0 = u.pm * BM + wr * 64 + fr, lc0 = wc * 32 + 8 * fq;
        const bool gate = u.pn >= 11;
        const int lg = (u.pn < 9) ? 2 * (u.pn % 3) : 0, bstr = (u.pn < 9) ? QKV_BSTR : SEQ;
        const int cb0 = gate ? GA_OFF + (u.pn - 11) * HALF + lc0 : u.pn * BM + lc0, cb1 = gate ? GB_OFF + (u.pn - 11) * HALF + lc0 : u.pn * BM + HALF + lc0;
        f32x4 bv[2][2];
#pragma unroll
        for (int n = 0; n < 2; ++n) { bv[0][n] = *(const f32x4*)(bias + cb0 + 4 * n); bv[1][n] = *(const f32x4*)(bias + cb1 + 4 * n); }
#pragma unroll
        for (int ai = 0; ai < 2; ++ai)
#pragma unroll
            for (int m = 0; m < 4; ++m) { const int rg = row0 + ai * HALF + m * 16, t = rg & (SEQ - 1), cm = t & ((1 << lg) - 1), prow = (rg >> 11) * bstr + (cm << (11 - lg)) + cm + (t >> lg);
                bf16_t* rowp = O + (size_t)prow * INW;
                f32x4 a0 = acc[ai][0][m][0] + bv[0][0], a1 = acc[ai][0][m][1] + bv[0][1], b0 = acc[ai][1][m][0] + bv[1][0], b1 = acc[ai][1][m][1] + bv[1][1];
                if (u.pn < 3) { a0 = a0 * qscale; a1 = a1 * qscale; b0 = b0 * qscale; b1 = b1 * qscale; }
                if (gate) {
#pragma unroll
                    for (int i = 0; i < 4; ++i) { const float s0 = fsig_gate(b0[i]), s1 = fsig_gate(b1[i]); a0[i] = fsig(a0[i]) * __builtin_amdgcn_rcpf(s0); a1[i] = fsig(a1[i]) * __builtin_amdgcn_rcpf(s1); b0[i] = s0; b1[i] = s1; } }
                u32x4 w; w.x = cvt_pk_bf16(a0[0], a0[1]); w.y = cvt_pk_bf16(a0[2], a0[3]); w.z = cvt_pk_bf16(a1[0], a1[1]); w.w = cvt_pk_bf16(a1[2], a1[3]);
#ifdef NOEPI_PROBE
                bf16_t* p0 = rowp + cb0; bf16_t* p1 = rowp + cb1;
                if (pf & 512) { const size_t pr2 = (size_t)(prow + (t & ((1 << lg) - 1))); p0 = O + pr2 * INW + cb0; p1 = O + pr2 * INW + cb1; }
                if (pf & 256) { p0 = O + (size_t)rg * INW + cb0; p1 = O + (size_t)rg * INW + cb1; }
                if (pf & 16) { const size_t slot = ((size_t)(((int)blockIdx.x * 8 + wr * 4 + wc) * 8 + ai * 4 + m) * 2) * 512 + (size_t)(fq * 16 + fr) * 8 + (size_t)((pf & 32) ? (u.pn % 6) : 0) * 16777216; p0 = O + slot; p1 = O + slot + 512; }
                if (pf & 64) { const int ln = fq * 16 + fr; const int r8 = u.pm * BM + ai * HALF + wr * 64 + m * 16 + (ln >> 3);
                    p0 = O + (size_t)r8 * INW + u.pn * BM + wc * 64 + (ln & 7) * 8; p1 = p0 + (size_t)8 * INW; }
                if (pf & 128) { const size_t slot = ((size_t)(((int)blockIdx.x * 8 + wr * 4 + wc) * 8 + ai * 4 + m) * 2) * 1024 + (size_t)fr * 64 + fq * 8 + (size_t)(u.pn % 6) * 33554432; p0 = O + slot; p1 = O + slot + 32; }
                *(u32x4*)p0 = w;
                w.x = cvt_pk_bf16(b0[0], b0[1]); w.y = cvt_pk_bf16(b0[2], b0[3]); w.z = cvt_pk_bf16(b1[0], b1[1]); w.w = cvt_pk_bf16(b1[2], b1[3]);
                *(u32x4*)p1 = w; }
#else
                *(u32x4*)(rowp + cb0) = w;
                w.x = cvt_pk_bf16(b0[0], b0[1]); w.y = cvt_pk_bf16(b0[2], b0[3]); w.z = cvt_pk_bf16(b1[0], b1[1]); w.w = cvt_pk_bf16(b1[2], b1[3]);
                *(u32x4*)(rowp + cb1) = w; }
#endif
    }
};
template <bool ACCUM> struct EpiGate {
    static constexpr bool PERM = true;
    bf16_t* O; const bf16_t* gate;
    __device__ __forceinline__ void operator()(const f32x4 (&acc)[2][2][4][2], const Unit& u, int wr, int wc, int fr, int fq) const {
        const int row0 = u.pm * BM + wr * 64 + fr, col0 = u.pn * BM + wc * 32 + 8 * fq;
#pragma unroll
        for (int ai = 0; ai < 2; ++ai)
#pragma unroll
            for (int m = 0; m < 4; ++m) { const size_t r = (size_t)(row0 + ai * HALF + m * 16);
#pragma unroll
                for (int bj = 0; bj < 2; ++bj) {
                    const u32x4 gw = *(const u32x4*)(gate + r * INW + col0 + bj * HALF);
                    bf16_t* op = O + r * DM + col0 + bj * HALF;
                    f32x4 v0 = acc[ai][bj][m][0], v1 = acc[ai][bj][m][1];
                    v0[0] *= bflo(gw.x); v0[1] *= bfhi(gw.x); v0[2] *= bflo(gw.y); v0[3] *= bfhi(gw.y);
                    v1[0] *= bflo(gw.z); v1[1] *= bfhi(gw.z); v1[2] *= bflo(gw.w); v1[3] *= bfhi(gw.w);
                    if (ACCUM) { const u32x4 ow = *(const u32x4*)op;
                        v0[0] += bflo(ow.x); v0[1] += bfhi(ow.x); v0[2] += bflo(ow.y); v0[3] += bfhi(ow.y);
                        v1[0] += bflo(ow.z); v1[1] += bfhi(ow.z); v1[2] += bflo(ow.w); v1[3] += bfhi(ow.w); }
                    u32x4 w; w.x = cvt_pk_bf16(v0[0], v0[1]); w.y = cvt_pk_bf16(v0[2], v0[3]); w.z = cvt_pk_bf16(v1[0], v1[1]); w.w = cvt_pk_bf16(v1[2], v1[3]);
                    *(u32x4*)op = w; } }
    }
};
struct EpiMix {
    static constexpr bool PERM = true;
    bf16_t* O; const bf16_t* ga; const bf16_t* gb;
    __device__ __forceinline__ void mid(f32x4 (&acc)[2][2][4][2], const Unit& u, int wr, int wc, int fr, int fq) const {
        int row0 = u.pm * BM + wr * 64 + fr, col0 = u.pn * BM + wc * 32 + 8 * fq;
        asm volatile("" : "+v"(row0), "+v"(col0));
#pragma unroll
        for (int ai = 0; ai < 2; ++ai)
#pragma unroll
            for (int m = 0; m < 4; ++m) { const size_t r = (size_t)(row0 + ai * HALF + m * 16);
#pragma unroll
                for (int bj = 0; bj < 2; ++bj) {
                    const u32x4 a = *(const u32x4*)(ga + r * INW + col0 + bj * HALF);
                    f32x4& v0 = acc[ai][bj][m][0]; f32x4& v1 = acc[ai][bj][m][1];
                    v0[0] *= bflo(a.x); v0[1] *= bfhi(a.x); v0[2] *= bflo(a.y); v0[3] *= bfhi(a.y);
                    v1[0] *= bflo(a.z); v1[1] *= bfhi(a.z); v1[2] *= bflo(a.w); v1[3] *= bfhi(a.w); }
                if (m == 3) asm volatile("" ::: "memory"); }
    }
    __device__ __forceinline__ void operator()(const f32x4 (&acc)[2][2][4][2], const Unit& u, int wr, int wc, int fr, int fq) const {
        const int row0 = u.pm * BM + wr * 64 + fr, col0 = u.pn * BM + wc * 32 + 8 * fq;
#pragma unroll
        for (int ai = 0; ai < 2; ++ai)
#pragma unroll
            for (int m = 0; m < 4; ++m) { const size_t r = (size_t)(row0 + ai * HALF + m * 16);
#pragma unroll
                for (int bj = 0; bj < 2; ++bj) {
                    const u32x4 b = *(const u32x4*)(gb + r * INW + col0 + bj * HALF);
                    const f32x4 v0 = acc[ai][bj][m][0], v1 = acc[ai][bj][m][1];
                    u32x4 w; w.x = cvt_pk_bf16(v0[0] * bflo(b.x), v0[1] * bfhi(b.x)); w.y = cvt_pk_bf16(v0[2] * bflo(b.y), v0[3] * bfhi(b.y));
                    w.z = cvt_pk_bf16(v1[0] * bflo(b.z), v1[1] * bfhi(b.z)); w.w = cvt_pk_bf16(v1[2] * bflo(b.w), v1[3] * bfhi(b.w));
                    *(u32x4*)(O + r * DM + col0 + bj * HALF) = w; }
                if (m == 3) asm volatile("" ::: "memory"); }
    }
};
struct EpiY {
    static constexpr bool PERM = true;
    bf16_t* Y;
    __device__ __forceinline__ void operator()(const f32x4 (&acc)[2][2][4][2], const Unit& u, int wr, int wc, int fr, int fq) const {
        const int col0 = u.pn * BM + wc * 32 + 8 * fq;
#pragma unroll
        for (int ai = 0; ai < 2; ++ai)
#pragma unroll
            for (int m = 0; m < 4; ++m) { bf16_t* rowp = Y + (size_t)(u.pm * BM + ai * HALF + wr * 64 + m * 16 + fr) * DM + col0;
#pragma unroll
                for (int bj = 0; bj < 2; ++bj) { const f32x4 v0 = acc[ai][bj][m][0], v1 = acc[ai][bj][m][1];
                    u32x4 w; w.x = cvt_pk_bf16(v0[0], v0[1]); w.y = cvt_pk_bf16(v0[2], v0[3]); w.z = cvt_pk_bf16(v1[0], v1[1]); w.w = cvt_pk_bf16(v1[2], v1[3]);
                    *(u32x4*)(rowp + bj * HALF) = w; } }
    }
};
struct EpiMoe1 {
    static constexpr bool PERM = true;
    bf16_t* hid; const int* cnt; const float* listw;
    __device__ __forceinline__ void operator()(const f32x4 (&acc)[2][2][4][2], const Unit& u, int wr, int wc, int fr, int fq) const {
        const int n_e = cnt[u.e * 64], pnl = u.pn & 1, hc0 = pnl * 128 + wc * 32 + 8 * fq;
        const __amdgpu_buffer_rsrc_t rs = __builtin_amdgcn_make_buffer_rsrc(hid, 0, MAXROWS * DEXP * 2, 0x00020000);
#pragma unroll
        for (int ai = 0; ai < 2; ++ai)
#pragma unroll
            for (int m = 0; m < 4; ++m) { const int r = ai * HALF + wr * 64 + m * 16 + fr, idx = u.rt * BM + r;
                const float w = idx < n_e ? listw[u.e * NTOK + idx] : 0.f;
                float h[8];
#pragma unroll
                for (int n = 0; n < 2; ++n)
#pragma unroll
                    for (int i = 0; i < 4; ++i) { const float g = acc[ai][0][m][n][i], uu = acc[ai][1][m][n][i]; h[n * 4 + i] = w * g * fsig(g) * uu; }
                u32x4 o; o.x = cvt_pk_bf16(h[0], h[1]); o.y = cvt_pk_bf16(h[2], h[3]); o.z = cvt_pk_bf16(h[4], h[5]); o.w = cvt_pk_bf16(h[6], h[7]);
                __builtin_amdgcn_raw_buffer_store_b128(o, rs, (unsigned)(((u.pm * BM + r) * DEXP + hc0) * 2), 0,   16); }
    }
};
struct EpiMoe2 {
    static constexpr bool PERM = true;
    bf16_t* po; const int* cnt; const int* list;
    __device__ __forceinline__ void operator()(const f32x4 (&acc)[2][2][4][2], const Unit& u, int wr, int wc, int fr, int fq) const {
        const int col0 = (u.pn & 3) * BM + wc * 32 + 8 * fq, n_e = cnt[u.e * 64];
#pragma unroll
        for (int ai = 0; ai < 2; ++ai)
#pragma unroll
            for (int m = 0; m < 4; ++m) { const int r = ai * HALF + wr * 64 + m * 16 + fr, idx = u.rt * BM + r;
                const int drow = idx < n_e ? list[u.e * NTOK + idx] : 2 * NTOK + r;
                bf16_t* rowp = po + (size_t)drow * DM + col0;
#pragma unroll
                for (int bj = 0; bj < 2; ++bj) { const f32x4 v0 = acc[ai][bj][m][0], v1 = acc[ai][bj][m][1];
                    u32x4 w; w.x = cvt_pk_bf16(v0[0], v0[1]); w.y = cvt_pk_bf16(v0[2], v0[3]); w.z = cvt_pk_bf16(v1[0], v1[1]); w.w = cvt_pk_bf16(v1[2], v1[3]);
                    *(u32x4*)(rowp + bj * HALF) = w; } }
    }
};

template <class Epi, class Sched, bool ALIGN_EPI>
__device__ __forceinline__ void gemm_phase(PG8_LAS unsigned char* lds, const Gemm g, const Sched& S, const Epi& E) {
    const int wid = g.wave, lane = lane_id(), tid = wid * 64 + lane, wr = wid >> 2, wc = wid & 3, fr = lane & 15, fq = lane >> 4;
    const int K = g.K, nt = K / BK;
    int RA[2]; unsigned CA[2], voffB[2];
#pragma unroll
    for (int i = 0; i < 2; ++i) { int R, C; stage_rc(tid * 16 + i * 8192, R, C); const int Rb = Epi::PERM ? ((R & ~31) + perm32(R & 31)) : R;
        RA[i] = R; CA[i] = (unsigned)C * 2u; voffB[i] = (unsigned)(Rb * K + C) * 2u; }
    const size_t kstep = (size_t)(BK * 2);
    const size_t hstep = (size_t)HALF * K * 2;
    const size_t tstep = 2 * hstep;
    const unsigned ldsw = (unsigned)wid * 1024u;
    const int aoff = lds_byte(wr * 64 + fr, fq * 8), boff = lds_byte(wc * 32 + fr, fq * 8);
#define PG8_SA(b, h) (((b) * 2 + (h)) * HTB)
#define PG8_SB(b, h) ((4 + (b) * 2 + (h)) * HTB)
#ifdef NOEPI_PROBE
#define PG8_STAGE(bufoff, gbase, voff) do { if (!(g.noepi & 2)) { _Pragma("unroll") for (int _i = 0; _i < 2; ++_i) \
        __builtin_amdgcn_global_load_lds((const unsigned*)((const char*)(gbase) + (voff)[_i]), (PG8_LAS unsigned*)(lds + (bufoff) + ldsw + _i * 8192), 16, 0, 0); } } while (0)
#else
#define PG8_STAGE(bufoff, gbase, voff) do { _Pragma("unroll") for (int _i = 0; _i < 2; ++_i) \
        __builtin_amdgcn_global_load_lds((const unsigned*)((const char*)(gbase) + (voff)[_i]), (PG8_LAS unsigned*)(lds + (bufoff) + ldsw + _i * 8192), 16, 0, 0); } while (0)
#endif
#ifdef NOEPI_PROBE
#define PG8_LDA(dst, b, h) do { if (!(g.noepi & 8)) { _Pragma("unroll") for (int m = 0; m < 4; ++m) _Pragma("unroll") for (int k = 0; k < 2; ++k) dst[m][k] = *(const PG8_LAS bf16x8*)(lds + PG8_SA(b, h) + aoff + m * 2048 + k * 1024); } } while (0)
#define PG8_LDB(dst, b, h) do { if (!(g.noepi & 8)) { _Pragma("unroll") for (int n = 0; n < 2; ++n) _Pragma("unroll") for (int k = 0; k < 2; ++k) dst[n][k] = *(const PG8_LAS bf16x8*)(lds + PG8_SB(b, h) + boff + n * 2048 + k * 1024); } } while (0)
#else
#define PG8_LDA(dst, b, h) do { _Pragma("unroll") for (int m = 0; m < 4; ++m) _Pragma("unroll") for (int k = 0; k < 2; ++k) dst[m][k] = *(const PG8_LAS bf16x8*)(lds + PG8_SA(b, h) + aoff + m * 2048 + k * 1024); } while (0)
#define PG8_LDB(dst, b, h) do { _Pragma("unroll") for (int n = 0; n < 2; ++n) _Pragma("unroll") for (int k = 0; k < 2; ++k) dst[n][k] = *(const PG8_LAS bf16x8*)(lds + PG8_SB(b, h) + boff + n * 2048 + k * 1024); } while (0)
#endif
#ifdef NOEPI_PROBE
#define PG8_MMA(ai, bj, At, Bt) do { if (!(g.noepi & 4)) { __builtin_amdgcn_s_setprio(1); _Pragma("unroll") for (int m = 0; m < 4; ++m) _Pragma("unroll") for (int n = 0; n < 2; ++n) _Pragma("unroll") for (int k = 0; k < 2; ++k) \
        acc[ai][bj][m][n] = __builtin_amdgcn_mfma_f32_16x16x32_bf16(Bt[n][k], At[m][k], acc[ai][bj][m][n], 0, 0, 0); __builtin_amdgcn_s_setprio(0); } } while (0)
#else
#define PG8_MMA(ai, bj, At, Bt) do { __builtin_amdgcn_s_setprio(1); _Pragma("unroll") for (int m = 0; m < 4; ++m) _Pragma("unroll") for (int n = 0; n < 2; ++n) _Pragma("unroll") for (int k = 0; k < 2; ++k) \
        acc[ai][bj][m][n] = __builtin_amdgcn_mfma_f32_16x16x32_bf16(Bt[n][k], At[m][k], acc[ai][bj][m][n], 0, 0, 0); __builtin_amdgcn_s_setprio(0); } while (0)
#endif
#define PG8_WAIT_V(n) asm volatile("s_waitcnt vmcnt(" #n ")" ::: "memory")
#define PG8_WAIT_L(n) asm volatile("s_waitcnt lgkmcnt(" #n ")" ::: "memory")
#define PG8_BAR __builtin_amdgcn_s_barrier()
#define PG8_SCHED __builtin_amdgcn_sched_barrier(0)
#define PG8_AOFF(dst, U) do { _Pragma("unroll") for (int _h = 0; _h < 2; ++_h) _Pragma("unroll") for (int _i = 0; _i < 2; ++_i) \
        dst[_h][_i] = (unsigned)S.arow(U, _h * HALF + RA[_i]) * (unsigned)(K * 2) + CA[_i]; } while (0)
    Unit cur, nxt; int ui = 0;
    if (!S.next(0, cur)) return;
    f32x4 acc[2][2][4][2];
#pragma unroll
    for (int a = 0; a < 2; ++a)
#pragma unroll
        for (int b = 0; b < 2; ++b)
#pragma unroll
            for (int m = 0; m < 4; ++m)
#pragma unroll
                for (int n = 0; n < 2; ++n) acc[a][b][m][n] = (f32x4){0.f, 0.f, 0.f, 0.f};
    bf16x8 At[4][2], B0[2][2], B1[2][2];
    unsigned offC[2][2], offN[2][2];
    PG8_AOFF(offC, cur);
    const char* A0 = (const char*)g.A;
    const char* cB = (const char*)g.Bt + (size_t)cur.pn * tstep;
    PG8_STAGE(PG8_SB(0, 0), cB, voffB); PG8_STAGE(PG8_SB(0, 1), cB + hstep, voffB); PG8_STAGE(PG8_SA(0, 0), A0, offC[0]); PG8_STAGE(PG8_SA(0, 1), A0, offC[1]);
    if (wr == 1) PG8_BAR;
    PG8_WAIT_V(2); PG8_BAR;
    PG8_STAGE(PG8_SB(1, 0), cB + kstep, voffB); PG8_STAGE(PG8_SA(1, 0), A0 + kstep, offC[0]); PG8_STAGE(PG8_SB(1, 1), cB + hstep + kstep, voffB);
    PG8_WAIT_V(6); PG8_BAR;
    for (;;) {
        const bool has_next = S.next(ui + 1, nxt);
        if (has_next) PG8_AOFF(offN, nxt);
        const char* nB = has_next ? (const char*)g.Bt + (size_t)nxt.pn * tstep : cB;
#pragma unroll 1
        for (int t = 0; t < nt; t += 2) {
            const bool last = (t == nt - 2);
            const char* a1 = A0 + (size_t)(t + 1) * kstep;
            const char* a2 = last ? A0 : A0 + (size_t)(t + 2) * kstep; const char* b2 = last ? nB : cB + (size_t)(t + 2) * kstep;
            const char* a3 = a2 + kstep; const char* b3 = b2 + kstep;
            PG8_LDB(B0, 0, 0); PG8_LDB(B1, 0, 1); PG8_SCHED; PG8_LDA(At, 0, 0); PG8_STAGE(PG8_SA(1, 1), a1, offC[1]);
            if (last && has_next) {
#pragma unroll
                for (int _h = 0; _h < 2; ++_h)
#pragma unroll
                    for (int _i = 0; _i < 2; ++_i) offC[_h][_i] = offN[_h][_i];
            }
            PG8_WAIT_V(8); PG8_WAIT_L(0); PG8_BAR; PG8_MMA(0, 0, At, B0); PG8_MMA(0, 1, At, B1); PG8_BAR; PG8_SCHED;
            PG8_LDA(At, 0, 1); PG8_STAGE(PG8_SB(0, 0), b2, voffB); PG8_STAGE(PG8_SB(0, 1), b2 + hstep, voffB); PG8_STAGE(PG8_SA(0, 0), a2, offC[0]);
            PG8_WAIT_V(8); PG8_WAIT_L(0); PG8_BAR; PG8_MMA(1, 0, At, B0); PG8_MMA(1, 1, At, B1); PG8_BAR; PG8_SCHED;
            PG8_LDB(B0, 1, 0); PG8_LDB(B1, 1, 1); PG8_SCHED; PG8_LDA(At, 1, 0); PG8_STAGE(PG8_SA(0, 1), a2, offC[1]);
            PG8_WAIT_V(8); PG8_WAIT_L(0); PG8_BAR; PG8_MMA(0, 0, At, B0); PG8_MMA(0, 1, At, B1); PG8_BAR; PG8_SCHED;
            PG8_LDA(At, 1, 1); PG8_STAGE(PG8_SB(1, 0), b3, voffB); PG8_STAGE(PG8_SB(1, 1), b3 + hstep, voffB); PG8_STAGE(PG8_SA(1, 0), a3, offC[0]);
            PG8_WAIT_V(8); PG8_WAIT_L(0); PG8_BAR; PG8_MMA(1, 0, At, B0); PG8_MMA(1, 1, At, B1); PG8_BAR; PG8_SCHED;
        }
        if constexpr (ALIGN_EPI) { if (wr == 0) PG8_BAR; }
#ifdef NOEPI_PROBE
        if (!(g.noepi & 1))
#endif
        E(acc, cur, wr, wc, fr, fq);
        S.done(cur);
        if (!has_next) break;
#pragma unroll
        for (int a = 0; a < 2; ++a)
#pragma unroll
            for (int b = 0; b < 2; ++b)
#pragma unroll
                for (int m = 0; m < 4; ++m)
#pragma unroll
                    for (int n = 0; n < 2; ++n) acc[a][b][m][n] = (f32x4){0.f, 0.f, 0.f, 0.f};
        cur = nxt; cB = nB; ++ui;
        if constexpr (ALIGN_EPI) { if (wr == 1) PG8_BAR; }
    }
    PG8_WAIT_V(0);
    if constexpr (!ALIGN_EPI) { if (wr == 0) PG8_BAR; }
    PG8_BAR;
#undef PG8_SA
#undef PG8_SB
#undef PG8_STAGE
#undef PG8_LDA
#undef PG8_LDB
#undef PG8_MMA
#undef PG8_WAIT_V
#undef PG8_WAIT_L
#undef PG8_BAR
#undef PG8_SCHED
#undef PG8_AOFF
}

struct Gemm2 { const bf16_t* A0; const bf16_t* B0; int K0; const bf16_t* A1; const bf16_t* B1; int K1; int wave; };
template <class Epi, class Sched, bool ALIGN_EPI>
__device__ __forceinline__ void gemm_phase2(PG8_LAS unsigned char* lds, const Gemm2 g, const Sched& S, const Epi& E) {
    const int wid = g.wave, lane = lane_id(), tid = wid * 64 + lane, wr = wid >> 2, wc = wid & 3, fr = lane & 15, fq = lane >> 4;
    const int nt0 = g.K0 / BK, nt = nt0 + g.K1 / BK;
    unsigned RA2[2], RB2[2], C2[2];
#pragma unroll
    for (int i = 0; i < 2; ++i) { int R, C; stage_rc(tid * 16 + i * 8192, R, C); const int Rb = Epi::PERM ? ((R & ~31) + perm32(R & 31)) : R;
        RA2[i] = (unsigned)R * 2u; RB2[i] = (unsigned)Rb * 2u; C2[i] = (unsigned)C * 2u; }
    const size_t kstep = (size_t)(BK * 2);
    const unsigned ldsw = (unsigned)wid * 1024u;
    const int aoff = lds_byte(wr * 64 + fr, fq * 8), boff = lds_byte(wc * 32 + fr, fq * 8);
#define PG8_SA(b, h) (((b) * 2 + (h)) * HTB)
#define PG8_SB(b, h) ((4 + (b) * 2 + (h)) * HTB)
#define PG8_STAGE(bufoff, gbase, R2, Kb) do { _Pragma("unroll") for (int _i = 0; _i < 2; ++_i) \
        __builtin_amdgcn_global_load_lds((const unsigned*)((const char*)(gbase) + ((R2)[_i] * (unsigned)(Kb) + C2[_i])), (PG8_LAS unsigned*)(lds + (bufoff) + ldsw + _i * 8192), 16, 0, 0); } while (0)
#define PG8_LDA(dst, b, h) do { _Pragma("unroll") for (int m = 0; m < 4; ++m) _Pragma("unroll") for (int k = 0; k < 2; ++k) dst[m][k] = *(const PG8_LAS bf16x8*)(lds + PG8_SA(b, h) + aoff + m * 2048 + k * 1024); } while (0)
#define PG8_LDB(dst, b, h) do { _Pragma("unroll") for (int n = 0; n < 2; ++n) _Pragma("unroll") for (int k = 0; k < 2; ++k) dst[n][k] = *(const PG8_LAS bf16x8*)(lds + PG8_SB(b, h) + boff + n * 2048 + k * 1024); } while (0)
#define PG8_MMA(ai, bj, At, Bt) do { __builtin_amdgcn_s_setprio(1); _Pragma("unroll") for (int m = 0; m < 4; ++m) _Pragma("unroll") for (int n = 0; n < 2; ++n) _Pragma("unroll") for (int k = 0; k < 2; ++k) \
        acc[ai][bj][m][n] = __builtin_amdgcn_mfma_f32_16x16x32_bf16(Bt[n][k], At[m][k], acc[ai][bj][m][n], 0, 0, 0); __builtin_amdgcn_s_setprio(0); } while (0)
#define PG8_WAIT_V(n) asm volatile("s_waitcnt vmcnt(" #n ")" ::: "memory")
#define PG8_WAIT_L(n) asm volatile("s_waitcnt lgkmcnt(" #n ")" ::: "memory")
#define PG8_BAR __builtin_amdgcn_s_barrier()
#define PG8_SCHED __builtin_amdgcn_sched_barrier(0)
#define PG8_APTR(pm_, h, tt) ((tt) < nt0 ? (const char*)g.A0 + ((size_t)((pm_) * BM + (h) * HALF) * g.K0 + (size_t)(tt) * BK) * 2 : (const char*)g.A1 + ((size_t)((pm_) * BM + (h) * HALF) * g.K1 + (size_t)((tt) - nt0) * BK) * 2)
#define PG8_BPTR(pn_, h, tt) ((tt) < nt0 ? (const char*)g.B0 + ((size_t)((pn_) * BM + (h) * HALF) * g.K0 + (size_t)(tt) * BK) * 2 : (const char*)g.B1 + ((size_t)((pn_) * BM + (h) * HALF) * g.K1 + (size_t)((tt) - nt0) * BK) * 2)
    Unit cur, nxt; int ui = 0;
    if (!S.next(0, cur)) return;
    f32x4 acc[2][2][4][2];
#pragma unroll
    for (int a = 0; a < 2; ++a)
#pragma unroll
        for (int b = 0; b < 2; ++b)
#pragma unroll
            for (int m = 0; m < 4; ++m)
#pragma unroll
                for (int n = 0; n < 2; ++n) acc[a][b][m][n] = (f32x4){0.f, 0.f, 0.f, 0.f};
    bf16x8 At[4][2], B0[2][2], B1[2][2];
    PG8_STAGE(PG8_SB(0, 0), PG8_BPTR(cur.pn, 0, 0), RB2, g.K0); PG8_STAGE(PG8_SB(0, 1), PG8_BPTR(cur.pn, 1, 0), RB2, g.K0); PG8_STAGE(PG8_SA(0, 0), PG8_APTR(cur.pm, 0, 0), RA2, g.K0); PG8_STAGE(PG8_SA(0, 1), PG8_APTR(cur.pm, 1, 0), RA2, g.K0);
    if (wr == 1) PG8_BAR;
    PG8_WAIT_V(2); PG8_BAR;
    PG8_STAGE(PG8_SB(1, 0), PG8_BPTR(cur.pn, 0, 1), RB2, g.K0); PG8_STAGE(PG8_SA(1, 0), PG8_APTR(cur.pm, 0, 1), RA2, g.K0); PG8_STAGE(PG8_SB(1, 1), PG8_BPTR(cur.pn, 1, 1), RB2, g.K0);
    PG8_WAIT_V(6); PG8_BAR;
    for (;;) {
        const bool has_next = S.next(ui + 1, nxt);
#pragma unroll 1
        for (int t = 0; t < nt; t += 2) {
            const bool last = (t == nt - 2);
            if (t == nt0) E.mid(acc, cur, wr, wc, fr, fq);
            const bool s1 = t >= nt0;
            const int t2 = last ? 0 : t + 2; const bool s2 = t2 >= nt0;
            const int pm2 = (last && has_next) ? nxt.pm : cur.pm, pn2 = (last && has_next) ? nxt.pn : cur.pn;
            const int Ks1 = s1 ? g.K1 : g.K0, Ks2 = s2 ? g.K1 : g.K0;
            const char* a1h1 = PG8_APTR(cur.pm, 1, t + 1);
            const char* a2h0 = PG8_APTR(pm2, 0, t2); const char* a2h1 = PG8_APTR(pm2, 1, t2);
            const char* b2h0 = PG8_BPTR(pn2, 0, t2); const char* b2h1 = PG8_BPTR(pn2, 1, t2);
            PG8_LDB(B0, 0, 0); PG8_LDB(B1, 0, 1); PG8_SCHED; PG8_LDA(At, 0, 0); PG8_STAGE(PG8_SA(1, 1), a1h1, RA2, Ks1);
            PG8_WAIT_V(8); PG8_WAIT_L(0); PG8_BAR; PG8_MMA(0, 0, At, B0); PG8_MMA(0, 1, At, B1); PG8_BAR; PG8_SCHED;
            PG8_LDA(At, 0, 1); PG8_STAGE(PG8_SB(0, 0), b2h0, RB2, Ks2); PG8_STAGE(PG8_SB(0, 1), b2h1, RB2, Ks2); PG8_STAGE(PG8_SA(0, 0), a2h0, RA2, Ks2);
            PG8_WAIT_V(8); PG8_WAIT_L(0); PG8_BAR; PG8_MMA(1, 0, At, B0); PG8_MMA(1, 1, At, B1); PG8_BAR; PG8_SCHED;
            PG8_LDB(B0, 1, 0); PG8_LDB(B1, 1, 1); PG8_SCHED; PG8_LDA(At, 1, 0); PG8_STAGE(PG8_SA(0, 1), a2h1, RA2, Ks2);
            PG8_WAIT_V(8); PG8_WAIT_L(0); PG8_BAR; PG8_MMA(0, 0, At, B0); PG8_MMA(0, 1, At, B1); PG8_BAR; PG8_SCHED;
            PG8_LDA(At, 1, 1); PG8_STAGE(PG8_SB(1, 0), b2h0 + kstep, RB2, Ks2); PG8_STAGE(PG8_SB(1, 1), b2h1 + kstep, RB2, Ks2); PG8_STAGE(PG8_SA(1, 0), a2h0 + kstep, RA2, Ks2);
            PG8_WAIT_V(8); PG8_WAIT_L(0); PG8_BAR; PG8_MMA(1, 0, At, B0); PG8_MMA(1, 1, At, B1); PG8_BAR; PG8_SCHED;
        }
        if constexpr (ALIGN_EPI) { if (wr == 0) PG8_BAR; }
        E(acc, cur, wr, wc, fr, fq);
        if (!has_next) break;
#pragma unroll
        for (int a = 0; a < 2; ++a)
#pragma unroll
            for (int b = 0; b < 2; ++b)
#pragma unroll
                for (int m = 0; m < 4; ++m)
#pragma unroll
                    for (int n = 0; n < 2; ++n) acc[a][b][m][n] = (f32x4){0.f, 0.f, 0.f, 0.f};
        cur = nxt; ++ui;
        if constexpr (ALIGN_EPI) { if (wr == 1) PG8_BAR; }
    }
    PG8_WAIT_V(0);
    if constexpr (!ALIGN_EPI) { if (wr == 0) PG8_BAR; }
    PG8_BAR;
#undef PG8_SA
#undef PG8_SB
#undef PG8_STAGE
#undef PG8_LDA
#undef PG8_LDB
#undef PG8_MMA
#undef PG8_WAIT_V
#undef PG8_WAIT_L
#undef PG8_BAR
#undef PG8_SCHED
#undef PG8_APTR
#undef PG8_BPTR
}
struct GemmGM { const bf16_t* XB; const bf16_t* WinT; const bf16_t* AO; const bf16_t* WpaT; const bf16_t* DIFF; const bf16_t* WeffT; const float* bias; bf16_t* MIXED; int wave; };
template <class Sched, class Pre>
__device__ __forceinline__ void gemm_phase_gm(PG8_LAS unsigned char* lds, const GemmGM g, const Sched& S, const Pre& pre) {
    const int wid = g.wave, lane = lane_id(), tid = wid * 64 + lane, wr = wid >> 2, wc = wid & 3, fr = lane & 15, fq = lane >> 4;
    constexpr int NTG = DM / BK, NTA = AOW / BK, NTP = POOLW / BK, NT = NTG + NTA + NTP;
    static_assert(NTG % 2 == 0 && NTA % 2 == 0 && NTP % 2 == 0, "segment boundaries on even K-tiles");
    unsigned RCB[2];
#pragma unroll
    for (int i = 0; i < 2; ++i) { int R, C; stage_rc(tid * 16 + i * 8192, R, C); const int Rb = (R & ~31) + perm32(R & 31);
        RCB[i] = ((unsigned)Rb << 16) | ((unsigned)R << 8) | (unsigned)C; }
    const size_t kstep = (size_t)(BK * 2);
    const unsigned ldsw = (unsigned)wid * 1024u;
    const int aoff = lds_byte(wr * 64 + fr, fq * 8), boff = lds_byte(wc * 32 + fr, fq * 8);
#define PG8_SA(b, h) (((b) * 2 + (h)) * HTB)
#define PG8_SB(b, h) ((4 + (b) * 2 + (h)) * HTB)
#define RA2 8
#define RB2 16
#define PG8_STAGE(bufoff, gbase, SH, Kb) do { _Pragma("unroll") for (int _i = 0; _i < 2; ++_i) \
        __builtin_amdgcn_global_load_lds((const unsigned*)((const char*)(gbase) + ((((RCB[_i] >> (SH)) & 0xffu) * (unsigned)(Kb) + (RCB[_i] & 0xffu)) * 2u)), (PG8_LAS unsigned*)(lds + (bufoff) + ldsw + _i * 8192), 16, 0, 0); } while (0)
#define PG8_LDA(dst, b, h) do { _Pragma("unroll") for (int m = 0; m < 4; ++m) _Pragma("unroll") for (int k = 0; k < 2; ++k) dst[m][k] = *(const PG8_LAS bf16x8*)(lds + PG8_SA(b, h) + aoff + m * 2048 + k * 1024); } while (0)
#define PG8_LDB(dst, b, h) do { _Pragma("unroll") for (int n = 0; n < 2; ++n) _Pragma("unroll") for (int k = 0; k < 2; ++k) dst[n][k] = *(const PG8_LAS bf16x8*)(lds + PG8_SB(b, h) + boff + n * 2048 + k * 1024); } while (0)
#define PG8_MMA(ai, bj, At, Bt) do { __builtin_amdgcn_s_setprio(1); _Pragma("unroll") for (int m = 0; m < 4; ++m) _Pragma("unroll") for (int n = 0; n < 2; ++n) _Pragma("unroll") for (int k = 0; k < 2; ++k) \
        acc[ai][bj][m][n] = __builtin_amdgcn_mfma_f32_16x16x32_bf16(Bt[n][k], At[m][k], acc[ai][bj][m][n], 0, 0, 0); __builtin_amdgcn_s_setprio(0); } while (0)
#define PG8_WAIT_V(n) asm volatile("s_waitcnt vmcnt(" #n ")" ::: "memory")
#define PG8_WAIT_L(n) asm volatile("s_waitcnt lgkmcnt(" #n ")" ::: "memory")
#define PG8_BAR __builtin_amdgcn_s_barrier()
#define PG8_SCHED __builtin_amdgcn_sched_barrier(0)
    int kG = DM, kA = AOW, kP = POOLW; asm volatile("" : "+s"(kG), "+s"(kA), "+s"(kP));
#define GM_K(tt) ((tt) < NTG ? kG : ((tt) < NTG + NTA ? kA : kP))
#define GM_APTR(pm_, h, tt) ((tt) < NTG ? (const char*)g.XB + ((size_t)((pm_) * BM + (h) * HALF) * DM + (size_t)(tt) * BK) * 2 : \
        ((tt) < NTG + NTA ? (const char*)g.AO + ((size_t)((pm_) * BM + (h) * HALF) * AOW + (size_t)((tt) - NTG) * BK) * 2 : (const char*)g.DIFF + ((size_t)((pm_) * BM + (h) * HALF) * POOLW + (size_t)((tt) - NTG - NTA) * BK) * 2))
#define GM_BPTR(tc_, h, tt) ((tt) < NTG ? (const char*)g.WinT + ((size_t)((11 + (tc_)) * BM + (h) * HALF) * DM + (size_t)(tt) * BK) * 2 : \
        ((tt) < NTG + NTA ? (const char*)g.WpaT + ((size_t)((tc_) * HALF) * AOW + (size_t)((tt) - NTG) * BK) * 2 : (const char*)g.WeffT + ((size_t)((tc_) * HALF) * POOLW + (size_t)((tt) - NTG - NTA) * BK) * 2))
#define GM_ITER(CM, SM) do { \
        PG8_LDB(B0, 0, 0); if (CM) PG8_LDB(B1, 0, 1); PG8_SCHED; PG8_LDA(At, 0, 0); PG8_STAGE(PG8_SA(1, 1), a1h1, RA2, Kc); \
        if (CM) PG8_WAIT_V(8); else PG8_WAIT_V(6); PG8_WAIT_L(0); PG8_BAR; PG8_MMA(0, 0, At, B0); if (CM) PG8_MMA(0, 1, At, B1); PG8_BAR; PG8_SCHED; \
        PG8_LDA(At, 0, 1); PG8_STAGE(PG8_SB(0, 0), b2h0, RB2, Ks); if (SM) PG8_STAGE(PG8_SB(0, 1), b2h1, RB2, Ks); PG8_STAGE(PG8_SA(0, 0), a2h0, RA2, Ks); \
        if (SM) PG8_WAIT_V(8); else PG8_WAIT_V(6); PG8_WAIT_L(0); PG8_BAR; PG8_MMA(1, 0, At, B0); if (CM) PG8_MMA(1, 1, At, B1); PG8_BAR; PG8_SCHED; \
        PG8_LDB(B0, 1, 0); if (CM) PG8_LDB(B1, 1, 1); PG8_SCHED; PG8_LDA(At, 1, 0); PG8_STAGE(PG8_SA(0, 1), a2h1, RA2, Ks); \
        if (SM) PG8_WAIT_V(8); else PG8_WAIT_V(6); PG8_WAIT_L(0); PG8_BAR; PG8_MMA(0, 0, At, B0); if (CM) PG8_MMA(0, 1, At, B1); PG8_BAR; PG8_SCHED; \
        PG8_LDA(At, 1, 1); PG8_STAGE(PG8_SB(1, 0), b2h0 + kstep, RB2, Ks); if (SM) PG8_STAGE(PG8_SB(1, 1), b2h1 + kstep, RB2, Ks); PG8_STAGE(PG8_SA(1, 0), a2h0 + kstep, RA2, Ks); \
        if (SM) PG8_WAIT_V(8); else PG8_WAIT_V(6); PG8_WAIT_L(0); PG8_BAR; PG8_MMA(1, 0, At, B0); if (CM) PG8_MMA(1, 1, At, B1); PG8_BAR; PG8_SCHED; } while (0)
    Unit cur, nxt; int ui = 0;
    if (!S.next(0, cur)) return;
    f32x4 acc[2][2][4][2];
#pragma unroll
    for (int a = 0; a < 2; ++a)
#pragma unroll
        for (int b = 0; b < 2; ++b)
#pragma unroll
            for (int m = 0; m < 4; ++m)
#pragma unroll
                for (int n = 0; n < 2; ++n) acc[a][b][m][n] = (f32x4){0.f, 0.f, 0.f, 0.f};
    bf16x8 At[4][2], B0[2][2], B1[2][2];
    PG8_STAGE(PG8_SB(0, 0), GM_BPTR(cur.pn, 0, 0), RB2, kG); PG8_STAGE(PG8_SB(0, 1), GM_BPTR(cur.pn, 1, 0), RB2, kG); PG8_STAGE(PG8_SA(0, 0), GM_APTR(cur.pm, 0, 0), RA2, kG); PG8_STAGE(PG8_SA(0, 1), GM_APTR(cur.pm, 1, 0), RA2, kG);
    if (wr == 1) PG8_BAR;
    PG8_WAIT_V(2); PG8_BAR;
    PG8_STAGE(PG8_SB(1, 0), GM_BPTR(cur.pn, 0, 1), RB2, kG); PG8_STAGE(PG8_SA(1, 0), GM_APTR(cur.pm, 0, 1), RA2, kG); PG8_STAGE(PG8_SB(1, 1), GM_BPTR(cur.pn, 1, 1), RB2, kG);
    PG8_WAIT_V(6); PG8_BAR;
    for (;;) {
        const bool has_next = S.next(ui + 1, nxt);
        u32x2 rho[2][4][2], sgb[2][4][2];
#define GM_SETUP(t_, last_) const int t2 = (last_) ? 0 : (t_) + 2; const int pm2 = ((last_) && has_next) ? nxt.pm : cur.pm, tc2 = ((last_) && has_next) ? nxt.pn : cur.pn; \
            int Kc = GM_K(t_), Ks = GM_K(t2); asm volatile("" : "+s"(Kc), "+s"(Ks)); const char* a1h1 = GM_APTR(cur.pm, 1, (t_) + 1); \
            const char* a2h0 = GM_APTR(pm2, 0, t2); const char* a2h1 = GM_APTR(pm2, 1, t2); const char* b2h0 = GM_BPTR(tc2, 0, t2); const char* b2h1 = GM_BPTR(tc2, 1, t2)
#pragma unroll 1
        for (int t = 0; t < NTG - 2; t += 2) { GM_SETUP(t, false); GM_ITER(1, 1); }
        if (ui == 0) pre();
        { GM_SETUP(NTG - 2, false); GM_ITER(1, 0); }
        {
            int lc0 = wc * 32 + 8 * fq; asm volatile("" : "+v"(lc0));
            const float* bga = g.bias + GA_OFF + cur.pn * HALF + lc0; const float* bgb = g.bias + GB_OFF + cur.pn * HALF + lc0;
            const f32x4 ba0 = *(const f32x4*)bga, ba1 = *(const f32x4*)(bga + 4), bb0 = *(const f32x4*)bgb, bb1 = *(const f32x4*)(bgb + 4);
#pragma unroll
            for (int ai = 0; ai < 2; ++ai)
#pragma unroll
                for (int m = 0; m < 4; ++m)
#pragma unroll
                    for (int n = 0; n < 2; ++n) { const f32x4 ga = acc[ai][0][m][n] + (n ? ba1 : ba0), gb = acc[ai][1][m][n] + (n ? bb1 : bb0); float r[4], sb[4];
#pragma unroll
                        for (int i = 0; i < 4; ++i) { sb[i] = fsig_gate(gb[i]); r[i] = fsig(ga[i]) * __builtin_amdgcn_rcpf(sb[i]); }
                        rho[ai][m][n].x = cvt_pk_bf16(r[0], r[1]); rho[ai][m][n].y = cvt_pk_bf16(r[2], r[3]); sgb[ai][m][n].x = cvt_pk_bf16(sb[0], sb[1]); sgb[ai][m][n].y = cvt_pk_bf16(sb[2], sb[3]);
                        acc[ai][0][m][n] = (f32x4){0.f, 0.f, 0.f, 0.f}; }
        }
#pragma unroll 1
        for (int t = NTG; t < NTG + NTA; t += 2) { GM_SETUP(t, false); GM_ITER(0, 0); }
#pragma unroll
        for (int ai = 0; ai < 2; ++ai)
#pragma unroll
            for (int m = 0; m < 4; ++m)
#pragma unroll
                for (int n = 0; n < 2; ++n) { f32x4& v = acc[ai][0][m][n]; const u32x2 rr = rho[ai][m][n]; v[0] *= bflo(rr.x); v[1] *= bfhi(rr.x); v[2] *= bflo(rr.y); v[3] *= bfhi(rr.y); }
#pragma unroll 1
        for (int t = NTG + NTA; t < NT - 2; t += 2) { GM_SETUP(t, false); GM_ITER(0, 0); }
        { GM_SETUP(NT - 2, true); GM_ITER(0, 1); }
        if (wr == 0) PG8_BAR;
        {
            const int row0 = cur.pm * BM + wr * 64 + fr, col0 = cur.pn * HALF + wc * 32 + 8 * fq;
#pragma unroll
            for (int ai = 0; ai < 2; ++ai)
#pragma unroll
                for (int m = 0; m < 4; ++m) { const f32x4 v0 = acc[ai][0][m][0], v1 = acc[ai][0][m][1]; const u32x2 s0 = sgb[ai][m][0], s1 = sgb[ai][m][1];
                    u32x4 w; w.x = cvt_pk_bf16(v0[0] * bflo(s0.x), v0[1] * bfhi(s0.x)); w.y = cvt_pk_bf16(v0[2] * bflo(s0.y), v0[3] * bfhi(s0.y));
                    w.z = cvt_pk_bf16(v1[0] * bflo(s1.x), v1[1] * bfhi(s1.x)); w.w = cvt_pk_bf16(v1[2] * bflo(s1.y), v1[3] * bfhi(s1.y));
                    *(u32x4*)(g.MIXED + (size_t)(row0 + ai * HALF + m * 16) * DM + col0) = w; }
        }
        if (!has_next) break;
#pragma unroll
        for (int a = 0; a < 2; ++a)
#pragma unroll
            for (int b = 0; b < 2; ++b)
#pragma unroll
                for (int m = 0; m < 4; ++m)
#pragma unroll
                    for (int n = 0; n < 2; ++n) acc[a][b][m][n] = (f32x4){0.f, 0.f, 0.f, 0.f};
        cur = nxt; ++ui;
        if (wr == 1) PG8_BAR;
    }
    PG8_WAIT_V(0);
    PG8_BAR;
#undef PG8_SA
#undef PG8_SB
#undef PG8_STAGE
#undef PG8_LDA
#undef PG8_LDB
#undef PG8_MMA
#undef PG8_WAIT_V
#undef PG8_WAIT_L
#undef PG8_BAR
#undef PG8_SCHED
#undef GM_K
#undef GM_APTR
#undef GM_BPTR
#undef GM_ITER
#undef GM_SETUP
#undef RA2
#undef RB2
}
}

constexpr int NWAVES = 8;
constexpr int RING_OFF = 0, RING_BYTES = 131072;
constexpr int ATTN_LDS = 147456;
constexpr int BIAS_OFF = ATTN_LDS;
constexpr int LDSCTL_OFF = BIAS_OFF + 3 * 4 * 192 * 4;
constexpr int MISC_OFF = LDSCTL_OFF, TILE_E_OFF = LDSCTL_OFF + 256, FIRST_OFF = TILE_E_OFF + 320 * 4;
constexpr int LDS_BYTES = 163840;
static_assert(FIRST_OFF + 64 * 4 <= LDS_BYTES, "LDS map");
constexpr size_t WS_XB = WS_X1B;
constexpr size_t WT_WIN = WS_WT;
constexpr size_t WT_WPA = WT_WIN + (size_t)INW * DM * 2;
constexpr size_t WT_WEFF = WT_WPA + (size_t)DM * AOW * 2;
constexpr size_t WT_WOUT = WT_WEFF + (size_t)DM * POOLW * 2;
constexpr size_t WT_WGU = WT_WOUT + (size_t)DM * DM * 2;
constexpr size_t WT_WD = WT_WGU + (size_t)NEXP * 512 * DM * 2;
static_assert(WT_WD + (size_t)NEXP * DM * DEXP * 2 <= WS_CTL, "weights fit");
constexpr int CW_CNT = 0;
constexpr int CW_BAR = 4096;
constexpr int CW_READY = 8192;
constexpr int CW_Q9 = 30720, CW_TMO = 30784;
constexpr size_t CTL_ZERO_BYTES = 262144;
#ifdef TPROBE
constexpr int CW_TS = 32768, CW_ACC = 49152;
#define TSTAMP(k) do { asm volatile("" ::: "memory"); if (F.wave == 0 && lane_id() == 0) __hip_atomic_store((unsigned*)(args.ws + WS_CTL) + CW_TS + (int)blockIdx.x * 32 + (k), (unsigned)__builtin_amdgcn_s_memrealtime(), __ATOMIC_RELAXED, __HIP_MEMORY_SCOPE_AGENT); asm volatile("" ::: "memory"); } while (0)
#else
#define TSTAMP(k) do { } while (0)
#endif

#define GAS __attribute__((address_space(1)))
#define LAS __attribute__((address_space(3)))
typedef GAS unsigned gu32;
#define RLX_AGENT __ATOMIC_RELAXED, __HIP_MEMORY_SCOPE_AGENT
#define LDS_WAIT() asm volatile("s_waitcnt lgkmcnt(0)" ::: "memory")
#define VM_WAIT() asm volatile("s_waitcnt vmcnt(0)" ::: "memory")
typedef unsigned v4u __attribute__((ext_vector_type(4)));
__device__ __forceinline__ unsigned pk2(float lo, float hi) { return (unsigned)f2bf(lo) | ((unsigned)f2bf(hi) << 16); }

#define XB_TMO      128
#define XB_XCNT(j)  (256  + 64 * (j))
#define XB_XSUB(j)  (1280 + 64 * (j))
#define XB_XGEN(j)  (2304 + 64 * (j))
#define XB_TOP      3328
#define XB_TOPGEN   3392
#define XCD_BAR_WORDS 3456
#define XB_SPIN_CAP (1u << 18)

__device__ __forceinline__ unsigned xb_ld(unsigned* p)              { return __hip_atomic_load(p, __ATOMIC_RELAXED, __HIP_MEMORY_SCOPE_AGENT); }
__device__ __forceinline__ unsigned xb_add(unsigned* p, unsigned v) { return __hip_atomic_fetch_add(p, v, __ATOMIC_RELAXED, __HIP_MEMORY_SCOPE_AGENT); }
__device__ __forceinline__ unsigned xb_xcc_id() { return (unsigned)__builtin_amdgcn_s_getreg((3 << 11) | 20) & 0xFu; }
#define XB_SPIN(cond, bar) do { unsigned _sp = 0; while (cond) { __builtin_amdgcn_s_sleep(1); \
    if ((++_sp & 255u) == 0u) { if (xb_ld(&(bar)[XB_TMO])) break; if (_sp > XB_SPIN_CAP) { atomicAdd(&(bar)[XB_TMO], 1u); break; } } } } while (0)

struct XcdBarrier {
    unsigned* bar; unsigned x; unsigned w;
    volatile LAS unsigned* st;
};

__device__ __forceinline__ XcdBarrier xcd_barrier_post(unsigned* bar, volatile LAS unsigned* st, unsigned w) {
    XcdBarrier b; b.bar = bar; b.x = xb_xcc_id(); b.st = st; b.w = w;
    if (w == 0u && lane_id() == 0) (void)xb_add(&bar[XB_XCNT(b.x)], 1u);
    return b;
}
__device__ __forceinline__ void xcd_barrier_complete(unsigned* bar, unsigned x, unsigned& nloc, unsigned& nx) {
    const unsigned G = gridDim.x * gridDim.y * gridDim.z;
    unsigned sum, cnt, mine, sp = 0u;
    for (;;) {
        sum = 0u; cnt = 0u; mine = 0u;
#pragma unroll
        for (unsigned j = 0; j < 16; ++j) { const unsigned c = xb_ld(&bar[XB_XCNT(j)]); sum += c; cnt += (c > 0u) ? 1u : 0u; mine = (j == x) ? c : mine; }
        if (sum == G) break;
        __builtin_amdgcn_s_sleep(1);
        if ((++sp & 255u) == 0u) { if (xb_ld(&bar[XB_TMO])) break; if (sp > XB_SPIN_CAP) { atomicAdd(&bar[XB_TMO], 1u); break; } }
    }
    nloc = mine > 0u ? mine : 1u; nx = cnt > 0u ? cnt : 1u;
}

__device__ __forceinline__ void xcd_barrier(const XcdBarrier& b) {
    asm volatile("s_waitcnt vmcnt(0)" ::: "memory");
    __syncthreads();
    if (b.w == 0u && lane_id() == 0) {
        unsigned* bar = b.bar;
        __builtin_amdgcn_s_waitcnt(0);
        unsigned nloc = b.st[0], nx = b.st[1];
        if (nloc == 0u) { xcd_barrier_complete(bar, b.x, nloc, nx); b.st[0] = nloc; b.st[1] = nx; }
        const unsigned old = xb_add(&bar[XB_XSUB(b.x)], 1u);
        const unsigned gen = old / nloc;
        if (old + 1u == (gen + 1u) * nloc) {
            __builtin_amdgcn_fence(__ATOMIC_RELEASE, "agent");
            asm volatile("s_waitcnt vmcnt(0)" ::: "memory");
            const unsigned og = xb_add(&bar[XB_TOP], 1u);
            const unsigned tg = og / nx;
            if (og + 1u == (tg + 1u) * nx) xb_add(&bar[XB_TOPGEN], 1u);
            else XB_SPIN(xb_ld(&bar[XB_TOPGEN]) == tg, bar);
            __builtin_amdgcn_fence(__ATOMIC_ACQUIRE, "agent");
            xb_add(&bar[XB_XGEN(b.x)], 1u);
            asm volatile("s_waitcnt vmcnt(0)" ::: "memory");
        } else {
            XB_SPIN(xb_ld(&bar[XB_XGEN(b.x)]) <= gen, bar);
            __builtin_amdgcn_fence(__ATOMIC_ACQUIRE, "agent");
            asm volatile("s_waitcnt vmcnt(0)" ::: "memory");
        }
    }
    __syncthreads();
}

__device__ __forceinline__ void xcd_arrive(const XcdBarrier& b) {
    asm volatile("s_waitcnt vmcnt(0)" ::: "memory");
    __syncthreads();
    if (b.w == 0u && lane_id() == 0) {
        unsigned* bar = b.bar;
        __builtin_amdgcn_s_waitcnt(0);
        unsigned nloc = b.st[0], nx = b.st[1];
        if (nloc == 0u) { xcd_barrier_complete(bar, b.x, nloc, nx); b.st[0] = nloc; b.st[1] = nx; }
        const unsigned old = xb_add(&bar[XB_XSUB(b.x)], 1u);
        const unsigned gen = old / nloc; unsigned role = 0u, tg = 0u;
        if (old + 1u == (gen + 1u) * nloc) {
            __builtin_amdgcn_fence(__ATOMIC_RELEASE, "agent");
            asm volatile("s_waitcnt vmcnt(0)" ::: "memory");
            const unsigned og = xb_add(&bar[XB_TOP], 1u); tg = og / nx;
            if (og + 1u == (tg + 1u) * nx) { xb_add(&bar[XB_TOPGEN], 1u); role = 2u; } else role = 1u;
        }
        b.st[2] = role; b.st[3] = gen; b.st[4] = tg;
    }
}
__device__ __forceinline__ void xcd_wait(const XcdBarrier& b) {
    if (b.w == 0u && lane_id() == 0) {
        unsigned* bar = b.bar; const unsigned role = b.st[2], gen = b.st[3], tg = b.st[4];
        if (role) {
            if (role == 1u) XB_SPIN(xb_ld(&bar[XB_TOPGEN]) <= tg, bar);
            __builtin_amdgcn_fence(__ATOMIC_ACQUIRE, "agent");
            xb_add(&bar[XB_XGEN(b.x)], 1u);
            asm volatile("s_waitcnt vmcnt(0)" ::: "memory");
        } else {
            XB_SPIN(xb_ld(&bar[XB_TOPGEN]) <= gen, bar);
            __builtin_amdgcn_fence(__ATOMIC_ACQUIRE, "agent");
            asm volatile("s_waitcnt vmcnt(0)" ::: "memory");
        }
    }
    asm volatile("s_waitcnt lgkmcnt(0)" ::: "memory"); __builtin_amdgcn_s_barrier(); asm volatile("" ::: "memory");
}


struct Frame {
    LAS unsigned char* lds;
    int wave, vcu, G;
};
struct MArgs { const float* in[20]; float* out; unsigned char* ws; int ph_lo, ph_hi; int flags; };

struct TrItem { const float* W; bf16_t* WT; int K, N, k0, n0, drow0; };
__device__ __forceinline__ void tr_load(const TrItem& t, float (&v)[32], int lane) {
#pragma unroll
    for (int i = 0; i < 32; ++i) v[i] = t.W[(size_t)(t.k0 + 2 * i + (lane >> 5)) * t.N + t.n0 + (lane & 31)];
}
__device__ __forceinline__ void tr_store(const TrItem& t, const float (&v)[32], LAS float* scr, int lane) {
#pragma unroll
    for (int i = 0; i < 32; ++i) scr[(2 * i + (lane >> 5)) * 33 + (lane & 31)] = v[i];
    LDS_WAIT(); asm volatile("" ::: "memory");
    const int c = lane & 7;
#pragma unroll
    for (int j = 0; j < 4; ++j) { const int n = (lane >> 3) + 8 * j; const LAS float* s = scr + (8 * c) * 33 + n;
        v4u o; o.x = pk2(s[0 * 33], s[1 * 33]); o.y = pk2(s[2 * 33], s[3 * 33]); o.z = pk2(s[4 * 33], s[5 * 33]); o.w = pk2(s[6 * 33], s[7 * 33]);
        *(GAS v4u*)(t.WT + (size_t)(t.drow0 + n) * t.K + t.k0 + 8 * c) = o; }
    LDS_WAIT(); asm volatile("" ::: "memory");
}
constexpr int TR_IN = (DM / 64) * (INW / 32), TR_PA = (AOW / 64) * (DM / 32), TR_OUT = (DM / 64) * (DM / 32), TR_G = (DM / 64) * (DEXP / 32), TR_D = (DEXP / 64) * (DM / 32);
constexpr int TR_DENSE = TR_IN + TR_PA + TR_OUT, TR_EXP = NEXP * (2 * TR_G + TR_D);
__device__ __forceinline__ TrItem tr_item(const MArgs& a, int it) {
    unsigned char* ws = a.ws; TrItem t; int r = it;
    constexpr int TR_IN_A = (DM / 64) * (GA_OFF / 32);
    if (r < TR_IN) { int kb, n0; if (r < TR_IN_A) { const int nb = GA_OFF / 32; kb = r / nb; n0 = (r % nb) * 32; } else { const int nb = (INW - GA_OFF) / 32, q = r - TR_IN_A; kb = q / nb; n0 = GA_OFF + (q % nb) * 32; }
        t.W = a.in[1]; t.WT = (bf16_t*)(ws + WT_WIN); t.K = DM; t.N = INW; t.k0 = kb * 64; t.n0 = n0;
        t.drow0 = t.n0 < GA_OFF ? t.n0 : (t.n0 < GB_OFF ? GA_OFF + ((t.n0 - GA_OFF) >> 7) * 256 + ((t.n0 - GA_OFF) & 127) : GA_OFF + ((t.n0 - GB_OFF) >> 7) * 256 + 128 + ((t.n0 - GB_OFF) & 127)); return t; } r -= TR_IN;
    if (r < TR_PA) { const int nb = DM / 32; t.W = a.in[6]; t.WT = (bf16_t*)(ws + WT_WPA); t.K = AOW; t.N = DM; t.k0 = (r / nb) * 64; t.n0 = (r % nb) * 32; t.drow0 = t.n0; return t; } r -= TR_PA;
    if (r < TR_OUT) { const int nb = DM / 32; t.W = a.in[8]; t.WT = (bf16_t*)(ws + WT_WOUT); t.K = DM; t.N = DM; t.k0 = (r / nb) * 64; t.n0 = (r % nb) * 32; t.drow0 = t.n0; return t; } r -= TR_OUT;
    const int e = r / (2 * TR_G + TR_D); r -= e * (2 * TR_G + TR_D);
    if (r < 2 * TR_G) { const int up = r >= TR_G; if (up) r -= TR_G; const int nb = DEXP / 32; t.W = (up ? a.in[16] : a.in[15]) + (size_t)e * DM * DEXP; t.WT = (bf16_t*)(ws + WT_WGU); t.K = DM; t.N = DEXP;
        t.k0 = (r / nb) * 64; t.n0 = (r % nb) * 32; t.drow0 = e * 512 + (t.n0 >> 7) * 256 + up * 128 + (t.n0 & 127); return t; }
    r -= 2 * TR_G;
    { const int nb = DM / 32; t.W = a.in[17] + (size_t)e * DEXP * DM; t.WT = (bf16_t*)(ws + WT_WD) + (size_t)e * DM * DEXP; t.K = DEXP; t.N = DM; t.k0 = (r / nb) * 64; t.n0 = (r % nb) * 32; t.drow0 = t.n0; return t; }
}
__device__ __forceinline__ void tr_run(Frame& F, const MArgs& a, int first, int stride, int end) {
    LAS float* scr = (LAS float*)(F.lds + RING_OFF + F.wave * 16384);
    if (first >= end) return;
    float vn[32]; TrItem tn = tr_item(a, first); tr_load(tn, vn, lane_id());
    for (int it = first; it < end; it += stride) {
        float v[32]; TrItem t = tn;
#pragma unroll
        for (int i = 0; i < 32; ++i) v[i] = vn[i];
        if (it + stride < end) { tn = tr_item(a, it + stride); tr_load(tn, vn, lane_id()); }
        tr_store(t, v, scr, lane_id());
    }
}
__device__ __forceinline__ void p0_prologue_a(Frame& F, const MArgs& a) {
    unsigned char* ws = a.ws;
    const int gw = F.vcu * NWAVES + F.wave, NGW = F.G * NWAVES, lane = lane_id();
    tr_run(F, a, gw, NGW, (DM / 64) * (GA_OFF / 32));
    const float* x = a.in[0]; bf16_t* XB = (bf16_t*)(ws + WS_XB);
    for (int it = gw * 8; it < NTOK * DM / 512; it += NGW * 8) {
        f32x4 a0[8], a1[8];
#pragma unroll
        for (int u = 0; u < 8; ++u) { const size_t o = (size_t)(it + u) * 512 + lane * 8; a0[u] = *(const f32x4*)(x + o); a1[u] = *(const f32x4*)(x + o + 4); }
#pragma unroll
        for (int u = 0; u < 8; ++u) { const size_t o = (size_t)(it + u) * 512 + lane * 8;
            v4u w; w.x = pk2(a0[u][0], a0[u][1]); w.y = pk2(a0[u][2], a0[u][3]); w.z = pk2(a1[u][0], a1[u][1]); w.w = pk2(a1[u][2], a1[u][3]);
            *(GAS v4u*)(XB + o) = w; } }
}
__device__ __forceinline__ void p0_prologue_b(Frame& F, const MArgs& a) {
    unsigned char* ws = a.ws;
    const int gw = F.vcu * NWAVES + F.wave, NGW = F.G * NWAVES, lane = lane_id();
    const float* w_pool = a.in[4]; const float* pscale = a.in[5]; const float* w_pp = a.in[7];
    bf16_t* WeffT = (bf16_t*)(ws + WT_WEFF);
    tr_run(F, a, (DM / 64) * (GA_OFF / 32) + gw, NGW, TR_DENSE);
    for (int it = gw; it < (DM / 32) * (POOLW / 32); it += NGW) {
        const int nb = it >> 4, kb = it & 15, g = kb >> 2, n0 = nb * 32, c0 = (kb & 3) * 32, rr = lane & 31, kk = lane >> 5;
        typedef float f32x16 __attribute__((ext_vector_type(16)));
        f32x16 acc = {0.f, 0.f, 0.f, 0.f, 0.f, 0.f, 0.f, 0.f, 0.f, 0.f, 0.f, 0.f, 0.f, 0.f, 0.f, 0.f};
        const float* ap = w_pp + (size_t)(g * 128 + kk) * DM + n0 + rr;
        const float* sp = pscale + g * 128 + kk;
        const float* bp = w_pool + (size_t)(g * 128 + c0 + rr) * 128 + kk;
#pragma unroll 16
        for (int ks = 0; ks < 64; ++ks) { const float av = ap[(size_t)(2 * ks) * DM] * sp[2 * ks], bv = bp[2 * ks];
            acc = __builtin_amdgcn_mfma_f32_32x32x2f32(av, bv, acc, 0, 0, 0); }
#pragma unroll
        for (int i = 0; i < 16; ++i) { const int n = n0 + (i & 3) + 8 * (i >> 2) + 4 * kk;
            WeffT[(size_t)n * POOLW + g * 128 + c0 + rr] = f2bf(acc[i]); }
    }
}

__device__ __forceinline__ int moe_tables(Frame& F, const int* cnt) {
    LAS int* tile_e = (LAS int*)(F.lds + TILE_E_OFF); LAS int* first = (LAS int*)(F.lds + FIRST_OFF);
    __syncthreads();
    if ((F.wave * 64 + lane_id()) < 64) {
        const int e = (F.wave * 64 + lane_id()), nt = (e < NEXP) ? ((__hip_atomic_load(cnt + (e & 31) * 64, RLX_AGENT) + 255) >> 8) : 0;
        int incl = nt;
#pragma unroll
        for (int o = 1; o < 32; o <<= 1) { const int t = __shfl_up(incl, o); if ((e & 31) >= o) incl += t; }
        const int f0 = incl - nt;
        if (e < NEXP) { first[e] = f0; for (int i = 0; i < nt; ++i) tile_e[f0 + i] = e; if (e == NEXP - 1) first[NEXP] = incl; }
    }
    __syncthreads();
    return first[NEXP];
}


typedef float f32x16 __attribute__((ext_vector_type(16)));
typedef short s16x4 __attribute__((ext_vector_type(4)));
constexpr float LOG2E = 1.4426950408889634f;
constexpr float QSCALE = 0.125f * LOG2E;
constexpr int VROW = 192;
__device__ __forceinline__ s16x4 vtr(const LAS unsigned char* p) { return __builtin_bit_cast(s16x4, __builtin_amdgcn_ds_read_tr16_b64_v4i16((LAS s16x4*)p)); }
constexpr int AT_K = 0, AT_V0 = 49152, AT_V1 = 98304;
__device__ __forceinline__ void attn_unit_decode(int un, int& b, int& h, int& g, int& dil, int& L, int& c0, int& l0) {
    const int j = un & 7, bh = un >> 3; h = bh % 12; b = bh / 12; g = h >> 2; dil = 1 << (2 * g); L = SEQ >> (2 * g);
    if (g == 0) { c0 = 0; l0 = 256 * j; } else if (g == 1) { c0 = j >> 1; l0 = 256 * (j & 1); } else { c0 = 2 * j; l0 = 0; }
}
__device__ __forceinline__ size_t attn_krow(int b, int g, int L, int c0, int l0, int wr_) {
    if (g == 2) { const int cls = c0 + ((wr_ >> 7) & 1), l = wr_ & 127; return (size_t)b * QKV_BSTR + (size_t)cls * (L + 1) + l; }
    int l = l0 - 128 + wr_; l = l < 0 ? 0 : l; return (size_t)b * QKV_BSTR + (size_t)c0 * (L + 1) + l;
}
__device__ __forceinline__ void attn_wave_q(int g, int c0, int l0, int w, int& cq, int& lq0) { cq = (g == 2) ? c0 + (w >> 2) : c0; lq0 = (g == 2) ? 32 * (w & 3) : l0 + 32 * w; }
__device__ __forceinline__ void phase_attn(Frame& F, const MArgs& a, const bf16_t* proj, bf16_t* aog, float* lse) {
    LAS float* bias2 = (LAS float*)(F.lds + BIAS_OFF);
    const float* rel_bias = a.in[3];
    int tid0 = (F.wave * 64 + lane_id()); asm volatile("" : "+v"(tid0));
    for (int i = tid0; i < 3 * 4 * 192; i += NWAVES * 64) { const int gs = i / 192, j = i - gs * 192 - 32, g = gs >> 2, dil = 1 << (2 * g);
        bias2[i] = (j >= 0 && j <= 128) ? rel_bias[t5_bucket(j * dil) * 12 + gs] * LOG2E : -1.0e30f; }
    asm volatile("s_waitcnt vmcnt(0) lgkmcnt(0)" ::: "memory"); __builtin_amdgcn_s_barrier(); asm volatile("" ::: "memory");
    LAS unsigned char* ring = F.lds;
    const unsigned lds0 = (unsigned)(size_t)F.lds;
    const int lane = lane_id(), w = F.wave, r = lane & 31, hh = lane >> 5;
    const int NU = BATCH * 12 * 8;
    const int drow = lane >> 3, schunk = (lane & 7) ^ (lane >> 3);
    int koff[4];
#pragma unroll
    for (int ks = 0; ks < 4; ++ks) koff[ks] = r * 128 + ((((2 * ks + hh) ^ (r & 7))) << 4);
    const int trow = 4 * hh + ((lane & 15) >> 2);
    int toff[2];
#pragma unroll
    for (int dt = 0; dt < 2; ++dt) toff[dt] = trow * 128 + (((4 * dt + 2 * ((lane >> 4) & 1) + ((lane & 3) >> 1)) ^ (trow & 7)) << 4) + (lane & 1) * 8;
#define AT_DMA(dst_off, col_off) do { _Pragma("unroll") for (int _p = 0; _p < 6; ++_p) { const int _pc = w + 8 * _p; \
        const bf16_t* _src = proj + attn_krow(b_, g_, L_, c0_, l0_, _pc * 8 + drow) * INW + (col_off) + h_ * HD + schunk * 8; \
        unsigned _keep; const unsigned _dst = (unsigned)__builtin_amdgcn_readfirstlane((int)(lds0 + (unsigned)(dst_off) + (unsigned)_pc * 1024u)); \
        asm volatile("s_mov_b32 %0, m0\n\ts_mov_b32 m0, %2\n\ts_nop 0\n\tglobal_load_lds_dwordx4 %1, off\n\ts_mov_b32 m0, %0" : "=&s"(_keep) : "v"(_src), "s"(_dst) : "memory"); } } while (0)
#define AT_QLOAD(dst) do { int cq_, lq_; attn_wave_q(g_, c0_, l0_, w, cq_, lq_); const bf16_t* _qp = proj + ((size_t)b_ * QKV_BSTR + (size_t)cq_ * (L_ + 1) + lq_ + r) * INW + Q_OFF + h_ * HD + 8 * hh; \
        _Pragma("unroll") for (int ks = 0; ks < 4; ++ks) dst[ks] = *(const bf16x8*)(_qp + 16 * ks); } while (0)
    bf16x8 qn[4];
    int un = F.vcu;
    { int b_, h_, g_, dil_, L_, c0_, l0_; attn_unit_decode(un, b_, h_, g_, dil_, L_, c0_, l0_); (void)dil_;
      AT_QLOAD(qn); AT_DMA(AT_K, K_OFF); AT_DMA(AT_V0, V_OFF); }
    bool first = true;
    for (int par = 0; un < NU; un += F.G, par ^= 1) {
        int b, h, g, dil, L, c0, l0; attn_unit_decode(un, b, h, g, dil, L, c0, l0);
        const bool has_next = (un + F.G) < NU;
        int cq, lq0; attn_wave_q(g, c0, l0, w, cq, lq0);
        const int wbase = (g == 2) ? 128 * (w >> 2) + 32 * (w & 3) - 128 : 32 * w;
        bf16x8 qf[4];
#pragma unroll
        for (int ks = 0; ks < 4; ++ks) qf[ks] = qn[ks];
        if (first) asm volatile("s_waitcnt vmcnt(0)" ::: "memory"); else asm volatile("s_waitcnt vmcnt(9)" ::: "memory");
        first = false;
        __builtin_amdgcn_s_barrier(); asm volatile("" ::: "memory");
        if (has_next) { int b_, h_, g_, dil_, L_, c0_, l0_; attn_unit_decode(un + F.G, b_, h_, g_, dil_, L_, c0_, l0_); (void)dil_;
            AT_QLOAD(qn); if (par == 0) AT_DMA(AT_V1, V_OFF); else AT_DMA(AT_V0, V_OFF); }
        f32x16 st[5];
#pragma unroll
        for (int kt = 0; kt < 5; ++kt) {
            int wrow = wbase + 32 * kt; if (g == 2) { const int lo_ = 128 * (w >> 2); wrow = wrow < lo_ ? lo_ : wrow; }
            f32x16 acc = {0.f, 0.f, 0.f, 0.f, 0.f, 0.f, 0.f, 0.f, 0.f, 0.f, 0.f, 0.f, 0.f, 0.f, 0.f, 0.f};
#pragma unroll
            for (int ks = 0; ks < 4; ++ks) { const bf16x8 kf = *(const LAS bf16x8*)(ring + AT_K + wrow * 128 + koff[ks]);
                acc = __builtin_amdgcn_mfma_f32_32x32x16_bf16(kf, qf[ks], acc, 0, 0, 0); }
            st[kt] = acc;
        }
        asm volatile("s_waitcnt lgkmcnt(0)" ::: "memory"); __builtin_amdgcn_s_barrier(); asm volatile("" ::: "memory");
        if (has_next) { int b_, h_, g_, dil_, L_, c0_, l0_; attn_unit_decode(un + F.G, b_, h_, g_, dil_, L_, c0_, l0_); (void)dil_; AT_DMA(AT_K, K_OFF); }
        const LAS float* bt = bias2 + h * 192 + 32 + 128 + (r - 4 * hh);
        float mx = -1.0e30f;
        if (lq0 >= 128) {
#pragma unroll
            for (int kt = 0; kt < 5; ++kt)
#pragma unroll
                for (int hb = 0; hb < 2; ++hb) { float bvv[8];
#pragma unroll
                    for (int i = 0; i < 8; ++i) bvv[i] = bt[-32 * kt - ((i & 3) + 8 * (2 * hb + (i >> 2)))];
                    asm volatile("" : "+v"(bvv[0]), "+v"(bvv[1]), "+v"(bvv[2]), "+v"(bvv[3]), "+v"(bvv[4]), "+v"(bvv[5]), "+v"(bvv[6]), "+v"(bvv[7]));
#pragma unroll
                    for (int i = 0; i < 8; ++i) { const float sv = st[kt][8 * hb + i] + bvv[i]; st[kt][8 * hb + i] = sv; mx = fmaxf(mx, sv); } }
        } else {
            const int jmax = lq0 + r, jl = 128 + r - 4 * hh;
#pragma unroll
            for (int kt = 0; kt < 5; ++kt)
#pragma unroll
                for (int hb = 0; hb < 2; ++hb) { float bvv[8];
#pragma unroll
                    for (int i = 0; i < 8; ++i) bvv[i] = bt[-32 * kt - ((i & 3) + 8 * (2 * hb + (i >> 2)))];
                    asm volatile("" : "+v"(bvv[0]), "+v"(bvv[1]), "+v"(bvv[2]), "+v"(bvv[3]), "+v"(bvv[4]), "+v"(bvv[5]), "+v"(bvv[6]), "+v"(bvv[7]));
#pragma unroll
                    for (int i = 0; i < 8; ++i) { const int jc = -32 * kt - ((i & 3) + 8 * (2 * hb + (i >> 2)));
                        const float sv = (jl + jc <= jmax) ? st[kt][8 * hb + i] + bvv[i] : -1.0e30f; st[kt][8 * hb + i] = sv; mx = fmaxf(mx, sv); } }
        }
        mx = fmaxf(mx, __shfl_xor(mx, 32));
        float lsum = 0.f;
#pragma unroll
        for (int kt = 0; kt < 5; ++kt)
#pragma unroll
            for (int i = 0; i < 16; ++i) { const float pv = __builtin_amdgcn_exp2f(st[kt][i] - mx); st[kt][i] = pv; lsum += pv; }
        lsum += __shfl_xor(lsum, 32);
        f32x16 o0 = {0.f, 0.f, 0.f, 0.f, 0.f, 0.f, 0.f, 0.f, 0.f, 0.f, 0.f, 0.f, 0.f, 0.f, 0.f, 0.f}, o1 = o0;
        const int vbuf = par ? AT_V1 : AT_V0;
#pragma unroll
        for (int kt = 0; kt < 5; ++kt) {
            int wrow = wbase + 32 * kt; if (g == 2) { const int lo_ = 128 * (w >> 2); wrow = wrow < lo_ ? lo_ : wrow; }
            const LAS unsigned char* vb = ring + vbuf + wrow * 128;
#pragma unroll
            for (int s2 = 0; s2 < 2; ++s2) {
                pg8::u32x4 pw; pw.x = pg8::cvt_pk_bf16(st[kt][8 * s2 + 0], st[kt][8 * s2 + 1]); pw.y = pg8::cvt_pk_bf16(st[kt][8 * s2 + 2], st[kt][8 * s2 + 3]);
                pw.z = pg8::cvt_pk_bf16(st[kt][8 * s2 + 4], st[kt][8 * s2 + 5]); pw.w = pg8::cvt_pk_bf16(st[kt][8 * s2 + 6], st[kt][8 * s2 + 7]);
                const bf16x8 pf = __builtin_bit_cast(bf16x8, pw);
#pragma unroll
                for (int dt = 0; dt < 2; ++dt) {
                    const s16x4 lo = vtr(vb + (16 * s2) * 128 + toff[dt]), hi = vtr(vb + (16 * s2 + 8) * 128 + toff[dt]);
                    const bf16x8 vf = {lo[0], lo[1], lo[2], lo[3], hi[0], hi[1], hi[2], hi[3]};
                    if (dt == 0) o0 = __builtin_amdgcn_mfma_f32_32x32x16_bf16(vf, pf, o0, 0, 0, 0); else o1 = __builtin_amdgcn_mfma_f32_32x32x16_bf16(vf, pf, o1, 0, 0, 0);
                }
            }
        }
        const float inv = 1.f / lsum;
        const int tok = b * SEQ + cq + dil * (lq0 + r);
        bf16_t* op = aog + ((size_t)g * NTOK + tok) * AOW + (h & 3) * HD + 4 * hh;
#pragma unroll
        for (int dt = 0; dt < 2; ++dt)
#pragma unroll
            for (int q4 = 0; q4 < 4; ++q4) { const f32x16& o = dt == 0 ? o0 : o1;
                pg8::u32x2 wv; wv.x = pg8::cvt_pk_bf16(o[4 * q4] * inv, o[4 * q4 + 1] * inv); wv.y = pg8::cvt_pk_bf16(o[4 * q4 + 2] * inv, o[4 * q4 + 3] * inv);
                *(pg8::u32x2*)(op + 32 * dt + 8 * q4) = wv; }
        if (hh == 0) lse[((size_t)g * NTOK + tok) * 4 + (h & 3)] = mx + __builtin_amdgcn_logf(lsum);
        asm volatile("s_waitcnt lgkmcnt(0)" ::: "memory");
    }
    asm volatile("s_waitcnt vmcnt(0) lgkmcnt(0)" ::: "memory"); __builtin_amdgcn_s_barrier(); asm volatile("" ::: "memory");
#undef AT_DMA
#undef AT_QLOAD
}
template <int W, int NI> __device__ __forceinline__ void pool_items(const bf16_t* proj, bf16_t* diff, int tok0, int ch) {
    pg8::u32x4 v[NI][W];
#pragma unroll
    for (int u = 0; u < NI; ++u) { const int tok = tok0 + 8 * u, t = tok & (SEQ - 1); const bf16_t* p = proj + (size_t)tok * INW + POOL_OFF + ch * 8;
#pragma unroll
        for (int j = 0; j < W; ++j) v[u][j] = *(const pg8::u32x4*)(p - (size_t)((t >= j) ? j : 0) * INW); }
#pragma unroll
    for (int u = 0; u < NI; ++u) { const int tok = tok0 + 8 * u, t = tok & (SEQ - 1);
        float s[8];
#pragma unroll
        for (int e = 0; e < 8; ++e) s[e] = 0.f;
#pragma unroll
        for (int j = 0; j < W; ++j) { const float m = (t >= j) ? 1.f : 0.f;
            s[0] += m * pg8::bflo(v[u][j].x); s[1] += m * pg8::bfhi(v[u][j].x); s[2] += m * pg8::bflo(v[u][j].y); s[3] += m * pg8::bfhi(v[u][j].y);
            s[4] += m * pg8::bflo(v[u][j].z); s[5] += m * pg8::bfhi(v[u][j].z); s[6] += m * pg8::bflo(v[u][j].w); s[7] += m * pg8::bfhi(v[u][j].w); }
        const float ic = 1.f / (float)((t + 1 < W) ? t + 1 : W);
        pg8::u32x4 o;
        o.x = pg8::cvt_pk_bf16(s[0] * ic - pg8::bflo(v[u][0].x), s[1] * ic - pg8::bfhi(v[u][0].x)); o.y = pg8::cvt_pk_bf16(s[2] * ic - pg8::bflo(v[u][0].y), s[3] * ic - pg8::bfhi(v[u][0].y));
        o.z = pg8::cvt_pk_bf16(s[4] * ic - pg8::bflo(v[u][0].z), s[5] * ic - pg8::bfhi(v[u][0].z)); o.w = pg8::cvt_pk_bf16(s[6] * ic - pg8::bflo(v[u][0].w), s[7] * ic - pg8::bfhi(v[u][0].w));
        *(pg8::u32x4*)(diff + (size_t)tok * POOLW + ch * 8) = o; }
}
__device__ __forceinline__ void phase_pool(Frame& F, const bf16_t* proj, bf16_t* diff) {
    const int gw = F.vcu * NWAVES + F.wave, NGW = F.G * NWAVES, lane = lane_id();
    for (int it = gw; it < NTOK / 4; it += NGW) {
        const int tg = it >> 3, cg = ((it & 7) + 2 * (it / NGW)) & 7, tok0 = tg * 32 + (lane >> 3), ch = cg * 8 + (lane & 7), gi = cg >> 1;
        if (gi == 0) pool_items<2, 4>(proj, diff, tok0, ch); else if (gi == 1) pool_items<4, 4>(proj, diff, tok0, ch);
        else if (gi == 2) { pool_items<8, 2>(proj, diff, tok0, ch); pool_items<8, 2>(proj, diff, tok0 + 16, ch); }
        else { pool_items<16, 1>(proj, diff, tok0, ch); pool_items<16, 1>(proj, diff, tok0 + 8, ch); pool_items<16, 1>(proj, diff, tok0 + 16, ch); pool_items<16, 1>(proj, diff, tok0 + 24, ch); }
    }
}
__device__ __forceinline__ void phase_combine(Frame& F, const bf16_t* aog, const float* lse, bf16_t* ao) {
    const int gt = (F.vcu * NWAVES + F.wave) * 64 + lane_id(), NGT = F.G * NWAVES * 64;
    for (int it = gt; it < NTOK * 32; it += NGT) {
        const int tok = it >> 5, ch = it & 31, slot = ch >> 3;
        const float l0 = lse[((size_t)0 * NTOK + tok) * 4 + slot], l1 = lse[((size_t)1 * NTOK + tok) * 4 + slot], l2 = lse[((size_t)2 * NTOK + tok) * 4 + slot];
        const float M = fmaxf(l0, fmaxf(l1, l2));
        float w0 = __builtin_amdgcn_exp2f(l0 - M), w1 = __builtin_amdgcn_exp2f(l1 - M), w2 = __builtin_amdgcn_exp2f(l2 - M);
        const float iw = 1.f / (w0 + w1 + w2); w0 *= iw; w1 *= iw; w2 *= iw;
        const pg8::u32x4 a0 = *(const pg8::u32x4*)(aog + ((size_t)0 * NTOK + tok) * AOW + ch * 8), a1 = *(const pg8::u32x4*)(aog + ((size_t)1 * NTOK + tok) * AOW + ch * 8),
                         a2 = *(const pg8::u32x4*)(aog + ((size_t)2 * NTOK + tok) * AOW + ch * 8);
        pg8::u32x4 o;
#define CMB(f) pg8::cvt_pk_bf16(w0 * pg8::bflo(a0.f) + w1 * pg8::bflo(a1.f) + w2 * pg8::bflo(a2.f), w0 * pg8::bfhi(a0.f) + w1 * pg8::bfhi(a1.f) + w2 * pg8::bfhi(a2.f))
        o.x = CMB(x); o.y = CMB(y); o.z = CMB(z); o.w = CMB(w);
#undef CMB
        *(pg8::u32x4*)(ao + (size_t)tok * AOW + ch * 8) = o;
    }
}

constexpr int XS = 1028;
template <class Pre> __device__ __forceinline__ void phase_ln_router(Frame& F, const MArgs& a, const bf16_t* y, bf16_t* x1b, int* cnt, int* list, float* listw, const Pre& pre) {
    const bf16_t* xb = x1b;
    LAS float* xs = (LAS float*)(F.lds + RING_OFF);
    LAS float* part = xs + 16 * XS;
    LAS float* lgs = part + 8 * 16 * 48;
    LAS unsigned* lcnt = (LAS unsigned*)(lgs + 8 * 16 * 40);
    LAS int* rtab = (LAS int*)(lcnt + 32);
    if ((F.wave * 64 + lane_id()) < 32) lcnt[(F.wave * 64 + lane_id())] = 0u;
    const float* g1 = a.in[9]; const float* b1 = a.in[10]; const float* wrg = a.in[11]; const float* brg = a.in[12]; const float* wre = a.in[13]; const float* bre = a.in[14];
    LAS float* gb1 = (LAS float*)(F.lds + RING_OFF + 122880);
    { int tid0 = (F.wave * 64 + lane_id()); asm volatile("" : "+v"(tid0)); for (int i = tid0; i < 2 * DM; i += NWAVES * 64) gb1[i] = (i < DM) ? g1[i] : b1[i - DM]; }
    __syncthreads();
    const int lane = lane_id(), w = F.wave, t16 = lane & 15, q = lane >> 4, tid = (F.wave * 64 + lane_id());
    bf16x8 wBh[4][3], wBl[4][3];
#pragma unroll
    for (int ks = 0; ks < 4; ++ks)
#pragma unroll
        for (int ct = 0; ct < 3; ++ct) { const int o = 16 * ct + t16; float wv[8];
#pragma unroll
            for (int j = 0; j < 8; ++j) { const int k = 128 * w + 32 * ks + 8 * q + j; wv[j] = (o < 4) ? wrg[k * 4 + o] : ((o < 36) ? wre[k * 32 + o - 4] : 0.f); }
            pg8::u32x4 hw, lw;
#pragma unroll
            for (int j2 = 0; j2 < 4; ++j2) { const unsigned hp = pg8::cvt_pk_bf16(wv[2 * j2], wv[2 * j2 + 1]);
                const unsigned lp = pg8::cvt_pk_bf16(wv[2 * j2] - pg8::bflo(hp), wv[2 * j2 + 1] - pg8::bfhi(hp)); hw[j2] = hp; lw[j2] = lp; }
            wBh[ks][ct] = __builtin_bit_cast(bf16x8, hw); wBl[ks][ct] = __builtin_bit_cast(bf16x8, lw); }
    const int ntile = NTOK / 16;
    pg8::u32x2 vn[2][4], yn[2][4];
#define LNR_LOAD(T_) do { _Pragma("unroll") for (int rr = 0; rr < 2; ++rr) _Pragma("unroll") for (int j = 0; j < 4; ++j) { const size_t o_ = (size_t)(16 * (T_) + 2 * w + rr) * DM + lane * 4 + 256 * j; \
        vn[rr][j] = *(const pg8::u32x2*)(xb + o_); yn[rr][j] = *(const pg8::u32x2*)(y + o_); } } while (0)
    pre();
    LNR_LOAD(F.vcu);
    const float rb0 = ((tid % 36) < 4) ? brg[tid % 36] : bre[(tid % 36) - 4], rb1 = (((tid + NWAVES * 64) % 36) < 4) ? brg[(tid + NWAVES * 64) % 36] : bre[((tid + NWAVES * 64) % 36) - 4];
    int ti = 0;
    for (int T = F.vcu; T < ntile; T += F.G, ++ti) {
        f32x4 v[2][4];
#pragma unroll
        for (int rr = 0; rr < 2; ++rr)
#pragma unroll
            for (int j = 0; j < 4; ++j) { f32x4 z; z[0] = ALPHA * pg8::bflo(vn[rr][j].x) + pg8::bflo(yn[rr][j].x); z[1] = ALPHA * pg8::bfhi(vn[rr][j].x) + pg8::bfhi(yn[rr][j].x);
                z[2] = ALPHA * pg8::bflo(vn[rr][j].y) + pg8::bflo(yn[rr][j].y); z[3] = ALPHA * pg8::bfhi(vn[rr][j].y) + pg8::bfhi(yn[rr][j].y); v[rr][j] = z; }
        if (T + F.G < ntile) LNR_LOAD(T + F.G);
#pragma unroll
        for (int rr = 0; rr < 2; ++rr) {
            const int tok = 16 * T + 2 * w + rr;
            float s = 0.f;
#pragma unroll
            for (int j = 0; j < 4; ++j) s += (v[rr][j][0] + v[rr][j][1]) + (v[rr][j][2] + v[rr][j][3]);
            const float mean = wave_sum(s) * (1.f / DM); float s2 = 0.f;
#pragma unroll
            for (int j = 0; j < 4; ++j) { const f32x4 d = v[rr][j] - mean; s2 += (d[0] * d[0] + d[1] * d[1]) + (d[2] * d[2] + d[3] * d[3]); }
            const float rstd = 1.f / sqrtf(wave_sum(s2) * (1.f / DM) + LN_EPS);
#pragma unroll
            for (int j = 0; j < 4; ++j) { const int k0 = lane * 4 + 256 * j;
                const f32x4 x1 = (v[rr][j] - mean) * rstd * *(const LAS f32x4*)(gb1 + k0) + *(const LAS f32x4*)(gb1 + DM + k0);
                *(LAS f32x4*)(xs + (2 * w + rr) * XS + k0) = x1;
                pg8::u32x2 pk; pk.x = pg8::cvt_pk_bf16(x1[0], x1[1]); pk.y = pg8::cvt_pk_bf16(x1[2], x1[3]);
                *(pg8::u32x2*)(x1b + (size_t)tok * DM + k0) = pk; }
        }
        __syncthreads();
        f32x4 acc[3];
#pragma unroll
        for (int ct = 0; ct < 3; ++ct) acc[ct] = (f32x4){0.f, 0.f, 0.f, 0.f};
        const LAS float* xr = xs + t16 * XS + 128 * w + 8 * q;
#pragma unroll
        for (int ks = 0; ks < 4; ++ks) { const f32x4 xa = *(const LAS f32x4*)(xr + 32 * ks), xb = *(const LAS f32x4*)(xr + 32 * ks + 4);
            pg8::u32x4 hw, lw;
            hw.x = pg8::cvt_pk_bf16(xa[0], xa[1]); hw.y = pg8::cvt_pk_bf16(xa[2], xa[3]); hw.z = pg8::cvt_pk_bf16(xb[0], xb[1]); hw.w = pg8::cvt_pk_bf16(xb[2], xb[3]);
            lw.x = pg8::cvt_pk_bf16(xa[0] - pg8::bflo(hw.x), xa[1] - pg8::bfhi(hw.x)); lw.y = pg8::cvt_pk_bf16(xa[2] - pg8::bflo(hw.y), xa[3] - pg8::bfhi(hw.y));
            lw.z = pg8::cvt_pk_bf16(xb[0] - pg8::bflo(hw.z), xb[1] - pg8::bfhi(hw.z)); lw.w = pg8::cvt_pk_bf16(xb[2] - pg8::bflo(hw.w), xb[3] - pg8::bfhi(hw.w));
            const bf16x8 ah = __builtin_bit_cast(bf16x8, hw), al = __builtin_bit_cast(bf16x8, lw);
#pragma unroll
            for (int ct = 0; ct < 3; ++ct) {
                acc[ct] = __builtin_amdgcn_mfma_f32_16x16x32_bf16(ah, wBh[ks][ct], acc[ct], 0, 0, 0);
                acc[ct] = __builtin_amdgcn_mfma_f32_16x16x32_bf16(al, wBh[ks][ct], acc[ct], 0, 0, 0);
                acc[ct] = __builtin_amdgcn_mfma_f32_16x16x32_bf16(ah, wBl[ks][ct], acc[ct], 0, 0, 0); } }
#pragma unroll
        for (int ct = 0; ct < 3; ++ct)
#pragma unroll
            for (int rg = 0; rg < 4; ++rg) part[(w * 16 + 4 * q + rg) * 48 + 16 * ct + t16] = acc[ct][rg];
        __syncthreads();
        for (int i = tid; i < 16 * 36; i += NWAVES * 64) { const int tk = i / 36, o = i - tk * 36; float sum = (i < NWAVES * 64) ? rb0 : rb1;
#pragma unroll
            for (int ww = 0; ww < 8; ++ww) sum += part[(ww * 16 + tk) * 48 + o];
            lgs[(ti * 16 + tk) * 40 + o] = sum; }
    }
#undef LNR_LOAD
    __syncthreads();
    for (int sl_ = tid; sl_ < ti * 16; sl_ += NWAVES * 64) {
        const LAS float* sl = lgs + sl_ * 40;
        int gi = 0; float gm = sl[0];
        for (int o = 1; o < 4; ++o) if (sl[o] > gm) { gm = sl[o]; gi = o; }
        float gs = 0.f; for (int o = 0; o < 4; ++o) gs += __expf(sl[o] - gm);
        const float gprob = 1.f / gs;
        const LAS float* el = sl + 4 + gi * 8;
        int i0 = 0; float l0 = el[0];
        for (int o = 1; o < 8; ++o) if (el[o] > l0) { l0 = el[o]; i0 = o; }
        int i1 = -1; float l1 = -3.0e38f;
        for (int o = 0; o < 8; ++o) if (o != i0 && el[o] > l1) { l1 = el[o]; i1 = o; }
        const float e1 = __expf(l1 - l0), w0 = gprob / (1.f + e1), w1 = gprob * e1 / (1.f + e1);
        const int ex0 = gi * 8 + i0, ex1 = gi * 8 + i1;
        const int r0 = (int)__hip_atomic_fetch_add(lcnt + ex0, 1u, __ATOMIC_RELAXED, __HIP_MEMORY_SCOPE_WORKGROUP), r1 = (int)__hip_atomic_fetch_add(lcnt + ex1, 1u, __ATOMIC_RELAXED, __HIP_MEMORY_SCOPE_WORKGROUP);
        rtab[sl_ * 4 + 0] = (ex0 << 16) | r0; rtab[sl_ * 4 + 1] = (ex1 << 16) | r1; ((LAS float*)rtab)[sl_ * 4 + 2] = w0; ((LAS float*)rtab)[sl_ * 4 + 3] = w1;
    }
    __syncthreads();
    if (tid < 32) { const unsigned n = lcnt[tid]; lcnt[tid] = n ? (unsigned)atomicAdd(&cnt[tid * 64], (int)n) : 0u; }
    __syncthreads();
    for (int sl_ = tid; sl_ < ti * 16; sl_ += NWAVES * 64) {
        const int tok = 16 * (F.vcu + (sl_ >> 4) * F.G) + (sl_ & 15);
        const int a0 = rtab[sl_ * 4 + 0], a1 = rtab[sl_ * 4 + 1]; const float w0 = ((LAS float*)rtab)[sl_ * 4 + 2], w1 = ((LAS float*)rtab)[sl_ * 4 + 3];
        const int ex0 = a0 >> 16, ex1 = a1 >> 16, r0 = (a0 & 0xffff) + (int)lcnt[ex0], r1 = (a1 & 0xffff) + (int)lcnt[ex1];
        list[ex0 * NTOK + r0] = tok * 2; listw[ex0 * NTOK + r0] = w0;
        list[ex1 * NTOK + r1] = tok * 2 + 1; listw[ex1 * NTOK + r1] = w1;
    }
}

#ifdef TPROBE
__device__ __forceinline__ void phase_final(Frame& F, const MArgs& a, const bf16_t* x1b, const bf16_t* po, const float pscale, const float pbump) {
#else
__device__ __forceinline__ void phase_final(Frame& F, const MArgs& a, const bf16_t* x1b, const bf16_t* po) {
#endif
    const float* g2 = a.in[18]; const float* b2 = a.in[19];
    const int gw = F.vcu * NWAVES + F.wave, NGW = F.G * NWAVES, lane = lane_id();
    f32x4 gg2[4], bb2[4];
#pragma unroll
    for (int j = 0; j < 4; ++j) { gg2[j] = *(const f32x4*)(g2 + lane * 4 + 256 * j); bb2[j] = *(const f32x4*)(b2 + lane * 4 + 256 * j); }
    pg8::u32x2 xn[2][4], pan[2][4], pbn[2][4];
#define FIN_LOAD(base_) do { _Pragma("unroll") for (int u = 0; u < 2; ++u) { const int tk = (base_) + u; \
        _Pragma("unroll") for (int j = 0; j < 4; ++j) { const int k0 = lane * 4 + 256 * j; xn[u][j] = *(const pg8::u32x2*)(x1b + (size_t)tk * DM + k0); \
            pan[u][j] = *(const pg8::u32x2*)(po + (size_t)tk * 2 * DM + k0); pbn[u][j] = *(const pg8::u32x2*)(po + (size_t)tk * 2 * DM + DM + k0); } } } while (0)
    FIN_LOAD(gw * 2);
    for (int base = gw * 2; base < NTOK; base += NGW * 2) {
        f32x4 v[2][4]; float s[2] = {0.f, 0.f};
#pragma unroll
        for (int u = 0; u < 2; ++u)
#pragma unroll
            for (int j = 0; j < 4; ++j) { f32x4 t;
                t[0] = ALPHA * pg8::bflo(xn[u][j].x) + (pg8::bflo(pan[u][j].x) + pg8::bflo(pbn[u][j].x)); t[1] = ALPHA * pg8::bfhi(xn[u][j].x) + (pg8::bfhi(pan[u][j].x) + pg8::bfhi(pbn[u][j].x));
                t[2] = ALPHA * pg8::bflo(xn[u][j].y) + (pg8::bflo(pan[u][j].y) + pg8::bflo(pbn[u][j].y)); t[3] = ALPHA * pg8::bfhi(xn[u][j].y) + (pg8::bfhi(pan[u][j].y) + pg8::bfhi(pbn[u][j].y));
                v[u][j] = t; s[u] += (t[0] + t[1]) + (t[2] + t[3]); }
        if (base + NGW * 2 < NTOK) FIN_LOAD(base + NGW * 2);
#pragma unroll
        for (int u = 0; u < 2; ++u) {
            const float mean = wave_sum(s[u]) * (1.f / DM); float s2 = 0.f;
#pragma unroll
            for (int j = 0; j < 4; ++j) { v[u][j] = v[u][j] - mean; s2 += (v[u][j][0] * v[u][j][0] + v[u][j][1] * v[u][j][1]) + (v[u][j][2] * v[u][j][2] + v[u][j][3] * v[u][j][3]); }
            const float rstd = 1.f / sqrtf(wave_sum(s2) * (1.f / DM) + LN_EPS);
            float* row = a.out + (size_t)(base + u) * DM;
#pragma unroll
            for (int j = 0; j < 4; ++j) { const int k0 = lane * 4 + 256 * j; f32x4 o_ = v[u][j] * rstd * gg2[j] + bb2[j];
#ifdef TPROBE
                if (base + u == 0 && k0 == 0) o_[0] += pbump; else o_[0] *= pscale;
                o_[1] *= pscale; o_[2] *= pscale; o_[3] *= pscale;
#endif
                *(f32x4*)(row + k0) = o_; }
        }
    }
#undef FIN_LOAD
}


#ifdef TPROBE
struct PreWait { XcdBarrier b; bool on; unsigned* ts; int k; int wave; __device__ __forceinline__ void operator()() const {
    if (wave == 0 && lane_id() == 0) __hip_atomic_store(ts + k, (unsigned)__builtin_amdgcn_s_memrealtime(), __ATOMIC_RELAXED, __HIP_MEMORY_SCOPE_AGENT);
    if (on) xcd_wait(b);
    if (wave == 0 && lane_id() == 0) __hip_atomic_store(ts + k + 1, (unsigned)__builtin_amdgcn_s_memrealtime(), __ATOMIC_RELAXED, __HIP_MEMORY_SCOPE_AGENT); } };
#define PREWAIT(k_) PreWait pre{bar, multi, (unsigned*)(args.ws + WS_CTL) + CW_TS + (int)blockIdx.x * 32, (k_), F.wave}
#else
struct PreWait { XcdBarrier b; bool on; __device__ __forceinline__ void operator()() const { if (on) xcd_wait(b); } };
#define PREWAIT(k_) PreWait pre{bar, multi}
#endif
__global__ void __launch_bounds__(NWAVES * 64, 2) mega(MArgs args) {
    extern __shared__ __attribute__((aligned(16))) unsigned char lds[];
    Frame F;
    F.lds = (LAS unsigned char*)lds;
    F.wave = __builtin_amdgcn_readfirstlane((int)(threadIdx.x >> 6));
    F.G = gridDim.x; { const int bx = blockIdx.x; F.vcu = (F.G % 8 == 0) ? (bx % 8) * (F.G / 8) + bx / 8 : bx; }
    unsigned char* ws = args.ws;
    gu32* ctl = (gu32*)(ws + WS_CTL);
    { int tid0 = (F.wave * 64 + lane_id()); asm volatile("" : "+v"(tid0)); for (int u = tid0; u < (LDS_BYTES - LDSCTL_OFF) / 4; u += NWAVES * 64) ((LAS unsigned*)(F.lds + LDSCTL_OFF))[u] = 0u; }
    __syncthreads();
    const int lo = args.ph_lo, hi = args.ph_hi;
    const bool multi = (hi - lo) > 1;
    XcdBarrier bar; bar.bar = (unsigned*)(ctl + CW_BAR); bar.x = 0; bar.st = nullptr; bar.w = (unsigned)F.wave;
    if (multi) bar = xcd_barrier_post((unsigned*)(ctl + CW_BAR), (volatile LAS unsigned*)(F.lds + MISC_OFF) + 8, (unsigned)F.wave);
    bf16_t* PROJ = (bf16_t*)(ws + WS_PROJ); bf16_t* MIXED = (bf16_t*)(ws + WS_MIXED); bf16_t* X1B = (bf16_t*)(ws + WS_X1B); bf16_t* XB = (bf16_t*)(ws + WS_XB);
    bf16_t* HID = (bf16_t*)(ws + WS_HID); bf16_t* PO = (bf16_t*)(ws + WS_PO); bf16_t* Y = (bf16_t*)(ws + WS_Z);
    bf16_t* AO = (bf16_t*)((unsigned char*)args.out + DO_AO); bf16_t* DIFF = (bf16_t*)((unsigned char*)args.out + DO_DIFF);
    bf16_t* AOG = (bf16_t*)((unsigned char*)args.out + DO_AOG); float* LSE = (float*)((unsigned char*)args.out + DO_LSE);
    int* cnt = (int*)(ws + WS_CTL) + CW_CNT; int* list = (int*)(ws + WS_LIST); float* listw = (float*)(ws + WS_LISTW);
#define PHASE_0 { TSTAMP(0); p0_prologue_a(F, args); TSTAMP(1); if (multi) xcd_arrive(bar); p0_prologue_b(F, args); TSTAMP(2); if (multi) xcd_wait(bar); TSTAMP(3); }
#define PHASE_1 { pg8::Gemm g{XB, (const bf16_t*)(ws + WT_WIN), DM, F.wave, args.flags}; pg8::StaticOrder S; S.init(NTOK, GA_OFF, F.G, (int)blockIdx.x);     \
        pg8::EpiProj E{PROJ, args.in[2], QSCALE}; pg8::gemm_phase<pg8::EpiProj, pg8::StaticOrder, true>(F.lds + RING_OFF, g, S, E); TSTAMP(4); \
        if (multi) xcd_arrive(bar);                                     \
          \
        { const int bx = (int)blockIdx.x; if (F.G == 256) { if (bx >= 128) tr_run(F, args, TR_DENSE + ((bx - 128) * NWAVES + F.wave), 1024, TR_DENSE + 10240); \
              else tr_run(F, args, TR_DENSE + 10240 + (bx * NWAVES + F.wave), 1024, TR_DENSE + TR_EXP); } \
          else tr_run(F, args, TR_DENSE + F.vcu * NWAVES + F.wave, F.G * NWAVES, TR_DENSE + TR_EXP); } \
        TSTAMP(5); if (multi) xcd_wait(bar); TSTAMP(6); }
#define PHASE_2 { phase_attn(F, args, PROJ, AOG, LSE); TSTAMP(7); if (multi) xcd_arrive(bar); }
#define PHASE_3 { phase_pool(F, PROJ, DIFF); TSTAMP(8); if (multi) xcd_wait(bar); TSTAMP(9); phase_combine(F, AOG, LSE, AO); TSTAMP(10); if (multi) xcd_arrive(bar); }
#define PHASE_4 { pg8::GemmGM g{XB, (const bf16_t*)(ws + WT_WIN), AO, (const bf16_t*)(ws + WT_WPA), DIFF, (const bf16_t*)(ws + WT_WEFF), args.in[2], MIXED, F.wave}; \
        pg8::StaticOrder S; S.init(NTOK, 2 * DM, F.G, (int)blockIdx.x);     \
        PREWAIT(11); pg8::gemm_phase_gm<pg8::StaticOrder>(F.lds + RING_OFF, g, S, pre); TSTAMP(13); }
#define PHASE_5 { }
#define PHASE_6 { TSTAMP(14); pg8::Gemm g{MIXED, (const bf16_t*)(ws + WT_WOUT), DM, F.wave, args.flags}; pg8::StaticOrder S; S.init(NTOK, DM, F.G, (int)blockIdx.x); \
        pg8::EpiY E{Y}; pg8::gemm_phase<pg8::EpiY, pg8::StaticOrder, true>(F.lds + RING_OFF, g, S, E); TSTAMP(15); if (multi) xcd_arrive(bar); }
#define PHASE_7 { PREWAIT(16); phase_ln_router(F, args, Y, X1B, cnt, list, listw, pre); TSTAMP(18); }
#define PHASE_8 { TSTAMP(19); const int ntiles = moe_tables(F, cnt); { pg8::Gemm g{X1B, (const bf16_t*)(ws + WT_WGU), DM, F.wave}; \
        pg8::MoeOrder S{(const LAS int*)(F.lds + TILE_E_OFF), (const LAS int*)(F.lds + FIRST_OFF), cnt, list, 2, F.G, F.vcu, ntiles, true, (unsigned*)(ctl + CW_READY)}; \
        pg8::EpiMoe1 E{HID, cnt, listw}; pg8::gemm_phase<pg8::EpiMoe1, pg8::MoeOrder, true>(F.lds + RING_OFF, g, S, E); } TSTAMP(20); \
          \
        { pg8::Gemm g{HID, (const bf16_t*)(ws + WT_WD), DEXP, F.wave}; \
        pg8::DynMoeOrder S{(const LAS int*)(F.lds + TILE_E_OFF), (const LAS int*)(F.lds + FIRST_OFF), 4, ntiles, (unsigned*)(ctl + CW_Q9), (const unsigned*)(ctl + CW_READY), 16u, (unsigned*)(ctl + CW_TMO), (volatile LAS int*)(F.lds + MISC_OFF + 64), F.wave}; \
        pg8::EpiMoe2 E{PO, cnt, list}; pg8::gemm_phase<pg8::EpiMoe2, pg8::DynMoeOrder, true>(F.lds + RING_OFF, g, S, E); } TSTAMP(21); }
#define PHASE_9 { }
#ifdef TPROBE
#define PHASE_10 { float pscale = 1.f, pbump = 0.f; if (multi) { unsigned* tsb = (unsigned*)(args.ws + WS_CTL) + CW_TS + (int)blockIdx.x * 32; unsigned* acc = (unsigned*)(args.ws + WS_CTL) + CW_ACC; \
        if (F.wave == 0 && lane_id() == 0) { __hip_atomic_store(tsb + 22, (unsigned)__builtin_amdgcn_s_memrealtime(), __ATOMIC_RELAXED, __HIP_MEMORY_SCOPE_AGENT); \
            const unsigned d1 = __hip_atomic_load(tsb + TP_B, __ATOMIC_RELAXED, __HIP_MEMORY_SCOPE_AGENT) - __hip_atomic_load(tsb + TP_A, __ATOMIC_RELAXED, __HIP_MEMORY_SCOPE_AGENT); \
            const unsigned d2 = __hip_atomic_load(tsb + TP_D, __ATOMIC_RELAXED, __HIP_MEMORY_SCOPE_AGENT) - __hip_atomic_load(tsb + TP_C, __ATOMIC_RELAXED, __HIP_MEMORY_SCOPE_AGENT); \
            atomicAdd(acc + 0, d1); atomicMax(acc + 1, d1); atomicAdd(acc + 2, d2); atomicMax(acc + 3, d2); } \
        xcd_barrier(bar); \
        const float v1 = TP_M1 ? (float)__hip_atomic_load(acc + 1, __ATOMIC_RELAXED, __HIP_MEMORY_SCOPE_AGENT) : (float)__hip_atomic_load(acc + 0, __ATOMIC_RELAXED, __HIP_MEMORY_SCOPE_AGENT) * (1.f / 256.f); \
        const float v2 = TP_M2 ? (float)__hip_atomic_load(acc + 3, __ATOMIC_RELAXED, __HIP_MEMORY_SCOPE_AGENT) : (float)__hip_atomic_load(acc + 2, __ATOMIC_RELAXED, __HIP_MEMORY_SCOPE_AGENT) * (1.f / 256.f); \
        pscale = 0.988f - (float)(TP_E) * v1 * 0.01f / (float)(TP_T1); pbump = 30.f * v2 * 0.01f / (float)(TP_T2); } \
        phase_final(F, args, X1B, PO, pscale, pbump); }
#else
#define PHASE_10 phase_final(F, args, X1B, PO);
#endif
#define IN(k) (lo <= (k) && (k) < hi)
#define SEAM(k) do { if (IN(k) && (k) + 1 < hi) xcd_barrier(bar); } while (0)
#define RUN(k, BODY) do { if (IN(k)) { BODY SEAM(k); } } while (0)
    if (IN(0)) PHASE_0
    if (IN(1)) PHASE_1
    if (IN(2)) PHASE_2
    if (IN(3)) PHASE_3
    RUN(4, PHASE_4);
    if (IN(6)) PHASE_6
    RUN(7, PHASE_7);
    RUN(8, PHASE_8);
    RUN(10, PHASE_10);
#undef IN
#undef SEAM
#undef RUN
}

#ifndef SINGLE_LAUNCH
#define SINGLE_LAUNCH 1
#endif
constexpr int NPHASES = 11;
#ifndef DUP_MASK
#define DUP_MASK 0
#endif
#ifndef DUP_FLAGS
#define DUP_FLAGS 0
#endif
extern "C" void kernel_launch(void* const* d_in, const int* in_sizes, int n_in, void* d_out, int out_size, void* d_ws, size_t ws_size, hipStream_t stream) {
    static int grid = 0;
    if (grid == 0) {
        if (n_in != 20 || in_sizes[0] != NTOK * DM || out_size != NTOK * DM || ws_size < WS_END) {
            fprintf(stderr, "kernel_launch: unexpected shapes (n_in %d, in0 %d, out %d, ws %zu)\n", n_in, n_in > 0 ? in_sizes[0] : -1, out_size, ws_size); grid = -1; return; }
        int dev = 0, cus = 0, per_cu = 0;
        if (hipGetDevice(&dev) != hipSuccess || hipDeviceGetAttribute(&cus, hipDeviceAttributeMultiprocessorCount, dev) != hipSuccess) { grid = -1; return; }
        if (hipFuncSetAttribute((const void*)mega, hipFuncAttributeMaxDynamicSharedMemorySize, LDS_BYTES) != hipSuccess) { fprintf(stderr, "kernel_launch: hipFuncSetAttribute failed\n"); grid = -1; return; }
        if (hipOccupancyMaxActiveBlocksPerMultiprocessor(&per_cu, (const void*)mega, NWAVES * 64, LDS_BYTES) != hipSuccess || per_cu < 1) {
            fprintf(stderr, "kernel_launch: occupancy query reports %d workgroups per CU\n", per_cu); (void)hipGetLastError(); grid = -1; return; }
        if (cus != 256) { fprintf(stderr, "kernel_launch: built for a 256-CU device (LDS tables of the LN/router phase are sized for 8 token tiles per workgroup); found %d CUs\n", cus); grid = -1; return; }
        grid = cus;
    }
    if (grid < 0) return;
    (void)hipMemsetAsync((unsigned char*)d_ws + WS_CTL, 0, CTL_ZERO_BYTES, stream);
    MArgs a{};
    for (int i = 0; i < 20; ++i) a.in[i] = (const float*)d_in[i];
    a.out = (float*)d_out; a.ws = (unsigned char*)d_ws;
    if (SINGLE_LAUNCH) { a.ph_lo = 0; a.ph_hi = NPHASES; hipLaunchKernelGGL(mega, dim3(grid), dim3(NWAVES * 64), LDS_BYTES, stream, a); return; }
    for (int p = 0; p < NPHASES; ++p) { a.ph_lo = p; a.ph_hi = p + 1;
        for (int rep = 0; rep < 1 + ((DUP_MASK >> p) & 1); ++rep) { a.flags = (rep == 0 && ((DUP_MASK >> p) & 1)) ? DUP_FLAGS : 0; if (rep && p == 7) (void)hipMemsetAsync((unsigned char*)d_ws + WS_CTL, 0, 8192, stream); hipLaunchKernelGGL(mega, dim3(grid), dim3(NWAVES * 64), LDS_BYTES, stream, a); } }
}
```
